# Optimizing an MI355X kernel written in HIP

```python
import math
import jax, jax.numpy as jnp
from jax import lax
import numpy as np

D_MODEL = 2048
BATCH = 4
SEQ = 8192
DEPTH = 1

CHUNK = 64
GLA_HEADS = 4
GLA_DK = D_MODEL // 2 // GLA_HEADS
GLA_DV = D_MODEL // GLA_HEADS
GLA_RANK = 16
GLA_TAU = 16.0
GMLP_BLOCK = 128
GMLP_GROUPS = 4
GMLP_DG = D_MODEL // GMLP_GROUPS
D_FF = ((8 * D_MODEL + 3 * 256 - 1) // (3 * 256)) * 256
PLE_DIM = 256
ALPHA = (2 * DEPTH) ** 0.25
BETA = (8 * DEPTH) ** -0.25
LN_EPS = 1e-5

SPLIT_SIZES = (
    GLA_HEADS * GLA_DK,
    GLA_HEADS * GLA_DK,
    GLA_HEADS * GLA_DV,
    GLA_HEADS * GLA_DV,
    GLA_HEADS * GLA_RANK,
    D_MODEL,
    D_MODEL,
    D_MODEL,
    D_MODEL,
)
D_IN = sum(SPLIT_SIZES)

kernel_name = "hybrid_gla_gmlp_deepnorm_block"


def _split_points():
    pts, acc = [], 0
    for s in SPLIT_SIZES[:-1]:
        acc += s
        pts.append(acc)
    return pts


def layer_norm(x, g, b):
    xf = x.astype(jnp.float32)
    mu = jnp.mean(xf, axis=-1, keepdims=True)
    var = jnp.mean(jnp.square(xf - mu), axis=-1, keepdims=True)
    return ((xf - mu) * lax.rsqrt(var + LN_EPS) * g + b).astype(x.dtype)


def rms_norm(x, g):
    xf = x.astype(jnp.float32)
    return (xf * lax.rsqrt(jnp.mean(jnp.square(xf), axis=-1, keepdims=True) + LN_EPS) * g).astype(x.dtype)


def gla_chunk_causal(q, k, v, log_a):
    bsz, s, h, dk = q.shape
    dv = v.shape[-1]
    nc = s // CHUNK
    f32 = jnp.float32
    q = q.astype(f32).reshape(bsz, nc, CHUNK, h, dk) * (dk ** -0.5)
    k = k.astype(f32).reshape(bsz, nc, CHUNK, h, dk)
    v = v.astype(f32).reshape(bsz, nc, CHUNK, h, dv)
    b = jnp.cumsum(log_a.astype(f32).reshape(bsz, nc, CHUNK, h, dk), axis=2)
    b_end = b[:, :, -1:]
    k_t = k * jnp.exp(b_end - b)
    q_t = q * jnp.exp(b_end)
    scores = jnp.einsum('bnihd,bnjhd->bnhij', q, k_t)
    o_intra = jnp.einsum('bnhij,bnjhv->bnihv', scores, v)

    def step(state, xs):
        qc, kc, vc, dc = xs
        o = jnp.einsum('blhd,bhdv->blhv', qc, state)
        state = jnp.exp(dc)[..., None] * state + jnp.einsum('blhd,blhv->bhdv', kc, vc)
        return state, o

    xs = (jnp.moveaxis(q_t, 1, 0), jnp.moveaxis(k_t, 1, 0), jnp.moveaxis(v, 1, 0),
          jnp.moveaxis(b_end[:, :, 0], 1, 0))
    state0 = jnp.zeros((bsz, h, dk, dv), f32)
    _, o_inter = lax.scan(step, state0, xs)
    o = o_intra + jnp.moveaxis(o_inter, 0, 1)
    return o.reshape(bsz, s, h, dv)


def gmlp_spatial_gate(u, z, ln_g, ln_b, w_s, b_s):
    bsz, s, d = u.shape
    nb = s // GMLP_BLOCK
    zn = layer_norm(z.reshape(bsz, nb, GMLP_BLOCK, GMLP_GROUPS, GMLP_DG), ln_g, ln_b)
    pos_chunk = jnp.arange(GMLP_BLOCK) // CHUNK
    mask = pos_chunk[:, None] >= pos_chunk[None, :]
    w = jnp.where(mask[None], w_s, jnp.zeros_like(w_s))
    sg = jnp.einsum('gij,bnjgc->bnigc', w, zn) + b_s.T[None, None, :, :, None]
    return u * sg.reshape(bsz, s, d)


def setup_inputs(seed: int = 0) -> dict:
    key = jax.random.key(seed)
    ks = jax.random.split(key, 24)
    f32 = jnp.float32
    nrm = lambda k, shape: jax.random.normal(k, shape, f32)
    L = DEPTH
    return {
        "x": nrm(ks[0], (BATCH, SEQ, D_MODEL)),
        "p": nrm(ks[1], (DEPTH, BATCH, SEQ, PLE_DIM)),
        "ln0_g": 1.0 + 0.01 * nrm(ks[2], (D_MODEL,)),
        "ln0_b": 0.01 * nrm(ks[3], (D_MODEL,)),
        "w_in": nrm(ks[4], (L, D_MODEL, D_IN)) * D_MODEL ** -0.5,
        "b_in": 0.01 * nrm(ks[5], (L, D_IN)),
        "w_f2": nrm(ks[6], (L, GLA_HEADS, GLA_RANK, GLA_DK)) * GLA_RANK ** -0.5,
        "b_f2": 0.1 * nrm(ks[7], (L, GLA_HEADS, GLA_DK)),
        "gla_norm_g": 1.0 + 0.01 * nrm(ks[8], (L, GLA_HEADS, GLA_DV)),
        "gmlp_ln_g": 1.0 + 0.01 * nrm(ks[9], (L, GMLP_GROUPS, GMLP_DG)),
        "gmlp_ln_b": 0.01 * nrm(ks[10], (L, GMLP_GROUPS, GMLP_DG)),
        "w_s": nrm(ks[11], (L, GMLP_GROUPS, GMLP_BLOCK, GMLP_BLOCK)) * GMLP_BLOCK ** -0.5,
        "b_s": 1.0 + 0.01 * nrm(ks[12], (L, GMLP_GROUPS, GMLP_BLOCK)),
        "w_o": nrm(ks[13], (L, D_MODEL, D_MODEL)) * (D_MODEL ** -0.5 * BETA),
        "ln1_g": 1.0 + 0.01 * nrm(ks[14], (L, D_MODEL)),
        "ln1_b": 0.01 * nrm(ks[15], (L, D_MODEL)),
        "w_gu": nrm(ks[16], (L, D_MODEL, 2 * D_FF)) * D_MODEL ** -0.5,
        "w_down": nrm(ks[17], (L, D_FF, D_MODEL)) * (D_FF ** -0.5 * BETA),
        "w_pg": nrm(ks[18], (L, D_MODEL, D_MODEL)) * D_MODEL ** -0.5,
        "b_pg": 0.01 * nrm(ks[19], (L, D_MODEL)),
        "w_pu": nrm(ks[20], (L, PLE_DIM, D_MODEL)) * (PLE_DIM ** -0.5 * BETA),
        "ln2_g": 1.0 + 0.01 * nrm(ks[21], (L, D_MODEL)),
        "ln2_b": 0.01 * nrm(ks[22], (L, D_MODEL)),
    }


def reference(x, p, ln0_g, ln0_b, w_in, b_in, w_f2, b_f2, gla_norm_g, gmlp_ln_g, gmlp_ln_b,
              w_s, b_s, w_o, ln1_g, ln1_b, w_gu, w_down, w_pg, b_pg, w_pu, ln2_g, ln2_b):
    bsz, s, d = x.shape
    pts = _split_points()
    h = layer_norm(x, ln0_g, ln0_b)
    for i in range(DEPTH):
        proj = h @ w_in[i] + b_in[i]
        q, k, v, og, fg, u, z, ga, gb = jnp.split(proj, pts, axis=-1)
        fg = fg.reshape(bsz, s, GLA_HEADS, GLA_RANK)
        f_logit = jnp.einsum('bshr,hrd->bshd', fg, w_f2[i]) + b_f2[i]
        log_a = jax.nn.log_sigmoid(f_logit.astype(jnp.float32)) / GLA_TAU
        o = gla_chunk_causal(q.reshape(bsz, s, GLA_HEADS, GLA_DK),
                             k.reshape(bsz, s, GLA_HEADS, GLA_DK),
                             v.reshape(bsz, s, GLA_HEADS, GLA_DV), log_a)
        y_a = rms_norm(o, gla_norm_g[i]).reshape(bsz, s, d) * jax.nn.silu(og)
        y_b = gmlp_spatial_gate(jax.nn.gelu(u, approximate=False), jax.nn.gelu(z, approximate=False),
                                gmlp_ln_g[i], gmlp_ln_b[i], w_s[i], b_s[i])
        m = jax.nn.sigmoid(ga) * y_a + jax.nn.sigmoid(gb) * y_b
        h = layer_norm(ALPHA * h + m @ w_o[i], ln1_g[i], ln1_b[i])
        gt, up = jnp.split(h @ w_gu[i], 2, axis=-1)
        ffn = (jax.nn.silu(gt) * up) @ w_down[i]
        ple = jax.nn.sigmoid(h @ w_pg[i] + b_pg[i]) * (p[i] @ w_pu[i])
        h = layer_norm(ALPHA * h + ffn + ple, ln2_g[i], ln2_b[i])
    return h
```

```cpp
#include <hip/hip_runtime.h>
#include <hip/hip_cooperative_groups.h>
#include <cstdio>
#include <cstdint>
namespace cg = cooperative_groups;
namespace pg8 {
#define PG8_LAS __attribute__((address_space(3)))
typedef unsigned short bf16_t;
typedef short bf16x8 __attribute__((ext_vector_type(8)));
typedef float f32x4 __attribute__((ext_vector_type(4)));
typedef unsigned u32x4 __attribute__((ext_vector_type(4)));
constexpr int BM = 256, BK = 64, HALF = 128, HTB = HALF * BK * 2  , STAGE_BYTES = 8 * HTB, NXCD = 8, WGM = 8;

__host__ __device__ __forceinline__ int lds_byte(int r, int c) { const int st = (r >> 4) * 2 + (c >> 5), rr = r & 15, cc = c & 31, ob = rr * 64 + cc * 2; return st * 1024 + (ob ^ (((ob >> 9) & 1) << 5)); }
__host__ __device__ __forceinline__ void stage_rc(int b, int& R, int& C) { const int st = b / 1024, sb = b % 1024, swz = sb ^ (((sb >> 9) & 1) << 5); R = (st >> 1) * 16 + swz / 64; C = (st & 1) * 32 + (swz % 64) / 2; }
__host__ __device__ __forceinline__ int perm32(int rho) { const int n = rho >> 4, i = rho & 15; return 8 * (i >> 2) + 4 * n + (i & 3); }

struct Unit { int pm, pn; };
struct Gemm { const bf16_t* A; const bf16_t* Bt; int M, N, K; };

struct StaticOrder {
    int nM, nN, nwg, G, c;
    __host__ __device__ void init(int M, int N, int G_, int c_) { nM = M / BM; nN = N / BM; nwg = nM * nN; G = G_; c = c_; }
    __host__ __device__ bool next(int i, Unit& u) const {
        const long L = (long)i * G + c; if (L >= nwg) return false;
        int wgid = (int)L; { const int q = nwg / NXCD, r = nwg % NXCD, xcd = wgid % NXCD, off = wgid / NXCD; wgid = (xcd < r ? xcd * (q + 1) : r * (q + 1) + (xcd - r) * q) + off; }
        const int nig = WGM * nN, gid = wgid / nig, fm = gid * WGM, gsz = (nM - fm) < WGM ? (nM - fm) : WGM;
        u.pm = fm + ((wgid % nig) % gsz); u.pn = (wgid % nig) / gsz; return true;
    }
    __device__ __forceinline__ void a_ready(const Unit&) const {}
    __device__ __forceinline__ void done(const Unit&) const {}
};
__device__ __forceinline__ unsigned cvt_pk_bf16(float lo, float hi) { unsigned r; asm volatile("v_cvt_pk_bf16_f32 %0, %1, %2" : "=v"(r) : "v"(lo), "v"(hi)); return r; }
typedef float f32x2 __attribute__((ext_vector_type(2)));
__device__ __forceinline__ f32x2 gelu_pk(f32x2 v) {
    const f32x2 av = __builtin_elementwise_abs(v), d = av * 0.2316418882f + 1.0f;
    f32x2 t; t.x = __builtin_amdgcn_rcpf(d.x); t.y = __builtin_amdgcn_rcpf(d.y);
    f32x2 q = t * 0.5307027145f + (-0.7265760135f); q = q * t + 0.7107068705f; q = q * t + (-0.142248368f); q = q * t + 0.127414796f; q = q * t;
    const f32x2 s = (v * v) * (-0.72134752044f);
    f32x2 e; e.x = __builtin_amdgcn_exp2f(s.x); e.y = __builtin_amdgcn_exp2f(s.y);
    const f32x2 m = v * (q * e), r = v - m;
    f32x2 o; o.x = v.x < 0.f ? m.x : r.x; o.y = v.y < 0.f ? m.y : r.y; return o;
}

template <class Epi, class Sched, bool ALIGN_EPI = false, bool SP2 = false>
__device__ __forceinline__ void gemm_phase(PG8_LAS unsigned char* lds, const Gemm g, const Sched& S, const Epi& E) {
    const int tid = threadIdx.x, wid = __builtin_amdgcn_readfirstlane(tid >> 6), lane = tid & 63, wr = wid >> 2, wc = wid & 3, fr = lane & 15, fq = lane >> 4;
    const int K = g.K, nt = K / BK;
    unsigned voffA[2], voffB[2];
#pragma unroll
    for (int i = 0; i < 2; ++i) { int R, C; stage_rc(tid * 16 + i * 8192, R, C); const int Rb = Epi::PERM ? ((R & ~31) + perm32(R & 31)) : R;
        voffA[i] = (unsigned)(R * K + C) * 2u; voffB[i] = (unsigned)(Rb * K + C) * 2u; }
    const size_t kstep = (size_t)(BK * 2);
    const size_t hstep = (size_t)HALF * K * 2;
    const size_t tstep = 2 * hstep;
    const unsigned ldsw = (unsigned)wid * 1024u;
    const int aoff = lds_byte(wr * 64 + fr, fq * 8), boff = lds_byte(wc * 32 + fr, fq * 8);
#define PG8_SA(b, h) (((b) * 2 + (h)) * HTB)
#define PG8_SB(b, h) ((4 + (b) * 2 + (h)) * HTB)
#define PG8_STAGE(bufoff, gbase, voff) do { _Pragma("unroll") for (int _i = 0; _i < 2; ++_i) \
        __builtin_amdgcn_global_load_lds((const unsigned*)((const char*)(gbase) + (voff)[_i]), (PG8_LAS unsigned*)(lds + (bufoff) + ldsw + _i * 8192), 16, 0, 0); } while (0)
#define PG8_LDA(dst, b, h) do { _Pragma("unroll") for (int m = 0; m < 4; ++m) _Pragma("unroll") for (int k = 0; k < 2; ++k) dst[m][k] = *(const PG8_LAS bf16x8*)(lds + PG8_SA(b, h) + aoff + m * 2048 + k * 1024); } while (0)
#define PG8_LDB(dst, b, h) do { _Pragma("unroll") for (int n = 0; n < 2; ++n) _Pragma("unroll") for (int k = 0; k < 2; ++k) dst[n][k] = *(const PG8_LAS bf16x8*)(lds + PG8_SB(b, h) + boff + n * 2048 + k * 1024); } while (0)
#define PG8_MMA(ai, bj, At, Bt) do { __builtin_amdgcn_s_setprio(1); _Pragma("unroll") for (int m = 0; m < 4; ++m) _Pragma("unroll") for (int n = 0; n < 2; ++n) _Pragma("unroll") for (int k = 0; k < 2; ++k) \
        acc[ai][bj][m][n] = __builtin_amdgcn_mfma_f32_16x16x32_bf16(Bt[n][k], At[m][k], acc[ai][bj][m][n], 0, 0, 0); __builtin_amdgcn_s_setprio(0); } while (0)
#define PG8_WAIT_V(n) asm volatile("s_waitcnt vmcnt(" #n ")" ::: "memory")
#define PG8_WAIT_L(n) asm volatile("s_waitcnt lgkmcnt(" #n ")" ::: "memory")
#define PG8_BAR __builtin_amdgcn_s_barrier()
#define PG8_SCHED __builtin_amdgcn_sched_barrier(0)
    Unit cur, nxt; int ui = 0;
    if (!S.next(0, cur)) return;
    f32x4 acc[2][2][4][2];
#pragma unroll
    for (int a = 0; a < 2; ++a)
#pragma unroll
        for (int b = 0; b < 2; ++b)
#pragma unroll
            for (int m = 0; m < 4; ++m)
#pragma unroll
                for (int n = 0; n < 2; ++n) acc[a][b][m][n] = (f32x4){0.f, 0.f, 0.f, 0.f};
    bf16x8 At[4][2], B0[2][2], B1[2][2];
    const char* cA = (const char*)g.A + (size_t)cur.pm * tstep; const char* cB = (const char*)g.Bt + (size_t)cur.pn * tstep;
    S.a_ready(cur);
    if constexpr (SP2) {
        PG8_STAGE(PG8_SB(0, 0), cB, voffB); PG8_STAGE(PG8_SB(0, 1), cB + hstep, voffB); PG8_STAGE(PG8_SA(0, 0), cA, voffA); PG8_STAGE(PG8_SA(0, 1), cA + hstep, voffA);
        if (wr == 1) PG8_BAR;
        PG8_WAIT_V(2); PG8_BAR;
        PG8_STAGE(PG8_SB(1, 0), cB + kstep, voffB); PG8_STAGE(PG8_SA(1, 0), cA + kstep, voffA); PG8_STAGE(PG8_SB(1, 1), cB + hstep + kstep, voffB);
        PG8_WAIT_V(6); PG8_BAR;
    } else {
        PG8_STAGE(PG8_SB(0, 0), cB, voffB); PG8_STAGE(PG8_SA(0, 0), cA, voffA); PG8_STAGE(PG8_SB(0, 1), cB + hstep, voffB); PG8_STAGE(PG8_SA(0, 1), cA + hstep, voffA);
        if (wr == 1) PG8_BAR;
        PG8_WAIT_V(4); PG8_BAR;
        PG8_STAGE(PG8_SB(1, 0), cB + kstep, voffB); PG8_STAGE(PG8_SA(1, 0), cA + kstep, voffA); PG8_STAGE(PG8_SB(1, 1), cB + hstep + kstep, voffB);
        PG8_WAIT_V(6); PG8_BAR;
    }
    for (;;) {
        const bool has_next = S.next(ui + 1, nxt);
        const char* nA = has_next ? (const char*)g.A + (size_t)nxt.pm * tstep : cA; const char* nB = has_next ? (const char*)g.Bt + (size_t)nxt.pn * tstep : cB;
        for (int t = 0; t < nt; t += 2) {
            const bool last = (t == nt - 2);
            const char* a1 = cA + (size_t)(t + 1) * kstep;
            const char* a2 = last ? nA : cA + (size_t)(t + 2) * kstep; const char* b2 = last ? nB : cB + (size_t)(t + 2) * kstep;
            const char* a3 = a2 + kstep; const char* b3 = b2 + kstep;
            if (last && has_next) S.a_ready(nxt);
            if constexpr (Epi::HOOK_T > 0) { if (t == Epi::HOOK_T) E.hook(acc, cur, wr, wc, fr, fq); }
            if constexpr (SP2) {
            PG8_LDB(B0, 0, 0); PG8_LDB(B1, 0, 1); PG8_SCHED; PG8_LDA(At, 0, 0); PG8_STAGE(PG8_SA(1, 1), a1 + hstep, voffA);
            PG8_WAIT_V(8); PG8_WAIT_L(0); PG8_BAR; PG8_MMA(0, 0, At, B0); PG8_MMA(0, 1, At, B1); PG8_BAR; PG8_SCHED;
            PG8_LDA(At, 0, 1); PG8_STAGE(PG8_SB(0, 0), b2, voffB); PG8_STAGE(PG8_SB(0, 1), b2 + hstep, voffB); PG8_STAGE(PG8_SA(0, 0), a2, voffA);
            PG8_WAIT_V(8); PG8_WAIT_L(0); PG8_BAR; PG8_MMA(1, 0, At, B0); PG8_MMA(1, 1, At, B1); PG8_BAR; PG8_SCHED;
            PG8_LDB(B0, 1, 0); PG8_LDB(B1, 1, 1); PG8_SCHED; PG8_LDA(At, 1, 0); PG8_STAGE(PG8_SA(0, 1), a2 + hstep, voffA);
            PG8_WAIT_V(8); PG8_WAIT_L(0); PG8_BAR; PG8_MMA(0, 0, At, B0); PG8_MMA(0, 1, At, B1); PG8_BAR; PG8_SCHED;
            PG8_LDA(At, 1, 1); PG8_STAGE(PG8_SB(1, 0), b3, voffB); PG8_STAGE(PG8_SB(1, 1), b3 + hstep, voffB); PG8_STAGE(PG8_SA(1, 0), a3, voffA);
            PG8_WAIT_V(8); PG8_WAIT_L(0); PG8_BAR; PG8_MMA(1, 0, At, B0); PG8_MMA(1, 1, At, B1); PG8_BAR; PG8_SCHED;
            } else {
            PG8_LDB(B0, 0, 0); PG8_SCHED; PG8_LDA(At, 0, 0); PG8_STAGE(PG8_SA(1, 1), a1 + hstep, voffA);
            PG8_WAIT_L(8); PG8_BAR; PG8_WAIT_L(0); PG8_MMA(0, 0, At, B0); PG8_BAR; PG8_SCHED;
            PG8_LDB(B1, 0, 1); PG8_STAGE(PG8_SB(0, 0), b2, voffB);
            PG8_BAR; PG8_WAIT_L(0); PG8_MMA(0, 1, At, B1); PG8_BAR;
            PG8_LDA(At, 0, 1); PG8_STAGE(PG8_SA(0, 0), a2, voffA);
            PG8_BAR; PG8_WAIT_L(0); PG8_MMA(1, 0, At, B0); PG8_BAR; PG8_SCHED;
            PG8_STAGE(PG8_SB(0, 1), b2 + hstep, voffB);
            PG8_WAIT_V(6); PG8_BAR; PG8_MMA(1, 1, At, B1); PG8_BAR;
            PG8_LDB(B0, 1, 0); PG8_SCHED; PG8_LDA(At, 1, 0); PG8_STAGE(PG8_SA(0, 1), a2 + hstep, voffA);
            PG8_WAIT_L(8); PG8_BAR; PG8_WAIT_L(0); PG8_MMA(0, 0, At, B0); PG8_BAR; PG8_SCHED;
            PG8_LDB(B1, 1, 1); PG8_STAGE(PG8_SB(1, 0), b3, voffB);
            PG8_BAR; PG8_WAIT_L(0); PG8_MMA(0, 1, At, B1); PG8_BAR;
            PG8_LDA(At, 1, 1); PG8_STAGE(PG8_SA(1, 0), a3, voffA);
            PG8_BAR; PG8_WAIT_L(0); PG8_MMA(1, 0, At, B0); PG8_BAR; PG8_SCHED;
            PG8_STAGE(PG8_SB(1, 1), b3 + hstep, voffB);
            PG8_WAIT_V(6); PG8_BAR; PG8_MMA(1, 1, At, B1); PG8_BAR;
            }
        }
        if constexpr (ALIGN_EPI) { if (wr == 0) PG8_BAR; }
        if constexpr (!Epi::AFTER_DRAIN) { E(acc, cur, wr, wc, fr, fq); S.done(cur); }
        if (!has_next) break;
#pragma unroll
        for (int a = 0; a < 2; ++a)
#pragma unroll
            for (int b = 0; b < 2; ++b)
#pragma unroll
                for (int m = 0; m < 4; ++m)
#pragma unroll
                    for (int n = 0; n < 2; ++n) acc[a][b][m][n] = (f32x4){0.f, 0.f, 0.f, 0.f};
        cur = nxt; cA = nA; cB = nB; ++ui;
        if constexpr (ALIGN_EPI) { if (wr == 1) PG8_BAR; }
    }
    PG8_WAIT_V(0);
    if constexpr (!ALIGN_EPI) { if (wr == 0) PG8_BAR; }
    PG8_BAR;
    if constexpr (Epi::AFTER_DRAIN) { E.fused(acc, cur, wr, wc, fr, fq, lds, wid, lane); S.done(cur); }
#undef PG8_SA
#undef PG8_SB
#undef PG8_STAGE
#undef PG8_LDA
#undef PG8_LDB
#undef PG8_MMA
#undef PG8_WAIT_V
#undef PG8_WAIT_L
#undef PG8_BAR
#undef PG8_SCHED
}
}

#define LAS __attribute__((address_space(3)))
typedef unsigned short bf16_t;
typedef short bf16x8 __attribute__((ext_vector_type(8)));
typedef float f32x4 __attribute__((ext_vector_type(4)));
typedef unsigned u32x4 __attribute__((ext_vector_type(4)));
typedef unsigned u32x2 __attribute__((ext_vector_type(2)));

constexpr int KX = 5888  , MTOK = 32768, DM = 2048, NCHUNK = 512  , DFF = 5632, N1 = 14592, NGU = 13312;
constexpr float ALPHA = 1.189207115002721f, LN_EPS = 1e-5f;
constexpr size_t MiB = 1u << 20;
constexpr size_t OFF_W1T = 0, OFF_WOT = 57 * MiB, OFF_H0 = 65 * MiB, OFF_Q = 193 * MiB, OFF_K = 257 * MiB, OFF_V = 321 * MiB, OFF_OG = 449 * MiB,
                 OFF_U = 577 * MiB, OFF_Z = 705 * MiB, OFF_GA = 833 * MiB, OFF_FG = 961 * MiB, OFF_CTL = 969 * MiB, WS_NEED = 970 * MiB;
constexpr size_t OFF_H1PRE = OFF_V, OFF_H1 = OFF_Z, OFF_ACT = OFF_Q  , OFF_GPG = OFF_GA, OFF_OUTPRE = 0;
constexpr size_t DO_GB = 0, DO_PLEB = 0, DO_DEC = 128 * MiB, DO_WGUT = 130 * MiB, DO_WDT = 182 * MiB, DO_WPUT = 204 * MiB, DO_PB = 205 * MiB;
constexpr int LDS_BYTES = 153600, LDS_BARW = 153536;

struct Args {
    const float *x, *p, *ln0_g, *ln0_b, *w_in, *b_in, *w_f2, *b_f2, *gla_g, *gm_g, *gm_b, *w_s, *b_s, *w_o, *ln1_g, *ln1_b, *w_gu, *w_down, *w_pg, *b_pg, *w_pu, *ln2_g, *ln2_b;
    unsigned char* out; unsigned char* ws; int ph_lo, ph_hi, coop, pad;
};

typedef float f32x2_t __attribute__((ext_vector_type(2))); typedef __bf16 bf16x2_t __attribute__((ext_vector_type(2)));
__device__ __forceinline__ unsigned cvtpk_s(float lo, float hi) { f32x2_t v = {lo, hi}; bf16x2_t b = __builtin_convertvector(v, bf16x2_t); return __builtin_bit_cast(unsigned, b); }
__device__ __forceinline__ float bflo(unsigned w) { return __uint_as_float(w << 16); }
__device__ __forceinline__ float bfhi(unsigned w) { return __uint_as_float(w & 0xffff0000u); }
__device__ __forceinline__ float sigm(float x) { return __builtin_amdgcn_rcpf(1.f + __expf(-x)); }
__device__ __forceinline__ float wave_sum(float v) {
#pragma unroll
    for (int o = 1; o < 64; o <<= 1) v += __shfl_xor(v, o);
    return v;
}
#define LDS_WAIT() asm volatile("s_waitcnt lgkmcnt(0)" ::: "memory")

using pg8::Unit;
using pg8::gelu_pk;
typedef float f32x2 __attribute__((ext_vector_type(2)));

__device__ __forceinline__ void act8(f32x4& v0, f32x4& v1, int mode) {
    if (mode == 0) { v0 = v0 * 0.0625f; v1 = v1 * 0.0625f; }
    else if (mode == 2) {
#pragma unroll
        for (int j = 0; j < 4; ++j) { v0[j] = v0[j] * sigm(v0[j]); v1[j] = v1[j] * sigm(v1[j]); } }
    else if (mode == 3) { f32x2 a = gelu_pk((f32x2){v0[0], v0[1]}), b = gelu_pk((f32x2){v0[2], v0[3]}), c = gelu_pk((f32x2){v1[0], v1[1]}), d = gelu_pk((f32x2){v1[2], v1[3]});
        v0 = (f32x4){a.x, a.y, b.x, b.y}; v1 = (f32x4){c.x, c.y, d.x, d.y}; }
    else if (mode == 4) {
#pragma unroll
        for (int j = 0; j < 4; ++j) { v0[j] = sigm(v0[j]); v1[j] = sigm(v1[j]); } }
}

struct Epi1 {
    static constexpr bool PERM = true, AFTER_DRAIN = false; static constexpr int HOOK_T = 0;
    unsigned char* ws; unsigned char* dout; const float* b_in;
    __device__ __forceinline__ void operator()(const f32x4 (&acc)[2][2][4][2], const Unit& u, int wr, int wc, int fr, int fq) const {
        const int pn = u.pn; const int row0 = u.pm * 256 + wr * 64 + fr;
        if (pn == 56) {
            if (wc < 2) {
                float* FG = (float*)(ws + OFF_FG); const int c0 = wc * 32 + 8 * fq;
                const f32x4 b0 = *(const f32x4*)(b_in + 6144 + c0), b1 = *(const f32x4*)(b_in + 6144 + c0 + 4);
#pragma unroll
                for (int ai = 0; ai < 2; ++ai)
#pragma unroll
                    for (int m = 0; m < 4; ++m) { float* rp = FG + (size_t)(row0 + ai * 128 + m * 16) * 64 + c0;
                        *(f32x4*)rp = acc[ai][0][m][0] + b0; *(f32x4*)(rp + 4) = acc[ai][0][m][1] + b1; }
            }
            return;
        }
        const int cw = wc * 32 + 8 * fq;
        if (pn >= 16 && pn < 48) {
            const bool first = pn < 32; const int t = first ? pn - 16 : pn - 32;
            const float* bA = b_in + (first ? 4096 : 6208) + 128 * t + cw; const float* bB = b_in + (first ? 10304 : 12352) + 128 * t + cw;
            const f32x4 a0 = *(const f32x4*)bA, a1 = *(const f32x4*)(bA + 4), g0 = *(const f32x4*)bB, g1 = *(const f32x4*)(bB + 4);
            bf16_t* rowp0 = (bf16_t*)(ws + (first ? OFF_OG : OFF_U)) + (size_t)row0 * 2048 + 128 * t + cw;
            if (first) pair_body<2>(acc, a0, a1, g0, g1, rowp0); else pair_body<3>(acc, a0, a1, g0, g1, rowp0);
            return;
        }
        int mode, ldc, colt, bsrc; bf16_t* base;
        if (pn < 4) { mode = 0; base = (bf16_t*)(ws + OFF_Q); ldc = 1024; colt = pn * 256; bsrc = pn * 256; }
        else if (pn < 8) { mode = 1; base = (bf16_t*)(ws + OFF_K); ldc = 1024; colt = (pn - 4) * 256; bsrc = pn * 256; }
        else if (pn < 16) { mode = 1; base = (bf16_t*)(ws + OFF_V); ldc = 2048; colt = (pn - 8) * 256; bsrc = pn * 256; }
        else { mode = 3; base = (bf16_t*)(ws + OFF_Z); ldc = 2048; colt = (pn - 48) * 256; bsrc = 8256 + (pn - 48) * 256; }
        f32x4 bv[2][2];
#pragma unroll
        for (int bj = 0; bj < 2; ++bj)
#pragma unroll
            for (int n = 0; n < 2; ++n) bv[bj][n] = *(const f32x4*)(b_in + bsrc + bj * 128 + (mode == 0 ? wc * 32 + 4 * fq + 16 * n : cw + 4 * n));
        bf16_t* rowp0 = base + (size_t)row0 * ldc + colt + cw;
        switch (mode) {
            case 0: body<0>(acc, bv, rowp0, ldc); break;
            case 1: body<1>(acc, bv, rowp0, ldc); break;
            default: body<3>(acc, bv, rowp0, ldc); break;
        }
    }
    template <int MODE> __device__ __forceinline__ void body(const f32x4 (&acc)[2][2][4][2], const f32x4 (&bv)[2][2], bf16_t* rowp0, int ldc) const {
#pragma unroll
        for (int ai = 0; ai < 2; ++ai)
#pragma unroll
            for (int m = 0; m < 4; ++m) { bf16_t* rowp = rowp0 + (size_t)(ai * 128 + m * 16) * ldc;
#pragma unroll
                for (int bj = 0; bj < 2; ++bj) { f32x4 v0 = acc[ai][bj][m][0] + bv[bj][0], v1 = acc[ai][bj][m][1] + bv[bj][1];
                    act8(v0, v1, MODE);
                    u32x4 w; w.x = cvtpk_s(v0[0], v0[1]); w.y = cvtpk_s(v0[2], v0[3]); w.z = cvtpk_s(v1[0], v1[1]); w.w = cvtpk_s(v1[2], v1[3]);
                    *(u32x4*)(rowp + bj * 128) = w; } }
    }
    template <int MODE> __device__ __forceinline__ void pair_body(const f32x4 (&acc)[2][2][4][2], const f32x4 a0, const f32x4 a1, const f32x4 g0, const f32x4 g1, bf16_t* rowp0) const {
#pragma unroll
        for (int ai = 0; ai < 2; ++ai)
#pragma unroll
            for (int m = 0; m < 4; ++m) { f32x4 v0 = acc[ai][0][m][0] + a0, v1 = acc[ai][0][m][1] + a1, s0 = acc[ai][1][m][0] + g0, s1 = acc[ai][1][m][1] + g1;
                act8(v0, v1, MODE); act8(s0, s1, 4);
                v0 = v0 * s0; v1 = v1 * s1;
                u32x4 w; w.x = cvtpk_s(v0[0], v0[1]); w.y = cvtpk_s(v0[2], v0[3]); w.z = cvtpk_s(v1[0], v1[1]); w.w = cvtpk_s(v1[2], v1[3]);
                *(u32x4*)(rowp0 + (size_t)(ai * 128 + m * 16) * 2048) = w; }
    }
};

template <bool HAS_P> struct EpiRes {
    static constexpr bool PERM = true, AFTER_DRAIN = false; static constexpr int HOOK_T = 0;
    bf16_t* out; const bf16_t* R; const bf16_t* P;
    __device__ __forceinline__ void operator()(const f32x4 (&acc)[2][2][4][2], const Unit& u, int wr, int wc, int fr, int fq) const {
        const int row0 = u.pm * 256 + wr * 64 + fr, col0 = u.pn * 256 + wc * 32 + 8 * fq;
#pragma unroll
        for (int ai = 0; ai < 2; ++ai)
#pragma unroll
            for (int mh = 0; mh < 2; ++mh) {
                u32x4 rr[2][2], qq[2][2];
#pragma unroll
                for (int m2 = 0; m2 < 2; ++m2)
#pragma unroll
                    for (int bj = 0; bj < 2; ++bj) { const size_t off = (size_t)(row0 + ai * 128 + (2 * mh + m2) * 16) * DM + col0 + bj * 128;
                        rr[m2][bj] = *(const u32x4*)(R + off); if (HAS_P) qq[m2][bj] = *(const u32x4*)(P + off); }
#pragma unroll
                for (int m2 = 0; m2 < 2; ++m2)
#pragma unroll
                    for (int bj = 0; bj < 2; ++bj) { const int m = 2 * mh + m2; const size_t off = (size_t)(row0 + ai * 128 + m * 16) * DM + col0 + bj * 128; const u32x4 r = rr[m2][bj];
                        f32x4 v0 = acc[ai][bj][m][0], v1 = acc[ai][bj][m][1];
                        v0 += (f32x4){bflo(r.x), bfhi(r.x), bflo(r.y), bfhi(r.y)} * ALPHA; v1 += (f32x4){bflo(r.z), bfhi(r.z), bflo(r.w), bfhi(r.w)} * ALPHA;
                        if (HAS_P) { const u32x4 q = qq[m2][bj];
                            v0 += (f32x4){bflo(q.x), bfhi(q.x), bflo(q.y), bfhi(q.y)}; v1 += (f32x4){bflo(q.z), bfhi(q.z), bflo(q.w), bfhi(q.w)}; }
                        u32x4 w; w.x = cvtpk_s(v0[0], v0[1]); w.y = cvtpk_s(v0[2], v0[3]); w.z = cvtpk_s(v1[0], v1[1]); w.w = cvtpk_s(v1[2], v1[3]);
                        *(u32x4*)(out + off) = w; }
                asm volatile("" ::: "memory");
            }
    }
};

struct EpiDown {
    static constexpr bool PERM = true, AFTER_DRAIN = false; static constexpr int HOOK_T = 4;
    bf16_t* out; const bf16_t* R; const bf16_t* G;
    __device__ __forceinline__ void hook(f32x4 (&acc)[2][2][4][2], const Unit& u, int wr, int wc, int fr, int fq) const {
        unsigned zoff; asm volatile("v_mov_b32 %0, 0" : "=v"(zoff));
        const bf16_t* gp = G + (size_t)(u.pm * 256 + wr * 64 + fr) * DM + u.pn * 256 + wc * 32 + 8 * fq + zoff;
#pragma unroll
        for (int ai = 0; ai < 2; ++ai)
#pragma unroll
            for (int mh = 0; mh < 2; ++mh) {
                u32x4 rr[2][2];
#pragma unroll
                for (int m2 = 0; m2 < 2; ++m2)
#pragma unroll
                    for (int bj = 0; bj < 2; ++bj) rr[m2][bj] = *(const u32x4*)(gp + (size_t)(ai * 128 + (2 * mh + m2) * 16) * DM + bj * 128);
#pragma unroll
                for (int m2 = 0; m2 < 2; ++m2)
#pragma unroll
                    for (int bj = 0; bj < 2; ++bj) { const u32x4 r = rr[m2][bj]; const int m = 2 * mh + m2;
                        acc[ai][bj][m][0] *= (f32x4){bflo(r.x), bfhi(r.x), bflo(r.y), bfhi(r.y)}; acc[ai][bj][m][1] *= (f32x4){bflo(r.z), bfhi(r.z), bflo(r.w), bfhi(r.w)}; }
                asm volatile("" ::: "memory");
            }
    }
    __device__ __forceinline__ void operator()(const f32x4 (&acc)[2][2][4][2], const Unit& u, int wr, int wc, int fr, int fq) const {
        const int row0 = u.pm * 256 + wr * 64 + fr, col0 = u.pn * 256 + wc * 32 + 8 * fq;
#pragma unroll
        for (int ai = 0; ai < 2; ++ai)
#pragma unroll
            for (int m = 0; m < 4; ++m)
#pragma unroll
                for (int bj = 0; bj < 2; ++bj) { const size_t off = (size_t)(row0 + ai * 128 + m * 16) * DM + col0 + bj * 128; const u32x4 r = *(const u32x4*)(R + off);
                    f32x4 v0 = acc[ai][bj][m][0], v1 = acc[ai][bj][m][1];
                    v0 += (f32x4){bflo(r.x), bfhi(r.x), bflo(r.y), bfhi(r.y)} * ALPHA; v1 += (f32x4){bflo(r.z), bfhi(r.z), bflo(r.w), bfhi(r.w)} * ALPHA;
                    u32x4 w; w.x = cvtpk_s(v0[0], v0[1]); w.y = cvtpk_s(v0[2], v0[3]); w.z = cvtpk_s(v1[0], v1[1]); w.w = cvtpk_s(v1[2], v1[3]);
                    *(u32x4*)(out + off) = w; }
    }
};

struct Epi5 {
    static constexpr bool PERM = true, AFTER_DRAIN = false; static constexpr int HOOK_T = 0;
    bf16_t* ACT; bf16_t* GPG; const float* b_pg;
    __device__ __forceinline__ void operator()(const f32x4 (&acc)[2][2][4][2], const Unit& u, int wr, int wc, int fr, int fq) const {
        const int pn = u.pn; const int row0 = u.pm * 256 + wr * 64 + fr, cw = wc * 32 + 8 * fq;
        if (pn < 44) {
#pragma unroll
            for (int ai = 0; ai < 2; ++ai)
#pragma unroll
                for (int m = 0; m < 4; ++m) { bf16_t* rowp = ACT + (size_t)(row0 + ai * 128 + m * 16) * KX + 256 + pn * 128 + cw;
                    f32x4 g0 = acc[ai][0][m][0], g1 = acc[ai][0][m][1]; const f32x4 u0 = acc[ai][1][m][0], u1 = acc[ai][1][m][1];
#pragma unroll
                    for (int j = 0; j < 4; ++j) { g0[j] = g0[j] * sigm(g0[j]) * u0[j]; g1[j] = g1[j] * sigm(g1[j]) * u1[j]; }
                    u32x4 w; w.x = cvtpk_s(g0[0], g0[1]); w.y = cvtpk_s(g0[2], g0[3]); w.z = cvtpk_s(g1[0], g1[1]); w.w = cvtpk_s(g1[2], g1[3]);
                    *(u32x4*)rowp = w; }
        } else {
            const int colt = (pn - 44) * 256;
            f32x4 bv[2][2];
#pragma unroll
            for (int bj = 0; bj < 2; ++bj)
#pragma unroll
                for (int n = 0; n < 2; ++n) bv[bj][n] = *(const f32x4*)(b_pg + colt + bj * 128 + cw + 4 * n);
#pragma unroll
            for (int ai = 0; ai < 2; ++ai)
#pragma unroll
                for (int m = 0; m < 4; ++m) { bf16_t* rowp = GPG + (size_t)(row0 + ai * 128 + m * 16) * DM + colt + cw;
#pragma unroll
                    for (int bj = 0; bj < 2; ++bj) { f32x4 v0 = acc[ai][bj][m][0] + bv[bj][0], v1 = acc[ai][bj][m][1] + bv[bj][1];
                        act8(v0, v1, 4);
                        u32x4 w; w.x = cvtpk_s(v0[0], v0[1]); w.y = cvtpk_s(v0[2], v0[3]); w.z = cvtpk_s(v1[0], v1[1]); w.w = cvtpk_s(v1[2], v1[3]);
                        *(u32x4*)(rowp + bj * 128) = w; } }
        }
    }
};

struct EpiPle {
    static constexpr bool PERM = true, AFTER_DRAIN = false; static constexpr int HOOK_T = 0;
    bf16_t* O; const bf16_t* G;
    __device__ __forceinline__ void operator()(const f32x4 (&acc)[2][2][4][2], const Unit& u, int wr, int wc, int fr, int fq) const {
        const int row0 = u.pm * 256 + wr * 64 + fr, col0 = u.pn * 256 + wc * 32 + 8 * fq;
#pragma unroll
        for (int ai = 0; ai < 2; ++ai) {
            u32x4 rr[4][2];
#pragma unroll
            for (int m = 0; m < 4; ++m)
#pragma unroll
                for (int bj = 0; bj < 2; ++bj) rr[m][bj] = *(const u32x4*)(G + (size_t)(row0 + ai * 128 + m * 16) * DM + col0 + bj * 128);
#pragma unroll
            for (int m = 0; m < 4; ++m)
#pragma unroll
                for (int bj = 0; bj < 2; ++bj) { const size_t off = (size_t)(row0 + ai * 128 + m * 16) * DM + col0 + bj * 128; const u32x4 r = rr[m][bj];
                    const f32x4 v0 = acc[ai][bj][m][0] * (f32x4){bflo(r.x), bfhi(r.x), bflo(r.y), bfhi(r.y)}, v1 = acc[ai][bj][m][1] * (f32x4){bflo(r.z), bfhi(r.z), bflo(r.w), bfhi(r.w)};
                    u32x4 w; w.x = cvtpk_s(v0[0], v0[1]); w.y = cvtpk_s(v0[2], v0[3]); w.z = cvtpk_s(v1[0], v1[1]); w.w = cvtpk_s(v1[2], v1[3]);
                    *(u32x4*)(O + off) = w; }
            asm volatile("" ::: "memory");
        }
    }
};

__device__ __forceinline__ int dkmap32(int pos) { const int qq = pos >> 3, jj = pos & 7; return jj < 4 ? 4 * qq + jj : 16 + 4 * qq + (jj - 4); }
__device__ __forceinline__ void tr_item(const float* W, int ldw, int srccol0, int k0, bf16_t* WT, int ldt, int dstrow0, LAS float* scr, int lane, bool zero, int dk0 = 0, bool qperm = false) {
    if (!zero) {
        f32x4 tv[8];
#pragma unroll
        for (int i = 0; i < 8; ++i) tv[i] = *(const f32x4*)(W + (size_t)(k0 + 8 * i + (lane >> 3)) * ldw + srccol0 + 4 * (lane & 7));
#pragma unroll
        for (int i = 0; i < 8; ++i) { LAS float* d = scr + (8 * i + (lane >> 3)) * 33 + 4 * (lane & 7); d[0] = tv[i][0]; d[1] = tv[i][1]; d[2] = tv[i][2]; d[3] = tv[i][3]; }
    }
    LDS_WAIT();
    const int c = lane & 7;
#pragma unroll
    for (int j = 0; j < 4; ++j) { const int n = (lane >> 3) + 8 * j; const LAS float* s = scr + (8 * c) * 33 + (qperm ? dkmap32(n) : n);
        u32x4 o; o.x = cvtpk_s(s[0 * 33], s[1 * 33]); o.y = cvtpk_s(s[2 * 33], s[3 * 33]); o.z = cvtpk_s(s[4 * 33], s[5 * 33]); o.w = cvtpk_s(s[6 * 33], s[7 * 33]);
        if (zero) o = (u32x4){0u, 0u, 0u, 0u};
        *(u32x4*)(WT + (size_t)(dstrow0 + n) * ldt + dk0 + k0 + 8 * c) = o; }
    LDS_WAIT();
}
template <bool OUT_BF16> __device__ __forceinline__ void ln_row(const float* in, void* outp, const float* g, const float* b, int lane) {
    const f32x4* xr = (const f32x4*)in + lane;
    f32x4 v[8]; float s = 0.f;
#pragma unroll
    for (int j = 0; j < 8; ++j) { v[j] = xr[64 * j]; s += (v[j][0] + v[j][1]) + (v[j][2] + v[j][3]); }
    const float mean = wave_sum(s) * (1.f / DM); float s2 = 0.f;
#pragma unroll
    for (int j = 0; j < 8; ++j) { v[j] = v[j] - mean; s2 += (v[j][0] * v[j][0] + v[j][1] * v[j][1]) + (v[j][2] * v[j][2] + v[j][3] * v[j][3]); }
    const float rstd = 1.f / sqrtf(wave_sum(s2) * (1.f / DM) + LN_EPS);
#pragma unroll
    for (int j = 0; j < 8; ++j) { const f32x4 gg = ((const f32x4*)g)[64 * j + lane], bb = ((const f32x4*)b)[64 * j + lane]; const f32x4 o = v[j] * rstd * gg + bb;
        if (OUT_BF16) { u32x2 w; w.x = cvtpk_s(o[0], o[1]); w.y = cvtpk_s(o[2], o[3]); ((u32x2*)outp)[64 * j + lane] = w; }
        else ((f32x4*)outp)[64 * j + lane] = o; }
}
template <bool OUT_BF16, bool IN_BF16 = false> __device__ __forceinline__ void ln_row2(const void* in0, const void* in1, void* out0, void* out1, const float* g, const float* b, int lane) {
    f32x4 v[8], w[8]; float s = 0.f, t = 0.f;
    if (IN_BF16) { const u32x2* x0 = (const u32x2*)in0 + lane; const u32x2* x1 = (const u32x2*)in1 + lane; u32x2 a0[8], a1[8];
#pragma unroll
        for (int j = 0; j < 8; ++j) { a0[j] = x0[64 * j]; a1[j] = x1[64 * j]; }
#pragma unroll
        for (int j = 0; j < 8; ++j) { v[j] = (f32x4){bflo(a0[j].x), bfhi(a0[j].x), bflo(a0[j].y), bfhi(a0[j].y)}; w[j] = (f32x4){bflo(a1[j].x), bfhi(a1[j].x), bflo(a1[j].y), bfhi(a1[j].y)}; }
    } else { const f32x4* x0 = (const f32x4*)in0 + lane; const f32x4* x1 = (const f32x4*)in1 + lane;
#pragma unroll
        for (int j = 0; j < 8; ++j) { v[j] = x0[64 * j]; w[j] = x1[64 * j]; } }
#pragma unroll
    for (int j = 0; j < 8; ++j) { s += (v[j][0] + v[j][1]) + (v[j][2] + v[j][3]); t += (w[j][0] + w[j][1]) + (w[j][2] + w[j][3]); }
#pragma unroll
    for (int o = 1; o < 64; o <<= 1) { s += __shfl_xor(s, o); t += __shfl_xor(t, o); }
    const float m0 = s * (1.f / DM), m1 = t * (1.f / DM); float s2 = 0.f, t2 = 0.f;
#pragma unroll
    for (int j = 0; j < 8; ++j) { v[j] = v[j] - m0; w[j] = w[j] - m1; s2 += (v[j][0] * v[j][0] + v[j][1] * v[j][1]) + (v[j][2] * v[j][2] + v[j][3] * v[j][3]); t2 += (w[j][0] * w[j][0] + w[j][1] * w[j][1]) + (w[j][2] * w[j][2] + w[j][3] * w[j][3]); }
#pragma unroll
    for (int o = 1; o < 64; o <<= 1) { s2 += __shfl_xor(s2, o); t2 += __shfl_xor(t2, o); }
    const float r0 = 1.f / sqrtf(s2 * (1.f / DM) + LN_EPS), r1 = 1.f / sqrtf(t2 * (1.f / DM) + LN_EPS);
#pragma unroll
    for (int j = 0; j < 8; ++j) { const f32x4 gg = ((const f32x4*)g)[64 * j + lane], bb = ((const f32x4*)b)[64 * j + lane]; const f32x4 o0 = v[j] * r0 * gg + bb, o1 = w[j] * r1 * gg + bb;
        if (OUT_BF16) { u32x2 p; p.x = cvtpk_s(o0[0], o0[1]); p.y = cvtpk_s(o0[2], o0[3]); ((u32x2*)out0)[64 * j + lane] = p; p.x = cvtpk_s(o1[0], o1[1]); p.y = cvtpk_s(o1[2], o1[3]); ((u32x2*)out1)[64 * j + lane] = p; }
        else { ((f32x4*)out0)[64 * j + lane] = o0; ((f32x4*)out1)[64 * j + lane] = o1; } }
}

__device__ __forceinline__ void phase_prep(const Args& a, LAS unsigned char* lds, int gw, int ngw, int wave, int lane) {
    LAS float* scr = (LAS float*)(lds + wave * 8448);
    bf16_t* W1T = (bf16_t*)(a.ws + OFF_W1T); bf16_t* WOT = (bf16_t*)(a.ws + OFF_WOT);
    constexpr int I1 = 32 * (N1 / 32), IO = 32 * 64;
    for (int it = gw; it < I1 + IO; it += ngw) {
        if (it < I1) { const int kb = it / (N1 / 32), nb = it % (N1 / 32), n0 = nb * 32;
            const bool zero = n0 >= 14400; int src;
            if (n0 < 4096) src = n0;
            else if (n0 < 8192) { const int t = (n0 - 4096) >> 8, wi = n0 & 255; src = wi < 128 ? 4096 + 128 * t + wi : 10304 + 128 * t + (wi - 128); }
            else if (n0 < 12288) { const int t = (n0 - 8192) >> 8, wi = n0 & 255; src = wi < 128 ? 6208 + 128 * t + wi : 12352 + 128 * t + (wi - 128); }
            else if (n0 < 14336) src = 8256 + (n0 - 12288);
            else src = 6144 + (n0 - 14336);
            tr_item(a.w_in, 14400, zero ? 0 : src, kb * 64, W1T, 2048, n0, scr, lane, zero, 0, n0 < 1024); }
        else { const int r = it - I1, kb = r / 64, nb = r % 64; tr_item(a.w_o, 2048, nb * 32, kb * 64, WOT, 2048, nb * 32, scr, lane, false); }
    }
    bf16_t* H0 = (bf16_t*)(a.ws + OFF_H0);
    for (int m = gw; m < MTOK; m += 2 * ngw) ln_row2<true>(a.x + (size_t)m * DM, a.x + (size_t)(m + ngw) * DM, H0 + (size_t)m * DM, H0 + (size_t)(m + ngw) * DM, a.ln0_g, a.ln0_b, lane);
}
__device__ __forceinline__ void phase_prep2(const Args& a, LAS unsigned char* lds, int gw, int ngw, int wave, int lane) {
    LAS float* scr = (LAS float*)(lds + wave * 8448);
    bf16_t* WGUT = (bf16_t*)(a.out + DO_WGUT); bf16_t* WDT = (bf16_t*)(a.out + DO_WDT);
    constexpr int IG = 32 * (NGU / 32), ID = 88 * 64, IP = 4 * 64;
    for (int it = gw; it < IG + ID + IP; it += ngw) {
        if (it < IG) { const int kb = it / (NGU / 32), nb = it % (NGU / 32), n0 = nb * 32, t = n0 >> 8, wi = n0 & 255;
            if (t < 44) tr_item(a.w_gu, 2 * DFF, wi < 128 ? t * 128 + wi : DFF + t * 128 + (wi - 128), kb * 64, WGUT, 2048, n0, scr, lane, false);
            else tr_item(a.w_pg, 2048, (t - 44) * 256 + wi, kb * 64, WGUT, 2048, n0, scr, lane, false); }
        else if (it < IG + ID) { const int r = it - IG, kb = r / 64, nb = r % 64; tr_item(a.w_down, 2048, nb * 32, kb * 64, WDT, KX, nb * 32, scr, lane, false, 256); }
        else { const int r = it - IG - ID, kb = r / 64, nb = r % 64; tr_item(a.w_pu, 2048, nb * 32, kb * 64, WDT, KX, nb * 32, scr, lane, false, 0); }
    }
}
__device__ __forceinline__ void phase_pconv(const Args& a, int gw, int ngw, int lane) {
    bf16_t* ACT = (bf16_t*)(a.ws + OFF_ACT);
    for (int i = gw * 64 + lane; i < MTOK * 64; i += ngw * 64) { const int m = i >> 6, c4 = (i & 63) * 4; const f32x4 v = *(const f32x4*)(a.p + (size_t)m * 256 + c4);
        u32x2 w; w.x = cvtpk_s(v[0], v[1]); w.y = cvtpk_s(v[2], v[3]); *(u32x2*)(ACT + (size_t)m * KX + c4) = w; }
}

__device__ __forceinline__ void phase_kt(const Args& a, LAS unsigned char* lds, int tid) {
    LAS float* fgs = (LAS float*)(lds + 131072);
    bf16_t* Kb = (bf16_t*)(a.ws + OFF_K); const float* FG = (const float*)(a.ws + OFF_FG); float* DEC = (float*)(a.out + DO_DEC);
    const int col2 = 2 * tid, h = col2 >> 8, d = col2 & 255;
    float w0[16], w1[16];
#pragma unroll
    for (int r = 0; r < 16; ++r) { const float2 t = *(const float2*)(a.w_f2 + (h * 16 + r) * 256 + d); w0[r] = t.x; w1[r] = t.y; }
    const float2 bb = *(const float2*)(a.b_f2 + h * 256 + d);
    for (int it = blockIdx.x; it < NCHUNK; it += gridDim.x) {
        const size_t row0 = (size_t)it * 64;
        __syncthreads();
#pragma unroll
        for (int i = 0; i < 2; ++i) { const int p = tid + 512 * i; ((LAS f32x4*)fgs)[p] = ((const f32x4*)(FG + row0 * 64))[p]; }
        __syncthreads();
        float run0 = 0.f, run1 = 0.f;
        unsigned kwc[8], kwn[8];
#pragma unroll
        for (int tt = 0; tt < 8; ++tt) { kwc[tt] = *(const unsigned*)(Kb + (row0 + 56 + tt) * 1024 + col2); kwn[tt] = 0u; }
        for (int tg = 7; tg >= 0; --tg) {
            if (tg > 0) {
#pragma unroll
                for (int tt = 0; tt < 8; ++tt) kwn[tt] = *(const unsigned*)(Kb + (row0 + (tg - 1) * 8 + tt) * 1024 + col2); }
            float v0[8], v1[8];
#pragma unroll
            for (int tt = 7; tt >= 0; --tt) { const int t = tg * 8 + tt;
                const LAS f32x4* fp = (const LAS f32x4*)(fgs + t * 64 + h * 16);
                float f0 = bb.x, f1 = bb.y;
#pragma unroll
                for (int r4 = 0; r4 < 4; ++r4) { const f32x4 fv = fp[r4];
#pragma unroll
                    for (int j = 0; j < 4; ++j) { f0 += fv[j] * w0[r4 * 4 + j]; f1 += fv[j] * w1[r4 * 4 + j]; } }
                const float la0 = (fminf(f0, 0.f) - __logf(1.f + __expf(-fabsf(f0)))) * 0.0625f, la1 = (fminf(f1, 0.f) - __logf(1.f + __expf(-fabsf(f1)))) * 0.0625f;
                const unsigned kw = kwc[tt];
                v0[tt] = bflo(kw) * __expf(run0); v1[tt] = bfhi(kw) * __expf(run1);
                run0 += la0; run1 += la1; }
            u32x4 p0, p1;
            p0.x = cvtpk_s(v0[0], v0[1]); p0.y = cvtpk_s(v0[2], v0[3]); p0.z = cvtpk_s(v0[4], v0[5]); p0.w = cvtpk_s(v0[6], v0[7]);
            p1.x = cvtpk_s(v1[0], v1[1]); p1.y = cvtpk_s(v1[2], v1[3]); p1.z = cvtpk_s(v1[4], v1[5]); p1.w = cvtpk_s(v1[6], v1[7]);
            *(LAS u32x4*)(lds + col2 * 128 + ((tg ^ (col2 & 7)) << 4)) = p0;
            *(LAS u32x4*)(lds + (col2 + 1) * 128 + ((tg ^ ((col2 + 1) & 7)) << 4)) = p1;
#pragma unroll
            for (int tt = 0; tt < 8; ++tt) kwc[tt] = kwn[tt];
        }
        *(float2*)(DEC + (size_t)it * 1024 + col2) = make_float2(__expf(run0), __expf(run1));
        __syncthreads();
#pragma unroll
        for (int i = 0; i < 16; ++i) { const int p = tid + 512 * i, c = p >> 3, s = p & 7;
            *(u32x4*)(Kb + (size_t)it * 65536 + c * 64 + s * 8) = *(const LAS u32x4*)(lds + c * 128 + ((s ^ (c & 7)) << 4)); }
    }
    __syncthreads();
}

__device__ __forceinline__ void phase_scan(const Args& a, LAS unsigned char* lds, int tid, int wave, int lane) {
    const int bx = blockIdx.x, xcd = bx & 7, jj = bx >> 3, bh = xcd * 2 + (jj >> 3), b = bh >> 2, h = bh & 3, dvb = jj & 7, l15 = lane & 15, q = lane >> 4;
    constexpr int KTB = 0, QB = 65536, VB = 131072, DB = 147456;
    const bf16_t* KT = (const bf16_t*)(a.ws + OFF_K) + (size_t)(b * 128) * 65536 + h * 16384;
    const bf16_t* Qg = (const bf16_t*)(a.ws + OFF_Q) + (size_t)(b * 8192) * 1024 + h * 256;
    bf16_t* Vg = (bf16_t*)(a.ws + OFF_V) + (size_t)(b * 8192) * 2048 + h * 512 + dvb * 64;
    const float* DEC = (const float*)(a.out + DO_DEC) + (size_t)(b * 128) * 1024 + h * 256;
#define SBAR() do { asm volatile("s_waitcnt lgkmcnt(0)" ::: "memory"); __builtin_amdgcn_s_barrier(); asm volatile("" ::: "memory"); } while (0)
    if (wave >= 4) {
        const int lw = wave - 4;
        const unsigned kvo = (unsigned)(((lane >> 3) * 64 + (((lane & 7) ^ ((lane >> 3) & 7)) << 3)) * 2);
        unsigned qvo[8];
#pragma unroll
        for (int i = 0; i < 8; ++i) { const int frl = 2 * i + (lane >> 5); qvo[i] = (unsigned)(((lw * 16 + frl) * 1024 + (((lane & 31) ^ (frl & 15)) << 3)) * 2); }
        const unsigned vvo = (unsigned)(((lane >> 3) * 2048 + (lane & 7) * 8) * 2);
#define G1(cc) do { const int c_ = (cc) > 127 ? 127 : (cc); const char* qb_ = (const char*)(Qg + (size_t)c_ * 65536); LAS unsigned char* d_ = lds + QB + ((cc) & 1) * 32768 + lw * 8192; \
            _Pragma("unroll") for (int i = 0; i < 8; ++i) __builtin_amdgcn_global_load_lds((const unsigned*)(qb_ + qvo[i]), (LAS unsigned*)(d_ + i * 1024), 16, 0, 0); } while (0)
#define G2(cc) do { const int c_ = (cc) > 127 ? 127 : (cc); const char* kb_ = (const char*)(KT + (size_t)c_ * 65536) + lw * 8192; LAS unsigned char* d_ = lds + KTB + ((cc) & 1) * 32768 + lw * 8192; \
            _Pragma("unroll") for (int i = 0; i < 8; ++i) __builtin_amdgcn_global_load_lds((const unsigned*)(kb_ + i * 1024 + kvo), (LAS unsigned*)(d_ + i * 1024), 16, 0, 0); \
            const char* vb_ = (const char*)(Vg + (size_t)(c_ * 64 + lw * 16) * 2048); LAS unsigned char* dv_ = lds + VB + ((cc) & 1) * 8192 + lw * 2048; \
            _Pragma("unroll") for (int i = 0; i < 2; ++i) __builtin_amdgcn_global_load_lds((const unsigned*)(vb_ + (size_t)i * 8 * 2048 * 2 + vvo), (LAS unsigned*)(dv_ + i * 1024), 16, 0, 0); \
            __builtin_amdgcn_global_load_lds((const unsigned*)(DEC + (size_t)c_ * 1024 + lw * 64 + lane), (LAS unsigned*)(lds + DB + ((cc) & 1) * 1024 + lw * 256), 4, 0, 0); } while (0)
        G2(0); G1(0); G2(1);
        for (int c = 0; c < 128; ++c) {
            asm volatile("s_waitcnt vmcnt(19)" ::: "memory");
            SBAR();
            G1(c + 1);
            asm volatile("s_waitcnt vmcnt(19)" ::: "memory");
            SBAR();
            G2(c + 2);
        }
        asm volatile("s_waitcnt vmcnt(0)" ::: "memory");
#undef G1
#undef G2
    } else {
        const unsigned ovo = (unsigned)((l15 * 2048 + 16 * wave + 4 * q) * 2);
        f32x4 accS[16];
#pragma unroll
        for (int i = 0; i < 16; ++i) accS[i] = (f32x4){0.f, 0.f, 0.f, 0.f};
        for (int c = 0; c < 128; ++c) {
            LAS unsigned char* KTs = lds + KTB + (c & 1) * 32768; LAS unsigned char* Qs = lds + QB + (c & 1) * 32768;
            const LAS unsigned short* Vs = (const LAS unsigned short*)(lds + VB + (c & 1) * 8192); LAS float* DECs = (LAS float*)(lds + DB + (c & 1) * 1024);
            SBAR();
            bf16x8 vb0, vb1;
            { const LAS unsigned short* vp = Vs + (8 * q) * 64 + 16 * wave + l15; unsigned w0[4], w1[4];
#pragma unroll
              for (int e = 0; e < 4; ++e) { w0[e] = (unsigned)vp[(2 * e) * 64] | ((unsigned)vp[(2 * e + 1) * 64] << 16); w1[e] = (unsigned)vp[(32 + 2 * e) * 64] | ((unsigned)vp[(32 + 2 * e + 1) * 64] << 16); }
              vb0 = __builtin_bit_cast(bf16x8, (u32x4){w0[0], w0[1], w0[2], w0[3]}); vb1 = __builtin_bit_cast(bf16x8, (u32x4){w1[0], w1[1], w1[2], w1[3]}); }
#define SCAN_KTLD(A0, A1, D, bt) do { _Pragma("unroll") for (int t = 0; t < 4; ++t) { const int dk = 16 * (4 * (bt) + t) + l15; \
                A0[t] = *(const LAS bf16x8*)(KTs + dk * 128 + ((q ^ (dk & 7)) << 4)); A1[t] = *(const LAS bf16x8*)(KTs + dk * 128 + (((4 + q) ^ (dk & 7)) << 4)); \
                D[t] = *(const LAS f32x4*)(DECs + 16 * (4 * (bt) + t) + 4 * q); } } while (0)
#define SCAN_KTMM(A0, A1, D, bt) do { _Pragma("unroll") for (int t = 0; t < 4; ++t) { f32x4 s_ = accS[4 * (bt) + t] * D[t]; \
                s_ = __builtin_amdgcn_mfma_f32_16x16x32_bf16(A0[t], vb0, s_, 0, 0, 0); accS[4 * (bt) + t] = __builtin_amdgcn_mfma_f32_16x16x32_bf16(A1[t], vb1, s_, 0, 0, 0); } } while (0)
            {
                bf16x8 xa0[4], xa1[4], ya0[4], ya1[4]; f32x4 xd[4], yd[4];
                SCAN_KTLD(xa0, xa1, xd, 0); __builtin_amdgcn_sched_barrier(0);
                SCAN_KTLD(ya0, ya1, yd, 1); __builtin_amdgcn_sched_barrier(0);
                SCAN_KTMM(xa0, xa1, xd, 0); __builtin_amdgcn_sched_barrier(0);
                SCAN_KTLD(xa0, xa1, xd, 2); __builtin_amdgcn_sched_barrier(0);
                SCAN_KTMM(ya0, ya1, yd, 1); __builtin_amdgcn_sched_barrier(0);
                SCAN_KTLD(ya0, ya1, yd, 3); __builtin_amdgcn_sched_barrier(0);
                SCAN_KTMM(xa0, xa1, xd, 2); __builtin_amdgcn_sched_barrier(0);
                SCAN_KTMM(ya0, ya1, yd, 3); __builtin_amdgcn_sched_barrier(0);
            }
            bf16x8 sf[8];
#pragma unroll
            for (int ks = 0; ks < 8; ++ks) { u32x4 w; w.x = cvtpk_s(accS[2 * ks][0], accS[2 * ks][1]); w.y = cvtpk_s(accS[2 * ks][2], accS[2 * ks][3]);
                w.z = cvtpk_s(accS[2 * ks + 1][0], accS[2 * ks + 1][1]); w.w = cvtpk_s(accS[2 * ks + 1][2], accS[2 * ks + 1][3]); sf[ks] = __builtin_bit_cast(bf16x8, w); }
            SBAR();
            f32x4 o[4];
#pragma unroll
            for (int ft = 0; ft < 4; ++ft) o[ft] = (f32x4){0.f, 0.f, 0.f, 0.f};
#define SCAN_QLD(Q, kb) do { _Pragma("unroll") for (int k2 = 0; k2 < 2; ++k2) _Pragma("unroll") for (int ft = 0; ft < 4; ++ft) { const int fr = 16 * ft + l15, pc = 4 * (2 * (kb) + k2) + q; \
                Q[k2 * 4 + ft] = *(const LAS u32x4*)(Qs + fr * 512 + ((pc ^ (fr & 15)) << 4)); } } while (0)
#define SCAN_QMM(Q, kb) do { _Pragma("unroll") for (int k2 = 0; k2 < 2; ++k2) _Pragma("unroll") for (int ft = 0; ft < 4; ++ft) \
                o[ft] = __builtin_amdgcn_mfma_f32_16x16x32_bf16(sf[2 * (kb) + k2], __builtin_bit_cast(bf16x8, Q[k2 * 4 + ft]), o[ft], 0, 0, 0); } while (0)
            {
                u32x4 xq[8], yq[8];
                SCAN_QLD(xq, 0); __builtin_amdgcn_sched_barrier(0);
                SCAN_QLD(yq, 1); __builtin_amdgcn_sched_barrier(0);
                SCAN_QMM(xq, 0); __builtin_amdgcn_sched_barrier(0);
                SCAN_QLD(xq, 2); __builtin_amdgcn_sched_barrier(0);
                SCAN_QMM(yq, 1); __builtin_amdgcn_sched_barrier(0);
                SCAN_QLD(yq, 3); __builtin_amdgcn_sched_barrier(0);
                SCAN_QMM(xq, 2); __builtin_amdgcn_sched_barrier(0);
                SCAN_QMM(yq, 3); __builtin_amdgcn_sched_barrier(0);
            }
#undef SCAN_KTLD
#undef SCAN_KTMM
#undef SCAN_QLD
#undef SCAN_QMM
#pragma unroll
            for (int ft = 0; ft < 4; ++ft) { u32x2 w; w.x = cvtpk_s(o[ft][0], o[ft][1]); w.y = cvtpk_s(o[ft][2], o[ft][3]);
                *(u32x2*)((char*)(Vg + (size_t)(c * 64 + 16 * ft) * 2048) + ovo) = w; }
        }
    }
    SBAR();
#undef SBAR
}

__device__ __forceinline__ void phase_merge(const Args& a, LAS unsigned char* lds, int tid, int wave, int lane) {
    const int g = blockIdx.x & 3, l15 = lane & 15, q = lane >> 4;
    LAS unsigned char* Ws = lds; LAS unsigned char* ZT = lds + 32768; LAS float* SG = (LAS float*)(lds + 65536); LAS float* MU = (LAS float*)(lds + 65536 + 67584); LAS float* RS = MU + 128; LAS float* RO = MU + 256;
    const bf16_t* Zb = (const bf16_t*)(a.ws + OFF_Z); const bf16_t* Ob = (const bf16_t*)(a.ws + OFF_V); const bf16_t* OGb = (const bf16_t*)(a.ws + OFF_OG);
    bf16_t* Ub = (bf16_t*)(a.ws + OFF_U);
    for (int p = tid; p < 4096; p += 512) { const int i = p >> 5, j4 = (p & 31) * 4; f32x4 v = *(const f32x4*)(a.w_s + (size_t)g * 16384 + i * 128 + j4);
        if ((j4 >> 6) > (i >> 6)) v = (f32x4){0.f, 0.f, 0.f, 0.f};
        u32x2 w; w.x = cvtpk_s(v[0], v[1]); w.y = cvtpk_s(v[2], v[3]);
        *(LAS u32x2*)(Ws + i * 256 + (((j4 >> 3) ^ (i & 7)) << 4) + (j4 & 4) * 2) = w; }
    for (int item = blockIdx.x; item < 1024; item += gridDim.x) {
        const int nb = item >> 2; const size_t row0 = (size_t)nb * 128; const int colg = g * 512;
        __syncthreads();
#pragma unroll 4
        for (int rr = 0; rr < 16; ++rr) { const int i = wave * 16 + rr; const size_t off = (row0 + i) * DM + colg + lane * 8;
            const u32x4 zw = *(const u32x4*)(Zb + off), ow = *(const u32x4*)(Ob + off);
            float z[8] = {bflo(zw.x), bfhi(zw.x), bflo(zw.y), bfhi(zw.y), bflo(zw.z), bfhi(zw.z), bflo(zw.w), bfhi(zw.w)};
            const float o[8] = {bflo(ow.x), bfhi(ow.x), bflo(ow.y), bfhi(ow.y), bflo(ow.z), bfhi(ow.z), bflo(ow.w), bfhi(ow.w)};
            float s = 0.f, so = 0.f;
#pragma unroll
            for (int e = 0; e < 8; ++e) { s += z[e]; so += o[e] * o[e]; }
            const float mean = wave_sum(s) * (1.f / 512.f); so = wave_sum(so); float s2 = 0.f;
#pragma unroll
            for (int e = 0; e < 8; ++e) { const float dd = z[e] - mean; s2 += dd * dd; }
            s2 = wave_sum(s2);
            if (lane == 0) { MU[i] = mean; RS[i] = 1.f / sqrtf(s2 * (1.f / 512.f) + LN_EPS); RO[i] = 1.f / sqrtf(so * (1.f / 512.f) + LN_EPS); } }
        __syncthreads();
        for (int cc = 0; cc < 4; ++cc) {
            const int colc = colg + cc * 128;
            u32x4 uw4[4], ow4[4], gw4[4];
#pragma unroll
            for (int k = 0; k < 4; ++k) { const int p = tid + 512 * k, i = p >> 4, c8 = (p & 15) * 8; const size_t off = (row0 + i) * DM + colc + c8;
                uw4[k] = *(const u32x4*)(Ub + off); ow4[k] = *(const u32x4*)(Ob + off); gw4[k] = *(const u32x4*)(OGb + off); }
#pragma unroll
            for (int i = 0; i < 4; ++i) { const int p = tid + 512 * i, j = p >> 4, c8 = (p & 15) * 8;
                const u32x4 zw = *(const u32x4*)(Zb + (row0 + j) * DM + colc + c8);
                const float z[8] = {bflo(zw.x), bfhi(zw.x), bflo(zw.y), bfhi(zw.y), bflo(zw.z), bfhi(zw.z), bflo(zw.w), bfhi(zw.w)};
                const float mu = MU[j], rs = RS[j];
                const f32x4 g0 = *(const f32x4*)(a.gm_g + colc + c8), g1 = *(const f32x4*)(a.gm_g + colc + c8 + 4), b0 = *(const f32x4*)(a.gm_b + colc + c8), b1 = *(const f32x4*)(a.gm_b + colc + c8 + 4);
#pragma unroll
                for (int e = 0; e < 8; ++e) { const float gg = e < 4 ? g0[e & 3] : g1[e & 3], bb = e < 4 ? b0[e & 3] : b1[e & 3]; const float zn = (z[e] - mu) * rs * gg + bb;
                    const int c = c8 + e; const unsigned short val = (unsigned short)(cvtpk_s(zn, 0.f) & 0xffffu);
                    *(LAS unsigned short*)(ZT + c * 256 + (((j >> 3) ^ (c & 7)) << 4) + (j & 7) * 2) = val; } }
            __syncthreads();
            {
                const int c = 16 * wave + l15; bf16x8 zf[4];
#pragma unroll
                for (int ks = 0; ks < 4; ++ks) zf[ks] = *(const LAS bf16x8*)(ZT + c * 256 + (((4 * ks + q) ^ (c & 7)) << 4));
#pragma unroll
                for (int it = 0; it < 8; ++it) { const int i = 16 * it + l15; f32x4 acc = (f32x4){0.f, 0.f, 0.f, 0.f};
#pragma unroll
                    for (int ks = 0; ks < 4; ++ks) { if (it < 4 && ks >= 2) continue;
                        const bf16x8 wf = *(const LAS bf16x8*)(Ws + i * 256 + (((4 * ks + q) ^ (i & 7)) << 4));
                        acc = __builtin_amdgcn_mfma_f32_16x16x32_bf16(wf, zf[ks], acc, 0, 0, 0); }
#pragma unroll
                    for (int r = 0; r < 4; ++r) SG[(16 * it + 4 * q + r) * 132 + c] = acc[r]; }
            }
            __syncthreads();
#pragma unroll
            for (int k = 0; k < 4; ++k) { const int p = tid + 512 * k, i = p >> 4, c8 = (p & 15) * 8; const size_t off = (row0 + i) * DM + colc + c8;
                const u32x4 uw = uw4[k], ow = ow4[k], gw = gw4[k];
                const f32x4 s0 = *(const LAS f32x4*)(SG + i * 132 + c8), s1 = *(const LAS f32x4*)(SG + i * 132 + c8 + 4);
                const f32x4 n0 = *(const f32x4*)(a.gla_g + colc + c8), n1 = *(const f32x4*)(a.gla_g + colc + c8 + 4);
                const float bs = a.b_s[g * 128 + i], ro = RO[i];
                const unsigned uu[4] = {uw.x, uw.y, uw.z, uw.w}, oo[4] = {ow.x, ow.y, ow.z, ow.w}, gg[4] = {gw.x, gw.y, gw.z, gw.w};
                float m[8];
#pragma unroll
                for (int e = 0; e < 8; ++e) { const int wi = e >> 1; const bool hi = e & 1;
                    const float uv = hi ? bfhi(uu[wi]) : bflo(uu[wi]), ov = hi ? bfhi(oo[wi]) : bflo(oo[wi]), gv = hi ? bfhi(gg[wi]) : bflo(gg[wi]);
                    const float sg = (e < 4 ? s0[e & 3] : s1[e & 3]) + bs, ng = e < 4 ? n0[e & 3] : n1[e & 3];
                    m[e] = gv * (ov * ro * ng) + uv * sg; }
                u32x4 w; w.x = cvtpk_s(m[0], m[1]); w.y = cvtpk_s(m[2], m[3]); w.z = cvtpk_s(m[4], m[5]); w.w = cvtpk_s(m[6], m[7]);
                *(u32x4*)(Ub + off) = w; }
        }
    }
    __syncthreads();
}

typedef __attribute__((address_space(1))) unsigned gu32;
#define XB_TMO      128
#define XB_XCNT(j)  (256  + 64 * (j))
#define XB_XSUB(j)  (1280 + 64 * (j))
#define XB_XGEN(j)  (2304 + 64 * (j))
#define XB_TOP      3328
#define XB_TOPGEN   3392
#define XCD_BAR_WORDS 3456
#define XB_SPIN_CAP (1u << 18)

__device__ __forceinline__ unsigned xb_ld(unsigned* p)              { return __hip_atomic_load(p, __ATOMIC_RELAXED, __HIP_MEMORY_SCOPE_AGENT); }
__device__ __forceinline__ unsigned xb_add(unsigned* p, unsigned v) { return __hip_atomic_fetch_add(p, v, __ATOMIC_RELAXED, __HIP_MEMORY_SCOPE_AGENT); }
__device__ __forceinline__ unsigned xb_xcc_id() { return (unsigned)__builtin_amdgcn_s_getreg((3 << 11) | 20) & 0xFu; }
#define XB_SPIN(cond, bar) do { unsigned _sp = 0; while (cond) { __builtin_amdgcn_s_sleep(1); \
    if ((++_sp & 255u) == 0u) { if (xb_ld(&(bar)[XB_TMO])) break; if (_sp > XB_SPIN_CAP) { atomicAdd(&(bar)[XB_TMO], 1u); break; } } } } while (0)

struct XcdBarrier {
    unsigned* bar; unsigned x;
    volatile LAS unsigned* st;
};

__device__ __forceinline__ XcdBarrier xcd_barrier_post(unsigned* bar, volatile LAS unsigned* st) {
    XcdBarrier b; b.bar = bar; b.x = xb_xcc_id(); b.st = st;
    if (threadIdx.x == 0) (void)xb_add(&bar[XB_XCNT(b.x)], 1u);
    return b;
}
__device__ __forceinline__ void xcd_barrier_complete(unsigned* bar, unsigned x, unsigned& nloc, unsigned& nx) {
    const unsigned G = gridDim.x * gridDim.y * gridDim.z;
    unsigned sum, cnt, mine, sp = 0u;
    for (;;) {
        sum = 0u; cnt = 0u; mine = 0u;
#pragma unroll
        for (unsigned j = 0; j < 16; ++j) { const unsigned c = xb_ld(&bar[XB_XCNT(j)]); sum += c; cnt += (c > 0u) ? 1u : 0u; mine = (j == x) ? c : mine; }
        if (sum == G) break;
        __builtin_amdgcn_s_sleep(1);
        if ((++sp & 255u) == 0u) { if (xb_ld(&bar[XB_TMO])) break; if (sp > XB_SPIN_CAP) { atomicAdd(&bar[XB_TMO], 1u); break; } }
    }
    nloc = mine > 0u ? mine : 1u; nx = cnt > 0u ? cnt : 1u;
}

__device__ __forceinline__ void xcd_barrier(const XcdBarrier& b) {
    asm volatile("s_waitcnt vmcnt(0)" ::: "memory");
    __syncthreads();
    if (threadIdx.x == 0) {
        unsigned* bar = b.bar;
        __builtin_amdgcn_s_waitcnt(0);
        unsigned nloc = b.st[0], nx = b.st[1];
        if (nloc == 0u) { xcd_barrier_complete(bar, b.x, nloc, nx); b.st[0] = nloc; b.st[1] = nx; }
        const unsigned old = xb_add(&bar[XB_XSUB(b.x)], 1u);
        const unsigned gen = old / nloc;
        if (old + 1u == (gen + 1u) * nloc) {
            __builtin_amdgcn_fence(__ATOMIC_RELEASE, "agent");
            asm volatile("s_waitcnt vmcnt(0)" ::: "memory");
            const unsigned og = xb_add(&bar[XB_TOP], 1u);
            const unsigned tg = og / nx;
            if (og + 1u == (tg + 1u) * nx) xb_add(&bar[XB_TOPGEN], 1u);
            else XB_SPIN(xb_ld(&bar[XB_TOPGEN]) == tg, bar);
            __builtin_amdgcn_fence(__ATOMIC_ACQUIRE, "agent");
            xb_add(&bar[XB_XGEN(b.x)], 1u);
            asm volatile("s_waitcnt vmcnt(0)" ::: "memory");
        } else {
            XB_SPIN(xb_ld(&bar[XB_XGEN(b.x)]) == gen, bar);
            __builtin_amdgcn_fence(__ATOMIC_ACQUIRE, "agent");
            asm volatile("s_waitcnt vmcnt(0)" ::: "memory");
        }
    }
    __syncthreads();
}


__global__ void __launch_bounds__(512, 2) mega(Args a) {
    extern __shared__ __attribute__((aligned(16))) unsigned char lds_raw[];
    LAS unsigned char* lds = (LAS unsigned char*)lds_raw;
    const int tid = threadIdx.x, lane = tid & 63, wave = __builtin_amdgcn_readfirstlane(tid >> 6);
    const int G = gridDim.x, gw = blockIdx.x * 8 + wave, ngw = G * 8;
    const int lo = a.ph_lo, hi = a.ph_hi;
    if (tid < 16) ((LAS unsigned*)(lds + LDS_BARW))[tid] = 0u;
    __syncthreads();
    XcdBarrier bar; bar.bar = (unsigned*)(a.ws + OFF_CTL); bar.x = 0; bar.st = nullptr;
    if (a.coop) bar = xcd_barrier_post((unsigned*)(a.ws + OFF_CTL), (volatile LAS unsigned*)(lds + LDS_BARW));
#define IN(k) (lo <= (k) && (k) < hi)
#define SEAM(k) do { if (IN(k) && IN((k) + 1)) { if ((k) == 0) cg::this_grid().sync(); else xcd_barrier(bar); } } while (0)
    if (IN(0)) { phase_prep(a, lds, gw, ngw, wave, lane); __syncthreads(); }
    SEAM(0);
    if (IN(1)) { pg8::Gemm gm{(const bf16_t*)(a.ws + OFF_H0), (const bf16_t*)(a.ws + OFF_W1T), MTOK, N1, DM}; pg8::StaticOrder S; S.init(MTOK, N1, G, (int)blockIdx.x);
        Epi1 E{a.ws, a.out, a.b_in};
        pg8::gemm_phase<Epi1, pg8::StaticOrder, true, true>(lds, gm, S, E); }
    SEAM(1);
    if (IN(2)) phase_kt(a, lds, tid);
    SEAM(2);
    if (IN(3)) { if (blockIdx.x < 128) phase_scan(a, lds, tid, wave, lane); else { phase_prep2(a, lds, (blockIdx.x - 128) * 8 + wave, (G - 128) * 8, wave, lane); __syncthreads(); } }
    SEAM(3);
    if (IN(4)) phase_merge(a, lds, tid, wave, lane);
    SEAM(4);
    if (IN(5)) { pg8::Gemm gm{(const bf16_t*)(a.ws + OFF_U), (const bf16_t*)(a.ws + OFF_WOT), MTOK, DM, DM}; pg8::StaticOrder S; S.init(MTOK, DM, G, (int)blockIdx.x);
        EpiRes<false> E{(bf16_t*)(a.ws + OFF_H1PRE), (const bf16_t*)(a.ws + OFF_H0), nullptr};
        pg8::gemm_phase<EpiRes<false>, pg8::StaticOrder, false, true>(lds, gm, S, E); }
    SEAM(5);
    if (IN(6)) { const bf16_t* src = (const bf16_t*)(a.ws + OFF_H1PRE); bf16_t* H1 = (bf16_t*)(a.ws + OFF_H1);
        for (int m = gw; m < MTOK; m += 2 * ngw) ln_row2<true, true>(src + (size_t)m * DM, src + (size_t)(m + ngw) * DM, H1 + (size_t)m * DM, H1 + (size_t)(m + ngw) * DM, a.ln1_g, a.ln1_b, lane); }
    SEAM(6);
    if (IN(7)) { phase_pconv(a, gw, ngw, lane);
        pg8::Gemm gm{(const bf16_t*)(a.ws + OFF_H1), (const bf16_t*)(a.out + DO_WGUT), MTOK, NGU, DM}; pg8::StaticOrder S; S.init(MTOK, NGU, G, (int)blockIdx.x);
        Epi5 E{(bf16_t*)(a.ws + OFF_ACT), (bf16_t*)(a.ws + OFF_GPG), a.b_pg};
        pg8::gemm_phase<Epi5, pg8::StaticOrder, true, true>(lds, gm, S, E); }
    SEAM(7);
    if (IN(9)) { pg8::Gemm gm{(const bf16_t*)(a.ws + OFF_ACT), (const bf16_t*)(a.out + DO_WDT), MTOK, DM, KX}; pg8::StaticOrder S; S.init(MTOK, DM, G, (int)blockIdx.x);
        EpiDown E{(bf16_t*)(a.ws + OFF_OUTPRE), (const bf16_t*)(a.ws + OFF_H1), (const bf16_t*)(a.ws + OFF_GPG)};
        pg8::gemm_phase<EpiDown, pg8::StaticOrder, false, true>(lds, gm, S, E); }
    SEAM(9);
    if (IN(10)) { const bf16_t* src = (const bf16_t*)(a.ws + OFF_OUTPRE); float* o = (float*)a.out;
        for (int m = gw; m < MTOK; m += 2 * ngw) ln_row2<false, true>(src + (size_t)m * DM, src + (size_t)(m + ngw) * DM, o + (size_t)m * DM, o + (size_t)(m + ngw) * DM, a.ln2_g, a.ln2_b, lane); }
    if (IN(11)) {
        float* o = (float*)a.out;
        if (a.pad == 0) { const bf16_t* src = (const bf16_t*)(a.ws + (size_t)a.coop * MiB);
            for (size_t i = (size_t)blockIdx.x * 512 + tid; i < (size_t)MTOK * DM; i += (size_t)G * 512) o[i] = __uint_as_float(((unsigned)src[i]) << 16); }
        else { const float* src = (const float*)(a.ws + (size_t)a.coop * MiB);
            for (size_t i = (size_t)blockIdx.x * 512 + tid; i < (size_t)MTOK * DM; i += (size_t)G * 512) o[i] = src[i]; }
    }
#undef IN
#undef SEAM
}

#ifndef N_LAUNCH_MODE
#define N_LAUNCH_MODE 1
#endif
extern "C" void kernel_launch(void* const* d_in, const int* in_sizes, int n_in, void* d_out, int out_size, void* d_ws, size_t ws_size, hipStream_t stream) {
    static int grid = 0;
    if (grid == 0) {
        if (n_in != 23 || out_size != MTOK * DM || ws_size < WS_NEED) { fprintf(stderr, "kernel_launch: unexpected shapes (n_in %d out %d ws %zu)\n", n_in, out_size, ws_size); grid = -1; return; }
        int dev = 0, cus = 0, per_cu = 0;
        hipGetDevice(&dev); hipDeviceGetAttribute(&cus, hipDeviceAttributeMultiprocessorCount, dev);
        if (hipFuncSetAttribute((const void*)mega, hipFuncAttributeMaxDynamicSharedMemorySize, LDS_BYTES) != hipSuccess) { fprintf(stderr, "kernel_launch: hipFuncSetAttribute failed\n"); grid = -1; return; }
        hipOccupancyMaxActiveBlocksPerMultiprocessor(&per_cu, (const void*)mega, 512, LDS_BYTES);
        (void)hipGetLastError();
        if (cus != 256 || per_cu < 1) { fprintf(stderr, "kernel_launch: needs 256 CUs with one resident block each (cus %d per_cu %d)\n", cus, per_cu); grid = -1; return; }
        grid = 256;
    }
    if (grid < 0) return;
    Args a{};
    const float** f = (const float**)&a;
    for (int i = 0; i < 23; ++i) f[i] = (const float*)d_in[i];
    a.out = (unsigned char*)d_out; a.ws = (unsigned char*)d_ws;
#if N_LAUNCH_MODE == 1
    a.ph_lo = 0; a.ph_hi = 11; a.coop = 1;
    if (hipMemsetAsync((char*)d_ws + OFF_CTL, 0, 65536, stream) != hipSuccess) { fprintf(stderr, "kernel_launch: memset failed\n"); return; }
    void* args[] = {&a};
    hipError_t e = hipLaunchCooperativeKernel((const void*)mega, dim3(grid), dim3(512), args, LDS_BYTES, stream);
    if (e != hipSuccess) fprintf(stderr, "cooperative launch failed: %s\n", hipGetErrorString(e));
#else
#ifndef DBG_STOP
#define DBG_STOP 10
#endif
#ifndef DBG_OFF_MIB
#define DBG_OFF_MIB 321
#endif
#ifndef DBG_F32
#define DBG_F32 0
#endif
#ifndef PROG
#define PROG {0, 1, 2, 3, 4, 5, 6, 7, 8, 9, 10}
#endif
    static const int prog[] = PROG;
    for (int pi = 0; pi < (int)(sizeof(prog) / sizeof(prog[0])); ++pi) { const int ph = prog[pi]; if (ph > DBG_STOP) break; a.ph_lo = ph; a.ph_hi = ph + 1; a.coop = 0;
        hipLaunchKernelGGL(mega, dim3(grid), dim3(512), LDS_BYTES, stream, a); }
    if (DBG_STOP < 10) { a.ph_lo = 11; a.ph_hi = 12; a.coop = DBG_OFF_MIB; a.pad = DBG_F32;
        hipLaunchKernelGGL(mega, dim3(grid), dim3(512), LDS_BYTES, stream, a); }
#endif
}
```

```cpp
#include <hip/hip_runtime.h>
#include <hip/hip_cooperative_groups.h>
#include <cstdio>
#include <cstdint>
namespace cg = cooperative_groups;
namespace pg8 {
#define PG8_LAS __attribute__((address_space(3)))
typedef unsigned short bf16_t;
typedef short bf16x8 __attribute__((ext_vector_type(8)));
typedef float f32x4 __attribute__((ext_vector_type(4)));
typedef unsigned u32x4 __attribute__((ext_vector_type(4)));
constexpr int BM = 256, BK = 64, HALF = 128, HTB = HALF * BK * 2  , STAGE_BYTES = 8 * HTB, NXCD = 8, WGM = 8;

__host__ __device__ __forceinline__ int lds_byte(int r, int c) { const int st = (r >> 4) * 2 + (c >> 5), rr = r & 15, cc = c & 31, ob = rr * 64 + cc * 2; return st * 1024 + (ob ^ (((ob >> 9) & 1) << 5)); }
__host__ __device__ __forceinline__ void stage_rc(int b, int& R, int& C) { const int st = b / 1024, sb = b % 1024, swz = sb ^ (((sb >> 9) & 1) << 5); R = (st >> 1) * 16 + swz / 64; C = (st & 1) * 32 + (swz % 64) / 2; }
__host__ __device__ __forceinline__ int perm32(int rho) { const int n = rho >> 4, i = rho & 15; return 8 * (i >> 2) + 4 * n + (i & 3); }

struct Unit { int pm, pn; };
struct Gemm { const bf16_t* A; const bf16_t* Bt; int M, N, K; };

struct StaticOrder {
    int nM, nN, nwg, G, c;
    __host__ __device__ void init(int M, int N, int G_, int c_) { nM = M / BM; nN = N / BM; nwg = nM * nN; G = G_; c = c_; }
    __host__ __device__ bool next(int i, Unit& u) const {
        const long L = (long)i * G + c; if (L >= nwg) return false;
        int wgid = (int)L; { const int q = nwg / NXCD, r = nwg % NXCD, xcd = wgid % NXCD, off = wgid / NXCD; wgid = (xcd < r ? xcd * (q + 1) : r * (q + 1) + (xcd - r) * q) + off; }
        const int nig = WGM * nN, gid = wgid / nig, fm = gid * WGM, gsz = (nM - fm) < WGM ? (nM - fm) : WGM;
        u.pm = fm + ((wgid % nig) % gsz); u.pn = (wgid % nig) / gsz; return true;
    }
    __device__ __forceinline__ void a_ready(const Unit&) const {}
    __device__ __forceinline__ void done(const Unit&) const {}
};
__device__ __forceinline__ unsigned cvt_pk_bf16(float lo, float hi) { unsigned r; asm volatile("v_cvt_pk_bf16_f32 %0, %1, %2" : "=v"(r) : "v"(lo), "v"(hi)); return r; }
typedef float f32x2 __attribute__((ext_vector_type(2)));
__device__ __forceinline__ f32x2 gelu_pk(f32x2 v) {
    const f32x2 av = __builtin_elementwise_abs(v), d = av * 0.2316418882f + 1.0f;
    f32x2 t; t.x = __builtin_amdgcn_rcpf(d.x); t.y = __builtin_amdgcn_rcpf(d.y);
    f32x2 q = t * 0.5307027145f + (-0.7265760135f); q = q * t + 0.7107068705f; q = q * t + (-0.142248368f); q = q * t + 0.127414796f; q = q * t;
    const f32x2 s = (v * v) * (-0.72134752044f);
    f32x2 e; e.x = __builtin_amdgcn_exp2f(s.x); e.y = __builtin_amdgcn_exp2f(s.y);
    const f32x2 m = v * (q * e), r = v - m;
    f32x2 o; o.x = v.x < 0.f ? m.x : r.x; o.y = v.y < 0.f ? m.y : r.y; return o;
}

template <class Epi, class Sched, bool ALIGN_EPI = false, bool SP2 = false>
__device__ __forceinline__ void gemm_phase(PG8_LAS unsigned char* lds, const Gemm g, const Sched& S, const Epi& E) {
    const int tid = threadIdx.x, wid = __builtin_amdgcn_readfirstlane(tid >> 6), lane = tid & 63, wr = wid >> 2, wc = wid & 3, fr = lane & 15, fq = lane >> 4;
    const int K = g.K, nt = K / BK;
    unsigned voffA[2], voffB[2];
#pragma unroll
    for (int i = 0; i < 2; ++i) { int R, C; stage_rc(tid * 16 + i * 8192, R, C); const int Rb = Epi::PERM ? ((R & ~31) + perm32(R & 31)) : R;
        voffA[i] = (unsigned)(R * K + C) * 2u; voffB[i] = (unsigned)(Rb * K + C) * 2u; }
    const size_t kstep = (size_t)(BK * 2);
    const size_t hstep = (size_t)HALF * K * 2;
    const size_t tstep = 2 * hstep;
    const unsigned ldsw = (unsigned)wid * 1024u;
    const int aoff = lds_byte(wr * 64 + fr, fq * 8), boff = lds_byte(wc * 32 + fr, fq * 8);
#define PG8_SA(b, h) (((b) * 2 + (h)) * HTB)
#define PG8_SB(b, h) ((4 + (b) * 2 + (h)) * HTB)
#define PG8_STAGE(bufoff, gbase, voff) do { _Pragma("unroll") for (int _i = 0; _i < 2; ++_i) \
        __builtin_amdgcn_global_load_lds((const unsigned*)((const char*)(gbase) + (voff)[_i]), (PG8_LAS unsigned*)(lds + (bufoff) + ldsw + _i * 8192), 16, 0, 0); } while (0)
#define PG8_LDA(dst, b, h) do { _Pragma("unroll") for (int m = 0; m < 4; ++m) _Pragma("unroll") for (int k = 0; k < 2; ++k) dst[m][k] = *(const PG8_LAS bf16x8*)(lds + PG8_SA(b, h) + aoff + m * 2048 + k * 1024); } while (0)
#define PG8_LDB(dst, b, h) do { _Pragma("unroll") for (int n = 0; n < 2; ++n) _Pragma("unroll") for (int k = 0; k < 2; ++k) dst[n][k] = *(const PG8_LAS bf16x8*)(lds + PG8_SB(b, h) + boff + n * 2048 + k * 1024); } while (0)
#define PG8_MMA(ai, bj, At, Bt) do { __builtin_amdgcn_s_setprio(1); _Pragma("unroll") for (int m = 0; m < 4; ++m) _Pragma("unroll") for (int n = 0; n < 2; ++n) _Pragma("unroll") for (int k = 0; k < 2; ++k) \
        acc[ai][bj][m][n] = __builtin_amdgcn_mfma_f32_16x16x32_bf16(Bt[n][k], At[m][k], acc[ai][bj][m][n], 0, 0, 0); __builtin_amdgcn_s_setprio(0); } while (0)
#define PG8_WAIT_V(n) asm volatile("s_waitcnt vmcnt(" #n ")" ::: "memory")
#define PG8_WAIT_L(n) asm volatile("s_waitcnt lgkmcnt(" #n ")" ::: "memory")
#define PG8_BAR __builtin_amdgcn_s_barrier()
#define PG8_SCHED __builtin_amdgcn_sched_barrier(0)
    Unit cur, nxt; int ui = 0;
    if (!S.next(0, cur)) return;
    f32x4 acc[2][2][4][2];
#pragma unroll
    for (int a = 0; a < 2; ++a)
#pragma unroll
        for (int b = 0; b < 2; ++b)
#pragma unroll
            for (int m = 0; m < 4; ++m)
#pragma unroll
                for (int n = 0; n < 2; ++n) acc[a][b][m][n] = (f32x4){0.f, 0.f, 0.f, 0.f};
    bf16x8 At[4][2], B0[2][2], B1[2][2];
    const char* cA = (const char*)g.A + (size_t)cur.pm * tstep; const char* cB = (const char*)g.Bt + (size_t)cur.pn * tstep;
    S.a_ready(cur);
    if constexpr (SP2) {
        PG8_STAGE(PG8_SB(0, 0), cB, voffB); PG8_STAGE(PG8_SB(0, 1), cB + hstep, voffB); PG8_STAGE(PG8_SA(0, 0), cA, voffA); PG8_STAGE(PG8_SA(0, 1), cA + hstep, voffA);
        if (wr == 1) PG8_BAR;
        PG8_WAIT_V(2); PG8_BAR;
        PG8_STAGE(PG8_SB(1, 0), cB + kstep, voffB); PG8_STAGE(PG8_SA(1, 0), cA + kstep, voffA); PG8_STAGE(PG8_SB(1, 1), cB + hstep + kstep, voffB);
        PG8_WAIT_V(6); PG8_BAR;
    } else {
        PG8_STAGE(PG8_SB(0, 0), cB, voffB); PG8_STAGE(PG8_SA(0, 0), cA, voffA); PG8_STAGE(PG8_SB(0, 1), cB + hstep, voffB); PG8_STAGE(PG8_SA(0, 1), cA + hstep, voffA);
        if (wr == 1) PG8_BAR;
        PG8_WAIT_V(4); PG8_BAR;
        PG8_STAGE(PG8_SB(1, 0), cB + kstep, voffB); PG8_STAGE(PG8_SA(1, 0), cA + kstep, voffA); PG8_STAGE(PG8_SB(1, 1), cB + hstep + kstep, voffB);
        PG8_WAIT_V(6); PG8_BAR;
    }
    for (;;) {
        const bool has_next = S.next(ui + 1, nxt);
        const char* nA = has_next ? (const char*)g.A + (size_t)nxt.pm * tstep : cA; const char* nB = has_next ? (const char*)g.Bt + (size_t)nxt.pn * tstep : cB;
        for (int t = 0; t < nt; t += 2) {
            const bool last = (t == nt - 2);
            const char* a1 = cA + (size_t)(t + 1) * kstep;
            const char* a2 = last ? nA : cA + (size_t)(t + 2) * kstep; const char* b2 = last ? nB : cB + (size_t)(t + 2) * kstep;
            const char* a3 = a2 + kstep; const char* b3 = b2 + kstep;
            if (last && has_next) S.a_ready(nxt);
            if constexpr (Epi::HOOK_T > 0) { if (t == Epi::HOOK_T) E.hook(acc, cur, wr, wc, fr, fq); }
            if constexpr (SP2) {
            PG8_LDB(B0, 0, 0); PG8_LDB(B1, 0, 1); PG8_SCHED; PG8_LDA(At, 0, 0); PG8_STAGE(PG8_SA(1, 1), a1 + hstep, voffA);
            PG8_WAIT_V(8); PG8_WAIT_L(0); PG8_BAR; PG8_MMA(0, 0, At, B0); PG8_MMA(0, 1, At, B1); PG8_BAR; PG8_SCHED;
            PG8_LDA(At, 0, 1); PG8_STAGE(PG8_SB(0, 0), b2, voffB); PG8_STAGE(PG8_SB(0, 1), b2 + hstep, voffB); PG8_STAGE(PG8_SA(0, 0), a2, voffA);
            PG8_WAIT_V(8); PG8_WAIT_L(0); PG8_BAR; PG8_MMA(1, 0, At, B0); PG8_MMA(1, 1, At, B1); PG8_BAR; PG8_SCHED;
            PG8_LDB(B0, 1, 0); PG8_LDB(B1, 1, 1); PG8_SCHED; PG8_LDA(At, 1, 0); PG8_STAGE(PG8_SA(0, 1), a2 + hstep, voffA);
            PG8_WAIT_V(8); PG8_WAIT_L(0); PG8_BAR; PG8_MMA(0, 0, At, B0); PG8_MMA(0, 1, At, B1); PG8_BAR; PG8_SCHED;
            PG8_LDA(At, 1, 1); PG8_STAGE(PG8_SB(1, 0), b3, voffB); PG8_STAGE(PG8_SB(1, 1), b3 + hstep, voffB); PG8_STAGE(PG8_SA(1, 0), a3, voffA);
            PG8_WAIT_V(8); PG8_WAIT_L(0); PG8_BAR; PG8_MMA(1, 0, At, B0); PG8_MMA(1, 1, At, B1); PG8_BAR; PG8_SCHED;
            } else {
            PG8_LDB(B0, 0, 0); PG8_SCHED; PG8_LDA(At, 0, 0); PG8_STAGE(PG8_SA(1, 1), a1 + hstep, voffA);
            PG8_WAIT_L(8); PG8_BAR; PG8_WAIT_L(0); PG8_MMA(0, 0, At, B0); PG8_BAR; PG8_SCHED;
            PG8_LDB(B1, 0, 1); PG8_STAGE(PG8_SB(0, 0), b2, voffB);
            PG8_BAR; PG8_WAIT_L(0); PG8_MMA(0, 1, At, B1); PG8_BAR;
            PG8_LDA(At, 0, 1); PG8_STAGE(PG8_SA(0, 0), a2, voffA);
            PG8_BAR; PG8_WAIT_L(0); PG8_MMA(1, 0, At, B0); PG8_BAR; PG8_SCHED;
            PG8_STAGE(PG8_SB(0, 1), b2 + hstep, voffB);
            PG8_WAIT_V(6); PG8_BAR; PG8_MMA(1, 1, At, B1); PG8_BAR;
            PG8_LDB(B0, 1, 0); PG8_SCHED; PG8_LDA(At, 1, 0); PG8_STAGE(PG8_SA(0, 1), a2 + hstep, voffA);
            PG8_WAIT_L(8); PG8_BAR; PG8_WAIT_L(0); PG8_MMA(0, 0, At, B0); PG8_BAR; PG8_SCHED;
            PG8_LDB(B1, 1, 1); PG8_STAGE(PG8_SB(1, 0), b3, voffB);
            PG8_BAR; PG8_WAIT_L(0); PG8_MMA(0, 1, At, B1); PG8_BAR;
            PG8_LDA(At, 1, 1); PG8_STAGE(PG8_SA(1, 0), a3, voffA);
            PG8_BAR; PG8_WAIT_L(0); PG8_MMA(1, 0, At, B0); PG8_BAR; PG8_SCHED;
            PG8_STAGE(PG8_SB(1, 1), b3 + hstep, voffB);
            PG8_WAIT_V(6); PG8_BAR; PG8_MMA(1, 1, At, B1); PG8_BAR;
            }
        }
        if constexpr (ALIGN_EPI) { if (wr == 0) PG8_BAR; }
        if constexpr (!Epi::AFTER_DRAIN) { E(acc, cur, wr, wc, fr, fq); S.done(cur); }
        if (!has_next) break;
#pragma unroll
        for (int a = 0; a < 2; ++a)
#pragma unroll
            for (int b = 0; b < 2; ++b)
#pragma unroll
                for (int m = 0; m < 4; ++m)
#pragma unroll
                    for (int n = 0; n < 2; ++n) acc[a][b][m][n] = (f32x4){0.f, 0.f, 0.f, 0.f};
        cur = nxt; cA = nA; cB = nB; ++ui;
        if constexpr (ALIGN_EPI) { if (wr == 1) PG8_BAR; }
    }
    PG8_WAIT_V(0);
    if constexpr (!ALIGN_EPI) { if (wr == 0) PG8_BAR; }
    PG8_BAR;
    if constexpr (Epi::AFTER_DRAIN) { E.fused(acc, cur, wr, wc, fr, fq, lds, wid, lane); S.done(cur); }
#undef PG8_SA
#undef PG8_SB
#undef PG8_STAGE
#undef PG8_LDA
#undef PG8_LDB
#undef PG8_MMA
#undef PG8_WAIT_V
#undef PG8_WAIT_L
#undef PG8_BAR
#undef PG8_SCHED
}
}

#define LAS __attribute__((address_space(3)))
typedef unsigned short bf16_t;
typedef short bf16x8 __attribute__((ext_vector_type(8)));
typedef float f32x4 __attribute__((ext_vector_type(4)));
typedef unsigned u32x4 __attribute__((ext_vector_type(4)));
typedef unsigned u32x2 __attribute__((ext_vector_type(2)));

constexpr int KX = 5888  , MTOK = 32768, DM = 2048, NCHUNK = 512  , DFF = 5632, N1 = 14592, NGU = 13312;
constexpr float ALPHA = 1.189207115002721f, LN_EPS = 1e-5f;
constexpr size_t MiB = 1u << 20;
constexpr size_t OFF_W1T = 0, OFF_WOT = 57 * MiB, OFF_H0 = 65 * MiB, OFF_Q = 193 * MiB, OFF_K = 257 * MiB, OFF_V = 321 * MiB, OFF_OG = 449 * MiB,
                 OFF_U = 577 * MiB, OFF_Z = 705 * MiB, OFF_GA = 833 * MiB, OFF_FG = 961 * MiB, OFF_CTL = 969 * MiB, WS_NEED = 970 * MiB;
constexpr size_t OFF_H1PRE = OFF_V, OFF_H1 = OFF_Z, OFF_ACT = OFF_Q  , OFF_GPG = OFF_GA, OFF_OUTPRE = 0;
constexpr size_t DO_GB = 0, DO_PLEB = 0, DO_DEC = 128 * MiB, DO_WGUT = 130 * MiB, DO_WDT = 182 * MiB, DO_WPUT = 204 * MiB, DO_PB = 205 * MiB;
constexpr int LDS_BYTES = 153600, LDS_BARW = 153536;

struct Args {
    const float *x, *p, *ln0_g, *ln0_b, *w_in, *b_in, *w_f2, *b_f2, *gla_g, *gm_g, *gm_b, *w_s, *b_s, *w_o, *ln1_g, *ln1_b, *w_gu, *w_down, *w_pg, *b_pg, *w_pu, *ln2_g, *ln2_b;
    unsigned char* out; unsigned char* ws; int ph_lo, ph_hi, coop, pad;
};

typedef float f32x2_t __attribute__((ext_vector_type(2))); typedef __bf16 bf16x2_t __attribute__((ext_vector_type(2)));
__device__ __forceinline__ unsigned cvtpk_s(float lo, float hi) { f32x2_t v = {lo, hi}; bf16x2_t b = __builtin_convertvector(v, bf16x2_t); return __builtin_bit_cast(unsigned, b); }
__device__ __forceinline__ float bflo(unsigned w) { return __uint_as_float(w << 16); }
__device__ __forceinline__ float bfhi(unsigned w) { return __uint_as_float(w & 0xffff0000u); }
__device__ __forceinline__ float sigm(float x) { return __builtin_amdgcn_rcpf(1.f + __expf(-x)); }
__device__ __forceinline__ float wave_sum(float v) {
#pragma unroll
    for (int o = 1; o < 64; o <<= 1) v += __shfl_xor(v, o);
    return v;
}
#define LDS_WAIT() asm volatile("s_waitcnt lgkmcnt(0)" ::: "memory")

using pg8::Unit;
using pg8::gelu_pk;
typedef float f32x2 __attribute__((ext_vector_type(2)));

__device__ __forceinline__ void act8(f32x4& v0, f32x4& v1, int mode) {
    if (mode == 0) { v0 = v0 * 0.0625f; v1 = v1 * 0.0625f; }
    else if (mode == 2) {
#pragma unroll
        for (int j = 0; j < 4; ++j) { v0[j] = v0[j] * sigm(v0[j]); v1[j] = v1[j] * sigm(v1[j]); } }
    else if (mode == 3) { f32x2 a = gelu_pk((f32x2){v0[0], v0[1]}), b = gelu_pk((f32x2){v0[2], v0[3]}), c = gelu_pk((f32x2){v1[0], v1[1]}), d = gelu_pk((f32x2){v1[2], v1[3]});
        v0 = (f32x4){a.x, a.y, b.x, b.y}; v1 = (f32x4){c.x, c.y, d.x, d.y}; }
    else if (mode == 4) {
#pragma unroll
        for (int j = 0; j < 4; ++j) { v0[j] = sigm(v0[j]); v1[j] = sigm(v1[j]); } }
}

struct Epi1 {
    static constexpr bool PERM = true, AFTER_DRAIN = false; static constexpr int HOOK_T = 0;
    unsigned char* ws; unsigned char* dout; const float* b_in;
    __device__ __forceinline__ void operator()(const f32x4 (&acc)[2][2][4][2], const Unit& u, int wr, int wc, int fr, int fq) const {
        const int pn = u.pn; const int row0 = u.pm * 256 + wr * 64 + fr;
        if (pn == 56) {
            if (wc < 2) {
                float* FG = (float*)(ws + OFF_FG); const int c0 = wc * 32 + 8 * fq;
                const f32x4 b0 = *(const f32x4*)(b_in + 6144 + c0), b1 = *(const f32x4*)(b_in + 6144 + c0 + 4);
#pragma unroll
                for (int ai = 0; ai < 2; ++ai)
#pragma unroll
                    for (int m = 0; m < 4; ++m) { float* rp = FG + (size_t)(row0 + ai * 128 + m * 16) * 64 + c0;
                        *(f32x4*)rp = acc[ai][0][m][0] + b0; *(f32x4*)(rp + 4) = acc[ai][0][m][1] + b1; }
            }
            return;
        }
        const int cw = wc * 32 + 8 * fq;
        if (pn >= 16 && pn < 48) {
            const bool first = pn < 32; const int t = first ? pn - 16 : pn - 32;
            const float* bA = b_in + (first ? 4096 : 6208) + 128 * t + cw; const float* bB = b_in + (first ? 10304 : 12352) + 128 * t + cw;
            const f32x4 a0 = *(const f32x4*)bA, a1 = *(const f32x4*)(bA + 4), g0 = *(const f32x4*)bB, g1 = *(const f32x4*)(bB + 4);
            bf16_t* rowp0 = (bf16_t*)(ws + (first ? OFF_OG : OFF_U)) + (size_t)row0 * 2048 + 128 * t + cw;
            if (first) pair_body<2>(acc, a0, a1, g0, g1, rowp0); else pair_body<3>(acc, a0, a1, g0, g1, rowp0);
            return;
        }
        int mode, ldc, colt, bsrc; bf16_t* base;
        if (pn < 4) { mode = 0; base = (bf16_t*)(ws + OFF_Q); ldc = 1024; colt = pn * 256; bsrc = pn * 256; }
        else if (pn < 8) { mode = 1; base = (bf16_t*)(ws + OFF_K); ldc = 1024; colt = (pn - 4) * 256; bsrc = pn * 256; }
        else if (pn < 16) { mode = 1; base = (bf16_t*)(ws + OFF_V); ldc = 2048; colt = (pn - 8) * 256; bsrc = pn * 256; }
        else { mode = 3; base = (bf16_t*)(ws + OFF_Z); ldc = 2048; colt = (pn - 48) * 256; bsrc = 8256 + (pn - 48) * 256; }
        f32x4 bv[2][2];
#pragma unroll
        for (int bj = 0; bj < 2; ++bj)
#pragma unroll
            for (int n = 0; n < 2; ++n) bv[bj][n] = *(const f32x4*)(b_in + bsrc + bj * 128 + (mode == 0 ? wc * 32 + 4 * fq + 16 * n : cw + 4 * n));
        bf16_t* rowp0 = base + (size_t)row0 * ldc + colt + cw;
        switch (mode) {
            case 0: body<0>(acc, bv, rowp0, ldc); break;
            case 1: body<1>(acc, bv, rowp0, ldc); break;
            default: body<3>(acc, bv, rowp0, ldc); break;
        }
    }
    template <int MODE> __device__ __forceinline__ void body(const f32x4 (&acc)[2][2][4][2], const f32x4 (&bv)[2][2], bf16_t* rowp0, int ldc) const {
#pragma unroll
        for (int ai = 0; ai < 2; ++ai)
#pragma unroll
            for (int m = 0; m < 4; ++m) { bf16_t* rowp = rowp0 + (size_t)(ai * 128 + m * 16) * ldc;
#pragma unroll
                for (int bj = 0; bj < 2; ++bj) { f32x4 v0 = acc[ai][bj][m][0] + bv[bj][0], v1 = acc[ai][bj][m][1] + bv[bj][1];
                    act8(v0, v1, MODE);
                    u32x4 w; w.x = cvtpk_s(v0[0], v0[1]); w.y = cvtpk_s(v0[2], v0[3]); w.z = cvtpk_s(v1[0], v1[1]); w.w = cvtpk_s(v1[2], v1[3]);
                    *(u32x4*)(rowp + bj * 128) = w; } }
    }
    template <int MODE> __device__ __forceinline__ void pair_body(const f32x4 (&acc)[2][2][4][2], const f32x4 a0, const f32x4 a1, const f32x4 g0, const f32x4 g1, bf16_t* rowp0) const {
#pragma unroll
        for (int ai = 0; ai < 2; ++ai)
#pragma unroll
            for (int m = 0; m < 4; ++m) { f32x4 v0 = acc[ai][0][m][0] + a0, v1 = acc[ai][0][m][1] + a1, s0 = acc[ai][1][m][0] + g0, s1 = acc[ai][1][m][1] + g1;
                act8(v0, v1, MODE); act8(s0, s1, 4);
                v0 = v0 * s0; v1 = v1 * s1;
                u32x4 w; w.x = cvtpk_s(v0[0], v0[1]); w.y = cvtpk_s(v0[2], v0[3]); w.z = cvtpk_s(v1[0], v1[1]); w.w = cvtpk_s(v1[2], v1[3]);
                *(u32x4*)(rowp0 + (size_t)(ai * 128 + m * 16) * 2048) = w; }
    }
};

template <bool HAS_P> struct EpiRes {
    static constexpr bool PERM = true, AFTER_DRAIN = false; static constexpr int HOOK_T = 0;
    bf16_t* out; const bf16_t* R; const bf16_t* P;
    __device__ __forceinline__ void operator()(const f32x4 (&acc)[2][2][4][2], const Unit& u, int wr, int wc, int fr, int fq) const {
        const int row0 = u.pm * 256 + wr * 64 + fr, col0 = u.pn * 256 + wc * 32 + 8 * fq;
#pragma unroll
        for (int ai = 0; ai < 2; ++ai)
#pragma unroll
            for (int mh = 0; mh < 2; ++mh) {
                u32x4 rr[2][2], qq[2][2];
#pragma unroll
                for (int m2 = 0; m2 < 2; ++m2)
#pragma unroll
                    for (int bj = 0; bj < 2; ++bj) { const size_t off = (size_t)(row0 + ai * 128 + (2 * mh + m2) * 16) * DM + col0 + bj * 128;
                        rr[m2][bj] = *(const u32x4*)(R + off); if (HAS_P) qq[m2][bj] = *(const u32x4*)(P + off); }
#pragma unroll
                for (int m2 = 0; m2 < 2; ++m2)
#pragma unroll
                    for (int bj = 0; bj < 2; ++bj) { const int m = 2 * mh + m2; const size_t off = (size_t)(row0 + ai * 128 + m * 16) * DM + col0 + bj * 128; const u32x4 r = rr[m2][bj];
                        f32x4 v0 = acc[ai][bj][m][0], v1 = acc[ai][bj][m][1];
                        v0 += (f32x4){bflo(r.x), bfhi(r.x), bflo(r.y), bfhi(r.y)} * ALPHA; v1 += (f32x4){bflo(r.z), bfhi(r.z), bflo(r.w), bfhi(r.w)} * ALPHA;
                        if (HAS_P) { const u32x4 q = qq[m2][bj];
                            v0 += (f32x4){bflo(q.x), bfhi(q.x), bflo(q.y), bfhi(q.y)}; v1 += (f32x4){bflo(q.z), bfhi(q.z), bflo(q.w), bfhi(q.w)}; }
                        u32x4 w; w.x = cvtpk_s(v0[0], v0[1]); w.y = cvtpk_s(v0[2], v0[3]); w.z = cvtpk_s(v1[0], v1[1]); w.w = cvtpk_s(v1[2], v1[3]);
                        *(u32x4*)(out + off) = w; }
                asm volatile("" ::: "memory");
            }
    }
};

struct EpiDown {
    static constexpr bool PERM = true, AFTER_DRAIN = false; static constexpr int HOOK_T = 4;
    bf16_t* out; const bf16_t* R; const bf16_t* G;
    __device__ __forceinline__ void hook(f32x4 (&acc)[2][2][4][2], const Unit& u, int wr, int wc, int fr, int fq) const {
        unsigned zoff; asm volatile("v_mov_b32 %0, 0" : "=v"(zoff));
        const bf16_t* gp = G + (size_t)(u.pm * 256 + wr * 64 + fr) * DM + u.pn * 256 + wc * 32 + 8 * fq + zoff;
#pragma unroll
        for (int ai = 0; ai < 2; ++ai)
#pragma unroll
            for (int mh = 0; mh < 2; ++mh) {
                u32x4 rr[2][2];
#pragma unroll
                for (int m2 = 0; m2 < 2; ++m2)
#pragma unroll
                    for (int bj = 0; bj < 2; ++bj) rr[m2][bj] = *(const u32x4*)(gp + (size_t)(ai * 128 + (2 * mh + m2) * 16) * DM + bj * 128);
#pragma unroll
                for (int m2 = 0; m2 < 2; ++m2)
#pragma unroll
                    for (int bj = 0; bj < 2; ++bj) { const u32x4 r = rr[m2][bj]; const int m = 2 * mh + m2;
                        acc[ai][bj][m][0] *= (f32x4){bflo(r.x), bfhi(r.x), bflo(r.y), bfhi(r.y)}; acc[ai][bj][m][1] *= (f32x4){bflo(r.z), bfhi(r.z), bflo(r.w), bfhi(r.w)}; }
                asm volatile("" ::: "memory");
            }
    }
    __device__ __forceinline__ void operator()(const f32x4 (&acc)[2][2][4][2], const Unit& u, int wr, int wc, int fr, int fq) const {
        const int row0 = u.pm * 256 + wr * 64 + fr, col0 = u.pn * 256 + wc * 32 + 8 * fq;
#pragma unroll
        for (int ai = 0; ai < 2; ++ai)
#pragma unroll
            for (int m = 0; m < 4; ++m)
#pragma unroll
                for (int bj = 0; bj < 2; ++bj) { const size_t off = (size_t)(row0 + ai * 128 + m * 16) * DM + col0 + bj * 128; const u32x4 r = *(const u32x4*)(R + off);
                    f32x4 v0 = acc[ai][bj][m][0], v1 = acc[ai][bj][m][1];
                    v0 += (f32x4){bflo(r.x), bfhi(r.x), bflo(r.y), bfhi(r.y)} * ALPHA; v1 += (f32x4){bflo(r.z), bfhi(r.z), bflo(r.w), bfhi(r.w)} * ALPHA;
                    u32x4 w; w.x = cvtpk_s(v0[0], v0[1]); w.y = cvtpk_s(v0[2], v0[3]); w.z = cvtpk_s(v1[0], v1[1]); w.w = cvtpk_s(v1[2], v1[3]);
                    *(u32x4*)(out + off) = w; }
    }
};

struct Epi5 {
    static constexpr bool PERM = true, AFTER_DRAIN = false; static constexpr int HOOK_T = 0;
    bf16_t* ACT; bf16_t* GPG; const float* b_pg;
    __device__ __forceinline__ void operator()(const f32x4 (&acc)[2][2][4][2], const Unit& u, int wr, int wc, int fr, int fq) const {
        const int pn = u.pn; const int row0 = u.pm * 256 + wr * 64 + fr, cw = wc * 32 + 8 * fq;
        if (pn < 44) {
#pragma unroll
            for (int ai = 0; ai < 2; ++ai)
#pragma unroll
                for (int m = 0; m < 4; ++m) { bf16_t* rowp = ACT + (size_t)(row0 + ai * 128 + m * 16) * KX + 256 + pn * 128 + cw;
                    f32x4 g0 = acc[ai][0][m][0], g1 = acc[ai][0][m][1]; const f32x4 u0 = acc[ai][1][m][0], u1 = acc[ai][1][m][1];
#pragma unroll
                    for (int j = 0; j < 4; ++j) { g0[j] = g0[j] * sigm(g0[j]) * u0[j]; g1[j] = g1[j] * sigm(g1[j]) * u1[j]; }
                    u32x4 w; w.x = cvtpk_s(g0[0], g0[1]); w.y = cvtpk_s(g0[2], g0[3]); w.z = cvtpk_s(g1[0], g1[1]); w.w = cvtpk_s(g1[2], g1[3]);
                    *(u32x4*)rowp = w; }
        } else {
            const int colt = (pn - 44) * 256;
            f32x4 bv[2][2];
#pragma unroll
            for (int bj = 0; bj < 2; ++bj)
#pragma unroll
                for (int n = 0; n < 2; ++n) bv[bj][n] = *(const f32x4*)(b_pg + colt + bj * 128 + cw + 4 * n);
#pragma unroll
            for (int ai = 0; ai < 2; ++ai)
#pragma unroll
                for (int m = 0; m < 4; ++m) { bf16_t* rowp = GPG + (size_t)(row0 + ai * 128 + m * 16) * DM + colt + cw;
#pragma unroll
                    for (int bj = 0; bj < 2; ++bj) { f32x4 v0 = acc[ai][bj][m][0] + bv[bj][0], v1 = acc[ai][bj][m][1] + bv[bj][1];
                        act8(v0, v1, 4);
                        u32x4 w; w.x = cvtpk_s(v0[0], v0[1]); w.y = cvtpk_s(v0[2], v0[3]); w.z = cvtpk_s(v1[0], v1[1]); w.w = cvtpk_s(v1[2], v1[3]);
                        *(u32x4*)(rowp + bj * 128) = w; } }
        }
    }
};

struct EpiPle {
    static constexpr bool PERM = true, AFTER_DRAIN = false; static constexpr int HOOK_T = 0;
    bf16_t* O; const bf16_t* G;
    __device__ __forceinline__ void operator()(const f32x4 (&acc)[2][2][4][2], const Unit& u, int wr, int wc, int fr, int fq) const {
        const int row0 = u.pm * 256 + wr * 64 + fr, col0 = u.pn * 256 + wc * 32 + 8 * fq;
#pragma unroll
        for (int ai = 0; ai < 2; ++ai) {
            u32x4 rr[4][2];
#pragma unroll
            for (int m = 0; m < 4; ++m)
#pragma unroll
                for (int bj = 0; bj < 2; ++bj) rr[m][bj] = *(const u32x4*)(G + (size_t)(row0 + ai * 128 + m * 16) * DM + col0 + bj * 128);
#pragma unroll
            for (int m = 0; m < 4; ++m)
#pragma unroll
                for (int bj = 0; bj < 2; ++bj) { const size_t off = (size_t)(row0 + ai * 128 + m * 16) * DM + col0 + bj * 128; const u32x4 r = rr[m][bj];
                    const f32x4 v0 = acc[ai][bj][m][0] * (f32x4){bflo(r.x), bfhi(r.x), bflo(r.y), bfhi(r.y)}, v1 = acc[ai][bj][m][1] * (f32x4){bflo(r.z), bfhi(r.z), bflo(r.w), bfhi(r.w)};
                    u32x4 w; w.x = cvtpk_s(v0[0], v0[1]); w.y = cvtpk_s(v0[2], v0[3]); w.z = cvtpk_s(v1[0], v1[1]); w.w = cvtpk_s(v1[2], v1[3]);
                    *(u32x4*)(O + off) = w; }
            asm volatile("" ::: "memory");
        }
    }
};

__device__ __forceinline__ int dkmap32(int pos) { const int qq = pos >> 3, jj = pos & 7; return jj < 4 ? 4 * qq + jj : 16 + 4 * qq + (jj - 4); }
__device__ __forceinline__ void tr_item(const float* W, int ldw, int srccol0, int k0, bf16_t* WT, int ldt, int dstrow0, LAS float* scr, int lane, bool zero, int dk0 = 0, bool qperm = false) {
    if (!zero) {
        f32x4 tv[8];
#pragma unroll
        for (int i = 0; i < 8; ++i) tv[i] = *(const f32x4*)(W + (size_t)(k0 + 8 * i + (lane >> 3)) * ldw + srccol0 + 4 * (lane & 7));
#pragma unroll
        for (int i = 0; i < 8; ++i) { LAS float* d = scr + (8 * i + (lane >> 3)) * 33 + 4 * (lane & 7); d[0] = tv[i][0]; d[1] = tv[i][1]; d[2] = tv[i][2]; d[3] = tv[i][3]; }
    }
    LDS_WAIT();
    const int c = lane & 7;
#pragma unroll
    for (int j = 0; j < 4; ++j) { const int n = (lane >> 3) + 8 * j; const LAS float* s = scr + (8 * c) * 33 + (qperm ? dkmap32(n) : n);
        u32x4 o; o.x = cvtpk_s(s[0 * 33], s[1 * 33]); o.y = cvtpk_s(s[2 * 33], s[3 * 33]); o.z = cvtpk_s(s[4 * 33], s[5 * 33]); o.w = cvtpk_s(s[6 * 33], s[7 * 33]);
        if (zero) o = (u32x4){0u, 0u, 0u, 0u};
        *(u32x4*)(WT + (size_t)(dstrow0 + n) * ldt + dk0 + k0 + 8 * c) = o; }
    LDS_WAIT();
}
template <bool OUT_BF16> __device__ __forceinline__ void ln_row(const float* in, void* outp, const float* g, const float* b, int lane) {
    const f32x4* xr = (const f32x4*)in + lane;
    f32x4 v[8]; float s = 0.f;
#pragma unroll
    for (int j = 0; j < 8; ++j) { v[j] = xr[64 * j]; s += (v[j][0] + v[j][1]) + (v[j][2] + v[j][3]); }
    const float mean = wave_sum(s) * (1.f / DM); float s2 = 0.f;
#pragma unroll
    for (int j = 0; j < 8; ++j) { v[j] = v[j] - mean; s2 += (v[j][0] * v[j][0] + v[j][1] * v[j][1]) + (v[j][2] * v[j][2] + v[j][3] * v[j][3]); }
    const float rstd = 1.f / sqrtf(wave_sum(s2) * (1.f / DM) + LN_EPS);
#pragma unroll
    for (int j = 0; j < 8; ++j) { const f32x4 gg = ((const f32x4*)g)[64 * j + lane], bb = ((const f32x4*)b)[64 * j + lane]; const f32x4 o = v[j] * rstd * gg + bb;
        if (OUT_BF16) { u32x2 w; w.x = cvtpk_s(o[0], o[1]); w.y = cvtpk_s(o[2], o[3]); ((u32x2*)outp)[64 * j + lane] = w; }
        else ((f32x4*)outp)[64 * j + lane] = o; }
}
template <bool OUT_BF16, bool IN_BF16 = false> __device__ __forceinline__ void ln_row2(const void* in0, const void* in1, void* out0, void* out1, const float* g, const float* b, int lane) {
    f32x4 v[8], w[8]; float s = 0.f, t = 0.f;
    if (IN_BF16) { const u32x2* x0 = (const u32x2*)in0 + lane; const u32x2* x1 = (const u32x2*)in1 + lane; u32x2 a0[8], a1[8];
#pragma unroll
        for (int j = 0; j < 8; ++j) { a0[j] = x0[64 * j]; a1[j] = x1[64 * j]; }
#pragma unroll
        for (int j = 0; j < 8; ++j) { v[j] = (f32x4){bflo(a0[j].x), bfhi(a0[j].x), bflo(a0[j].y), bfhi(a0[j].y)}; w[j] = (f32x4){bflo(a1[j].x), bfhi(a1[j].x), bflo(a1[j].y), bfhi(a1[j].y)}; }
    } else { const f32x4* x0 = (const f32x4*)in0 + lane; const f32x4* x1 = (const f32x4*)in1 + lane;
#pragma unroll
        for (int j = 0; j < 8; ++j) { v[j] = x0[64 * j]; w[j] = x1[64 * j]; } }
#pragma unroll
    for (int j = 0; j < 8; ++j) { s += (v[j][0] + v[j][1]) + (v[j][2] + v[j][3]); t += (w[j][0] + w[j][1]) + (w[j][2] + w[j][3]); }
#pragma unroll
    for (int o = 1; o < 64; o <<= 1) { s += __shfl_xor(s, o); t += __shfl_xor(t, o); }
    const float m0 = s * (1.f / DM), m1 = t * (1.f / DM); float s2 = 0.f, t2 = 0.f;
#pragma unroll
    for (int j = 0; j < 8; ++j) { v[j] = v[j] - m0; w[j] = w[j] - m1; s2 += (v[j][0] * v[j][0] + v[j][1] * v[j][1]) + (v[j][2] * v[j][2] + v[j][3] * v[j][3]); t2 += (w[j][0] * w[j][0] + w[j][1] * w[j][1]) + (w[j][2] * w[j][2] + w[j][3] * w[j][3]); }
#pragma unroll
    for (int o = 1; o < 64; o <<= 1) { s2 += __shfl_xor(s2, o); t2 += __shfl_xor(t2, o); }
    const float r0 = 1.f / sqrtf(s2 * (1.f / DM) + LN_EPS), r1 = 1.f / sqrtf(t2 * (1.f / DM) + LN_EPS);
#pragma unroll
    for (int j = 0; j < 8; ++j) { const f32x4 gg = ((const f32x4*)g)[64 * j + lane], bb = ((const f32x4*)b)[64 * j + lane]; const f32x4 o0 = v[j] * r0 * gg + bb, o1 = w[j] * r1 * gg + bb;
        if (OUT_BF16) { u32x2 p; p.x = cvtpk_s(o0[0], o0[1]); p.y = cvtpk_s(o0[2], o0[3]); ((u32x2*)out0)[64 * j + lane] = p; p.x = cvtpk_s(o1[0], o1[1]); p.y = cvtpk_s(o1[2], o1[3]); ((u32x2*)out1)[64 * j + lane] = p; }
        else { ((f32x4*)out0)[64 * j + lane] = o0; ((f32x4*)out1)[64 * j + lane] = o1; } }
}

__device__ __forceinline__ void phase_prep(const Args& a, LAS unsigned char* lds, int gw, int ngw, int wave, int lane) {
    LAS float* scr = (LAS float*)(lds + wave * 8448);
    bf16_t* W1T = (bf16_t*)(a.ws + OFF_W1T); bf16_t* WOT = (bf16_t*)(a.ws + OFF_WOT);
    constexpr int I1 = 32 * (N1 / 32), IO = 32 * 64;
    for (int it = gw; it < I1 + IO; it += ngw) {
        if (it < I1) { const int kb = it / (N1 / 32), nb = it % (N1 / 32), n0 = nb * 32;
            const bool zero = n0 >= 14400; int src;
            if (n0 < 4096) src = n0;
            else if (n0 < 8192) { const int t = (n0 - 4096) >> 8, wi = n0 & 255; src = wi < 128 ? 4096 + 128 * t + wi : 10304 + 128 * t + (wi - 128); }
            else if (n0 < 12288) { const int t = (n0 - 8192) >> 8, wi = n0 & 255; src = wi < 128 ? 6208 + 128 * t + wi : 12352 + 128 * t + (wi - 128); }
            else if (n0 < 14336) src = 8256 + (n0 - 12288);
            else src = 6144 + (n0 - 14336);
            tr_item(a.w_in, 14400, zero ? 0 : src, kb * 64, W1T, 2048, n0, scr, lane, zero, 0, n0 < 1024); }
        else { const int r = it - I1, kb = r / 64, nb = r % 64; tr_item(a.w_o, 2048, nb * 32, kb * 64, WOT, 2048, nb * 32, scr, lane, false); }
    }
    bf16_t* H0 = (bf16_t*)(a.ws + OFF_H0);
    for (int m = gw; m < MTOK; m += 2 * ngw) ln_row2<true>(a.x + (size_t)m * DM, a.x + (size_t)(m + ngw) * DM, H0 + (size_t)m * DM, H0 + (size_t)(m + ngw) * DM, a.ln0_g, a.ln0_b, lane);
}
__device__ __forceinline__ void phase_prep2(const Args& a, LAS unsigned char* lds, int gw, int ngw, int wave, int lane) {
    LAS float* scr = (LAS float*)(lds + wave * 8448);
    bf16_t* WGUT = (bf16_t*)(a.out + DO_WGUT); bf16_t* WDT = (bf16_t*)(a.out + DO_WDT);
    constexpr int IG = 32 * (NGU / 32), ID = 88 * 64, IP = 4 * 64;
    for (int it = gw; it < IG + ID + IP; it += ngw) {
        if (it < IG) { const int kb = it / (NGU / 32), nb = it % (NGU / 32), n0 = nb * 32, t = n0 >> 8, wi = n0 & 255;
            if (t < 44) tr_item(a.w_gu, 2 * DFF, wi < 128 ? t * 128 + wi : DFF + t * 128 + (wi - 128), kb * 64, WGUT, 2048, n0, scr, lane, false);
            else tr_item(a.w_pg, 2048, (t - 44) * 256 + wi, kb * 64, WGUT, 2048, n0, scr, lane, false); }
        else if (it < IG + ID) { const int r = it - IG, kb = r / 64, nb = r % 64; tr_item(a.w_down, 2048, nb * 32, kb * 64, WDT, KX, nb * 32, scr, lane, false, 256); }
        else { const int r = it - IG - ID, kb = r / 64, nb = r % 64; tr_item(a.w_pu, 2048, nb * 32, kb * 64, WDT, KX, nb * 32, scr, lane, false, 0); }
    }
}
__device__ __forceinline__ void phase_pconv(const Args& a, int gw, int ngw, int lane) {
    bf16_t* ACT = (bf16_t*)(a.ws + OFF_ACT);
    for (int i = gw * 64 + lane; i < MTOK * 64; i += ngw * 64) { const int m = i >> 6, c4 = (i & 63) * 4; const f32x4 v = *(const f32x4*)(a.p + (size_t)m * 256 + c4);
        u32x2 w; w.x = cvtpk_s(v[0], v[1]); w.y = cvtpk_s(v[2], v[3]); *(u32x2*)(ACT + (size_t)m * KX + c4) = w; }
}

__device__ __forceinline__ void phase_kt(const Args& a, LAS unsigned char* lds, int tid) {
    LAS float* fgs = (LAS float*)(lds + 131072);
    bf16_t* Kb = (bf16_t*)(a.ws + OFF_K); const float* FG = (const float*)(a.ws + OFF_FG); float* DEC = (float*)(a.out + DO_DEC);
    const int col2 = 2 * tid, h = col2 >> 8, d = col2 & 255;
    float w0[16], w1[16];
#pragma unroll
    for (int r = 0; r < 16; ++r) { const float2 t = *(const float2*)(a.w_f2 + (h * 16 + r) * 256 + d); w0[r] = t.x; w1[r] = t.y; }
    const float2 bb = *(const float2*)(a.b_f2 + h * 256 + d);
    for (int it = blockIdx.x; it < NCHUNK; it += gridDim.x) {
        const size_t row0 = (size_t)it * 64;
        __syncthreads();
#pragma unroll
        for (int i = 0; i < 2; ++i) { const int p = tid + 512 * i; ((LAS f32x4*)fgs)[p] = ((const f32x4*)(FG + row0 * 64))[p]; }
        __syncthreads();
        float run0 = 0.f, run1 = 0.f;
        unsigned kwc[8], kwn[8];
#pragma unroll
        for (int tt = 0; tt < 8; ++tt) { kwc[tt] = *(const unsigned*)(Kb + (row0 + 56 + tt) * 1024 + col2); kwn[tt] = 0u; }
        for (int tg = 7; tg >= 0; --tg) {
            if (tg > 0) {
#pragma unroll
                for (int tt = 0; tt < 8; ++tt) kwn[tt] = *(const unsigned*)(Kb + (row0 + (tg - 1) * 8 + tt) * 1024 + col2); }
            float v0[8], v1[8];
#pragma unroll
            for (int tt = 7; tt >= 0; --tt) { const int t = tg * 8 + tt;
                const LAS f32x4* fp = (const LAS f32x4*)(fgs + t * 64 + h * 16);
                float f0 = bb.x, f1 = bb.y;
#pragma unroll
                for (int r4 = 0; r4 < 4; ++r4) { const f32x4 fv = fp[r4];
#pragma unroll
                    for (int j = 0; j < 4; ++j) { f0 += fv[j] * w0[r4 * 4 + j]; f1 += fv[j] * w1[r4 * 4 + j]; } }
                const float la0 = (fminf(f0, 0.f) - __logf(1.f + __expf(-fabsf(f0)))) * 0.0625f, la1 = (fminf(f1, 0.f) - __logf(1.f + __expf(-fabsf(f1)))) * 0.0625f;
                const unsigned kw = kwc[tt];
                v0[tt] = bflo(kw) * __expf(run0); v1[tt] = bfhi(kw) * __expf(run1);
                run0 += la0; run1 += la1; }
            u32x4 p0, p1;
            p0.x = cvtpk_s(v0[0], v0[1]); p0.y = cvtpk_s(v0[2], v0[3]); p0.z = cvtpk_s(v0[4], v0[5]); p0.w = cvtpk_s(v0[6], v0[7]);
            p1.x = cvtpk_s(v1[0], v1[1]); p1.y = cvtpk_s(v1[2], v1[3]); p1.z = cvtpk_s(v1[4], v1[5]); p1.w = cvtpk_s(v1[6], v1[7]);
            *(LAS u32x4*)(lds + col2 * 128 + ((tg ^ (col2 & 7)) << 4)) = p0;
            *(LAS u32x4*)(lds + (col2 + 1) * 128 + ((tg ^ ((col2 + 1) & 7)) << 4)) = p1;
#pragma unroll
            for (int tt = 0; tt < 8; ++tt) kwc[tt] = kwn[tt];
        }
        *(float2*)(DEC + (size_t)it * 1024 + col2) = make_float2(__expf(run0), __expf(run1));
        __syncthreads();
#pragma unroll
        for (int i = 0; i < 16; ++i) { const int p = tid + 512 * i, c = p >> 3, s = p & 7;
            *(u32x4*)(Kb + (size_t)it * 65536 + c * 64 + s * 8) = *(const LAS u32x4*)(lds + c * 128 + ((s ^ (c & 7)) << 4)); }
    }
    __syncthreads();
}

__device__ __forceinline__ void phase_scan(const Args& a, LAS unsigned char* lds, int tid, int wave, int lane) {
    const int bx = blockIdx.x, xcd = bx & 7, jj = bx >> 3, bh = xcd * 2 + (jj >> 3), b = bh >> 2, h = bh & 3, dvb = jj & 7, l15 = lane & 15, q = lane >> 4;
    constexpr int KTB = 0, QB = 65536, VB = 131072, DB = 147456;
    const bf16_t* KT = (const bf16_t*)(a.ws + OFF_K) + (size_t)(b * 128) * 65536 + h * 16384;
    const bf16_t* Qg = (const bf16_t*)(a.ws + OFF_Q) + (size_t)(b * 8192) * 1024 + h * 256;
    bf16_t* Vg = (bf16_t*)(a.ws + OFF_V) + (size_t)(b * 8192) * 2048 + h * 512 + dvb * 64;
    const float* DEC = (const float*)(a.out + DO_DEC) + (size_t)(b * 128) * 1024 + h * 256;
#define SBAR() do { asm volatile("s_waitcnt lgkmcnt(0)" ::: "memory"); __builtin_amdgcn_s_barrier(); asm volatile("" ::: "memory"); } while (0)
    if (wave >= 4) {
        const int lw = wave - 4;
        const unsigned kvo = (unsigned)(((lane >> 3) * 64 + (((lane & 7) ^ ((lane >> 3) & 7)) << 3)) * 2);
        unsigned qvo[8];
#pragma unroll
        for (int i = 0; i < 8; ++i) { const int frl = 2 * i + (lane >> 5); qvo[i] = (unsigned)(((lw * 16 + frl) * 1024 + (((lane & 31) ^ (frl & 15)) << 3)) * 2); }
        const unsigned vvo = (unsigned)(((lane >> 3) * 2048 + (lane & 7) * 8) * 2);
#define G1(cc) do { const int c_ = (cc) > 127 ? 127 : (cc); const char* qb_ = (const char*)(Qg + (size_t)c_ * 65536); LAS unsigned char* d_ = lds + QB + ((cc) & 1) * 32768 + lw * 8192; \
            _Pragma("unroll") for (int i = 0; i < 8; ++i) __builtin_amdgcn_global_load_lds((const unsigned*)(qb_ + qvo[i]), (LAS unsigned*)(d_ + i * 1024), 16, 0, 0); } while (0)
#define G2(cc) do { const int c_ = (cc) > 127 ? 127 : (cc); const char* kb_ = (const char*)(KT + (size_t)c_ * 65536) + lw * 8192; LAS unsigned char* d_ = lds + KTB + ((cc) & 1) * 32768 + lw * 8192; \
            _Pragma("unroll") for (int i = 0; i < 8; ++i) __builtin_amdgcn_global_load_lds((const unsigned*)(kb_ + i * 1024 + kvo), (LAS unsigned*)(d_ + i * 1024), 16, 0, 0); \
            const char* vb_ = (const char*)(Vg + (size_t)(c_ * 64 + lw * 16) * 2048); LAS unsigned char* dv_ = lds + VB + ((cc) & 1) * 8192 + lw * 2048; \
            _Pragma("unroll") for (int i = 0; i < 2; ++i) __builtin_amdgcn_global_load_lds((const unsigned*)(vb_ + (size_t)i * 8 * 2048 * 2 + vvo), (LAS unsigned*)(dv_ + i * 1024), 16, 0, 0); \
            __builtin_amdgcn_global_load_lds((const unsigned*)(DEC + (size_t)c_ * 1024 + lw * 64 + lane), (LAS unsigned*)(lds + DB + ((cc) & 1) * 1024 + lw * 256), 4, 0, 0); } while (0)
        G2(0); G1(0); G2(1);
        for (int c = 0; c < 128; ++c) {
            asm volatile("s_waitcnt vmcnt(19)" ::: "memory");
            SBAR();
            G1(c + 1);
            asm volatile("s_waitcnt vmcnt(19)" ::: "memory");
            SBAR();
            G2(c + 2);
        }
        asm volatile("s_waitcnt vmcnt(0)" ::: "memory");
#undef G1
#undef G2
    } else {
        const unsigned ovo = (unsigned)((l15 * 2048 + 16 * wave + 4 * q) * 2);
        f32x4 accS[16];
#pragma unroll
        for (int i = 0; i < 16; ++i) accS[i] = (f32x4){0.f, 0.f, 0.f, 0.f};
        for (int c = 0; c < 128; ++c) {
            LAS unsigned char* KTs = lds + KTB + (c & 1) * 32768; LAS unsigned char* Qs = lds + QB + (c & 1) * 32768;
            const LAS unsigned short* Vs = (const LAS unsigned short*)(lds + VB + (c & 1) * 8192); LAS float* DECs = (LAS float*)(lds + DB + (c & 1) * 1024);
            SBAR();
            bf16x8 vb0, vb1;
            { const LAS unsigned short* vp = Vs + (8 * q) * 64 + 16 * wave + l15; unsigned w0[4], w1[4];
#pragma unroll
              for (int e = 0; e < 4; ++e) { w0[e] = (unsigned)vp[(2 * e) * 64] | ((unsigned)vp[(2 * e + 1) * 64] << 16); w1[e] = (unsigned)vp[(32 + 2 * e) * 64] | ((unsigned)vp[(32 + 2 * e + 1) * 64] << 16); }
              vb0 = __builtin_bit_cast(bf16x8, (u32x4){w0[0], w0[1], w0[2], w0[3]}); vb1 = __builtin_bit_cast(bf16x8, (u32x4){w1[0], w1[1], w1[2], w1[3]}); }
#define SCAN_KTLD(A0, A1, D, bt) do { _Pragma("unroll") for (int t = 0; t < 4; ++t) { const int dk = 16 * (4 * (bt) + t) + l15; \
                A0[t] = *(const LAS bf16x8*)(KTs + dk * 128 + ((q ^ (dk & 7)) << 4)); A1[t] = *(const LAS bf16x8*)(KTs + dk * 128 + (((4 + q) ^ (dk & 7)) << 4)); \
                D[t] = *(const LAS f32x4*)(DECs + 16 * (4 * (bt) + t) + 4 * q); } } while (0)
#define SCAN_KTMM(A0, A1, D, bt) do { _Pragma("unroll") for (int t = 0; t < 4; ++t) accS[4 * (bt) + t] = __builtin_amdgcn_mfma_f32_16x16x32_bf16(A0[t], vb0, accS[4 * (bt) + t] * D[t], 0, 0, 0); \
            _Pragma("unroll") for (int t = 0; t < 4; ++t) accS[4 * (bt) + t] = __builtin_amdgcn_mfma_f32_16x16x32_bf16(A1[t], vb1, accS[4 * (bt) + t], 0, 0, 0); } while (0)
            {
                bf16x8 xa0[4], xa1[4], ya0[4], ya1[4]; f32x4 xd[4], yd[4];
                SCAN_KTLD(xa0, xa1, xd, 0); __builtin_amdgcn_sched_barrier(0);
                SCAN_KTLD(ya0, ya1, yd, 1); __builtin_amdgcn_sched_barrier(0);
                SCAN_KTMM(xa0, xa1, xd, 0); __builtin_amdgcn_sched_barrier(0);
                SCAN_KTLD(xa0, xa1, xd, 2); __builtin_amdgcn_sched_barrier(0);
                SCAN_KTMM(ya0, ya1, yd, 1); __builtin_amdgcn_sched_barrier(0);
                SCAN_KTLD(ya0, ya1, yd, 3); __builtin_amdgcn_sched_barrier(0);
                SCAN_KTMM(xa0, xa1, xd, 2); __builtin_amdgcn_sched_barrier(0);
                SCAN_KTMM(ya0, ya1, yd, 3); __builtin_amdgcn_sched_barrier(0);
            }
            bf16x8 sf[8];
#pragma unroll
            for (int ks = 0; ks < 8; ++ks) { u32x4 w; w.x = cvtpk_s(accS[2 * ks][0], accS[2 * ks][1]); w.y = cvtpk_s(accS[2 * ks][2], accS[2 * ks][3]);
                w.z = cvtpk_s(accS[2 * ks + 1][0], accS[2 * ks + 1][1]); w.w = cvtpk_s(accS[2 * ks + 1][2], accS[2 * ks + 1][3]); sf[ks] = __builtin_bit_cast(bf16x8, w); }
            SBAR();
            f32x4 o[4];
#pragma unroll
            for (int ft = 0; ft < 4; ++ft) o[ft] = (f32x4){0.f, 0.f, 0.f, 0.f};
#define SCAN_QLD(Q, kb) do { _Pragma("unroll") for (int k2 = 0; k2 < 2; ++k2) _Pragma("unroll") for (int ft = 0; ft < 4; ++ft) { const int fr = 16 * ft + l15, pc = 4 * (2 * (kb) + k2) + q; \
                Q[k2 * 4 + ft] = *(const LAS u32x4*)(Qs + fr * 512 + ((pc ^ (fr & 15)) << 4)); } } while (0)
#define SCAN_QMM(Q, kb) do { _Pragma("unroll") for (int k2 = 0; k2 < 2; ++k2) _Pragma("unroll") for (int ft = 0; ft < 4; ++ft) \
                o[ft] = __builtin_amdgcn_mfma_f32_16x16x32_bf16(sf[2 * (kb) + k2], __builtin_bit_cast(bf16x8, Q[k2 * 4 + ft]), o[ft], 0, 0, 0); } while (0)
            {
                u32x4 xq[8], yq[8];
                SCAN_QLD(xq, 0); __builtin_amdgcn_sched_barrier(0);
                SCAN_QLD(yq, 1); __builtin_amdgcn_sched_barrier(0);
                SCAN_QMM(xq, 0); __builtin_amdgcn_sched_barrier(0);
                SCAN_QLD(xq, 2); __builtin_amdgcn_sched_barrier(0);
                SCAN_QMM(yq, 1); __builtin_amdgcn_sched_barrier(0);
                SCAN_QLD(yq, 3); __builtin_amdgcn_sched_barrier(0);
                SCAN_QMM(xq, 2); __builtin_amdgcn_sched_barrier(0);
                SCAN_QMM(yq, 3); __builtin_amdgcn_sched_barrier(0);
            }
#undef SCAN_KTLD
#undef SCAN_KTMM
#undef SCAN_QLD
#undef SCAN_QMM
#pragma unroll
            for (int ft = 0; ft < 4; ++ft) { u32x2 w; w.x = cvtpk_s(o[ft][0], o[ft][1]); w.y = cvtpk_s(o[ft][2], o[ft][3]);
                *(u32x2*)((char*)(Vg + (size_t)(c * 64 + 16 * ft) * 2048) + ovo) = w; }
        }
    }
    SBAR();
#undef SBAR
}

__device__ __forceinline__ void phase_merge(const Args& a, LAS unsigned char* lds, int tid, int wave, int lane) {
    const int g = blockIdx.x & 3, l15 = lane & 15, q = lane >> 4;
    LAS unsigned char* Ws = lds; LAS unsigned char* ZT = lds + 32768; LAS float* SG = (LAS float*)(lds + 65536); LAS float* MU = (LAS float*)(lds + 65536 + 67584); LAS float* RS = MU + 128; LAS float* RO = MU + 256;
    const bf16_t* Zb = (const bf16_t*)(a.ws + OFF_Z); const bf16_t* Ob = (const bf16_t*)(a.ws + OFF_V); const bf16_t* OGb = (const bf16_t*)(a.ws + OFF_OG);
    bf16_t* Ub = (bf16_t*)(a.ws + OFF_U);
    for (int p = tid; p < 4096; p += 512) { const int i = p >> 5, j4 = (p & 31) * 4; f32x4 v = *(const f32x4*)(a.w_s + (size_t)g * 16384 + i * 128 + j4);
        if ((j4 >> 6) > (i >> 6)) v = (f32x4){0.f, 0.f, 0.f, 0.f};
        u32x2 w; w.x = cvtpk_s(v[0], v[1]); w.y = cvtpk_s(v[2], v[3]);
        *(LAS u32x2*)(Ws + i * 256 + (((j4 >> 3) ^ (i & 7)) << 4) + (j4 & 4) * 2) = w; }
    for (int item = blockIdx.x; item < 1024; item += gridDim.x) {
        const int nb = item >> 2; const size_t row0 = (size_t)nb * 128; const int colg = g * 512;
        __syncthreads();
#pragma unroll 4
        for (int rr = 0; rr < 16; ++rr) { const int i = wave * 16 + rr; const size_t off = (row0 + i) * DM + colg + lane * 8;
            const u32x4 zw = *(const u32x4*)(Zb + off), ow = *(const u32x4*)(Ob + off);
            float z[8] = {bflo(zw.x), bfhi(zw.x), bflo(zw.y), bfhi(zw.y), bflo(zw.z), bfhi(zw.z), bflo(zw.w), bfhi(zw.w)};
            const float o[8] = {bflo(ow.x), bfhi(ow.x), bflo(ow.y), bfhi(ow.y), bflo(ow.z), bfhi(ow.z), bflo(ow.w), bfhi(ow.w)};
            float s = 0.f, so = 0.f;
#pragma unroll
            for (int e = 0; e < 8; ++e) { s += z[e]; so += o[e] * o[e]; }
            const float mean = wave_sum(s) * (1.f / 512.f); so = wave_sum(so); float s2 = 0.f;
#pragma unroll
            for (int e = 0; e < 8; ++e) { const float dd = z[e] - mean; s2 += dd * dd; }
            s2 = wave_sum(s2);
            if (lane == 0) { MU[i] = mean; RS[i] = 1.f / sqrtf(s2 * (1.f / 512.f) + LN_EPS); RO[i] = 1.f / sqrtf(so * (1.f / 512.f) + LN_EPS); } }
        __syncthreads();
        for (int cc = 0; cc < 4; ++cc) {
            const int colc = colg + cc * 128;
            u32x4 uw4[4], ow4[4], gw4[4];
#pragma unroll
            for (int k = 0; k < 4; ++k) { const int p = tid + 512 * k, i = p >> 4, c8 = (p & 15) * 8; const size_t off = (row0 + i) * DM + colc + c8;
                uw4[k] = *(const u32x4*)(Ub + off); ow4[k] = *(const u32x4*)(Ob + off); gw4[k] = *(const u32x4*)(OGb + off); }
#pragma unroll
            for (int i = 0; i < 4; ++i) { const int p = tid + 512 * i, j = p >> 4, c8 = (p & 15) * 8;
                const u32x4 zw = *(const u32x4*)(Zb + (row0 + j) * DM + colc + c8);
                const float z[8] = {bflo(zw.x), bfhi(zw.x), bflo(zw.y), bfhi(zw.y), bflo(zw.z), bfhi(zw.z), bflo(zw.w), bfhi(zw.w)};
                const float mu = MU[j], rs = RS[j];
                const f32x4 g0 = *(const f32x4*)(a.gm_g + colc + c8), g1 = *(const f32x4*)(a.gm_g + colc + c8 + 4), b0 = *(const f32x4*)(a.gm_b + colc + c8), b1 = *(const f32x4*)(a.gm_b + colc + c8 + 4);
#pragma unroll
                for (int e = 0; e < 8; ++e) { const float gg = e < 4 ? g0[e & 3] : g1[e & 3], bb = e < 4 ? b0[e & 3] : b1[e & 3]; const float zn = (z[e] - mu) * rs * gg + bb;
                    const int c = c8 + e; const unsigned short val = (unsigned short)(cvtpk_s(zn, 0.f) & 0xffffu);
                    *(LAS unsigned short*)(ZT + c * 256 + (((j >> 3) ^ (c & 7)) << 4) + (j & 7) * 2) = val; } }
            __syncthreads();
            {
                const int c = 16 * wave + l15; bf16x8 zf[4];
#pragma unroll
                for (int ks = 0; ks < 4; ++ks) zf[ks] = *(const LAS bf16x8*)(ZT + c * 256 + (((4 * ks + q) ^ (c & 7)) << 4));
#pragma unroll
                for (int it = 0; it < 8; ++it) { const int i = 16 * it + l15; f32x4 acc = (f32x4){0.f, 0.f, 0.f, 0.f};
#pragma unroll
                    for (int ks = 0; ks < 4; ++ks) { if (it < 4 && ks >= 2) continue;
                        const bf16x8 wf = *(const LAS bf16x8*)(Ws + i * 256 + (((4 * ks + q) ^ (i & 7)) << 4));
                        acc = __builtin_amdgcn_mfma_f32_16x16x32_bf16(wf, zf[ks], acc, 0, 0, 0); }
#pragma unroll
                    for (int r = 0; r < 4; ++r) SG[(16 * it + 4 * q + r) * 132 + c] = acc[r]; }
            }
            __syncthreads();
#pragma unroll
            for (int k = 0; k < 4; ++k) { const int p = tid + 512 * k, i = p >> 4, c8 = (p & 15) * 8; const size_t off = (row0 + i) * DM + colc + c8;
                const u32x4 uw = uw4[k], ow = ow4[k], gw = gw4[k];
                const f32x4 s0 = *(const LAS f32x4*)(SG + i * 132 + c8), s1 = *(const LAS f32x4*)(SG + i * 132 + c8 + 4);
                const f32x4 n0 = *(const f32x4*)(a.gla_g + colc + c8), n1 = *(const f32x4*)(a.gla_g + colc + c8 + 4);
                const float bs = a.b_s[g * 128 + i], ro = RO[i];
                const unsigned uu[4] = {uw.x, uw.y, uw.z, uw.w}, oo[4] = {ow.x, ow.y, ow.z, ow.w}, gg[4] = {gw.x, gw.y, gw.z, gw.w};
                float m[8];
#pragma unroll
                for (int e = 0; e < 8; ++e) { const int wi = e >> 1; const bool hi = e & 1;
                    const float uv = hi ? bfhi(uu[wi]) : bflo(uu[wi]), ov = hi ? bfhi(oo[wi]) : bflo(oo[wi]), gv = hi ? bfhi(gg[wi]) : bflo(gg[wi]);
                    const float sg = (e < 4 ? s0[e & 3] : s1[e & 3]) + bs, ng = e < 4 ? n0[e & 3] : n1[e & 3];
                    m[e] = gv * (ov * ro * ng) + uv * sg; }
                u32x4 w; w.x = cvtpk_s(m[0], m[1]); w.y = cvtpk_s(m[2], m[3]); w.z = cvtpk_s(m[4], m[5]); w.w = cvtpk_s(m[6], m[7]);
                *(u32x4*)(Ub + off) = w; }
        }
    }
    __syncthreads();
}

typedef __attribute__((address_space(1))) unsigned gu32;
#define XB_TMO      128
#define XB_XCNT(j)  (256  + 64 * (j))
#define XB_XSUB(j)  (1280 + 64 * (j))
#define XB_XGEN(j)  (2304 + 64 * (j))
#define XB_TOP      3328
#define XB_TOPGEN   3392
#define XCD_BAR_WORDS 3456
#define XB_SPIN_CAP (1u << 18)

__device__ __forceinline__ unsigned xb_ld(unsigned* p)              { return __hip_atomic_load(p, __ATOMIC_RELAXED, __HIP_MEMORY_SCOPE_AGENT); }
__device__ __forceinline__ unsigned xb_add(unsigned* p, unsigned v) { return __hip_atomic_fetch_add(p, v, __ATOMIC_RELAXED, __HIP_MEMORY_SCOPE_AGENT); }
__device__ __forceinline__ unsigned xb_xcc_id() { return (unsigned)__builtin_amdgcn_s_getreg((3 << 11) | 20) & 0xFu; }
#define XB_SPIN(cond, bar) do { unsigned _sp = 0; while (cond) { __builtin_amdgcn_s_sleep(1); \
    if ((++_sp & 255u) == 0u) { if (xb_ld(&(bar)[XB_TMO])) break; if (_sp > XB_SPIN_CAP) { atomicAdd(&(bar)[XB_TMO], 1u); break; } } } } while (0)

struct XcdBarrier {
    unsigned* bar; unsigned x;
    volatile LAS unsigned* st;
};

__device__ __forceinline__ XcdBarrier xcd_barrier_post(unsigned* bar, volatile LAS unsigned* st) {
    XcdBarrier b; b.bar = bar; b.x = xb_xcc_id(); b.st = st;
    if (threadIdx.x == 0) (void)xb_add(&bar[XB_XCNT(b.x)], 1u);
    return b;
}
__device__ __forceinline__ void xcd_barrier_complete(unsigned* bar, unsigned x, unsigned& nloc, unsigned& nx) {
    const unsigned G = gridDim.x * gridDim.y * gridDim.z;
    unsigned sum, cnt, mine, sp = 0u;
    for (;;) {
        sum = 0u; cnt = 0u; mine = 0u;
#pragma unroll
        for (unsigned j = 0; j < 16; ++j) { const unsigned c = xb_ld(&bar[XB_XCNT(j)]); sum += c; cnt += (c > 0u) ? 1u : 0u; mine = (j == x) ? c : mine; }
        if (sum == G) break;
        __builtin_amdgcn_s_sleep(1);
        if ((++sp & 255u) == 0u) { if (xb_ld(&bar[XB_TMO])) break; if (sp > XB_SPIN_CAP) { atomicAdd(&bar[XB_TMO], 1u); break; } }
    }
    nloc = mine > 0u ? mine : 1u; nx = cnt > 0u ? cnt : 1u;
}

__device__ __forceinline__ void xcd_barrier(const XcdBarrier& b) {
    asm volatile("s_waitcnt vmcnt(0)" ::: "memory");
    __syncthreads();
    if (threadIdx.x == 0) {
        unsigned* bar = b.bar;
        __builtin_amdgcn_s_waitcnt(0);
        unsigned nloc = b.st[0], nx = b.st[1];
        if (nloc == 0u) { xcd_barrier_complete(bar, b.x, nloc, nx); b.st[0] = nloc; b.st[1] = nx; }
        const unsigned old = xb_add(&bar[XB_XSUB(b.x)], 1u);
        const unsigned gen = old / nloc;
        if (old + 1u == (gen + 1u) * nloc) {
            __builtin_amdgcn_fence(__ATOMIC_RELEASE, "agent");
            asm volatile("s_waitcnt vmcnt(0)" ::: "memory");
            const unsigned og = xb_add(&bar[XB_TOP], 1u);
            const unsigned tg = og / nx;
            if (og + 1u == (tg + 1u) * nx) xb_add(&bar[XB_TOPGEN], 1u);
            else XB_SPIN(xb_ld(&bar[XB_TOPGEN]) == tg, bar);
            __builtin_amdgcn_fence(__ATOMIC_ACQUIRE, "agent");
            xb_add(&bar[XB_XGEN(b.x)], 1u);
            asm volatile("s_waitcnt vmcnt(0)" ::: "memory");
        } else {
            XB_SPIN(xb_ld(&bar[XB_XGEN(b.x)]) == gen, bar);
            __builtin_amdgcn_fence(__ATOMIC_ACQUIRE, "agent");
            asm volatile("s_waitcnt vmcnt(0)" ::: "memory");
        }
    }
    __syncthreads();
}


__global__ void __launch_bounds__(512, 2) mega(Args a) {
    extern __shared__ __attribute__((aligned(16))) unsigned char lds_raw[];
    LAS unsigned char* lds = (LAS unsigned char*)lds_raw;
    const int tid = threadIdx.x, lane = tid & 63, wave = __builtin_amdgcn_readfirstlane(tid >> 6);
    const int G = gridDim.x, gw = blockIdx.x * 8 + wave, ngw = G * 8;
    const int lo = a.ph_lo, hi = a.ph_hi;
    if (tid < 16) ((LAS unsigned*)(lds + LDS_BARW))[tid] = 0u;
    __syncthreads();
    XcdBarrier bar; bar.bar = (unsigned*)(a.ws + OFF_CTL); bar.x = 0; bar.st = nullptr;
    if (a.coop) bar = xcd_barrier_post((unsigned*)(a.ws + OFF_CTL), (volatile LAS unsigned*)(lds + LDS_BARW));
#define IN(k) (lo <= (k) && (k) < hi)
#define SEAM(k) do { if (IN(k) && IN((k) + 1)) { if ((k) == 0) cg::this_grid().sync(); else xcd_barrier(bar); } } while (0)
    if (IN(0)) { phase_prep(a, lds, gw, ngw, wave, lane); __syncthreads(); }
    SEAM(0);
    if (IN(1)) { pg8::Gemm gm{(const bf16_t*)(a.ws + OFF_H0), (const bf16_t*)(a.ws + OFF_W1T), MTOK, N1, DM}; pg8::StaticOrder S; S.init(MTOK, N1, G, (int)blockIdx.x);
        Epi1 E{a.ws, a.out, a.b_in};
        pg8::gemm_phase<Epi1, pg8::StaticOrder, true, true>(lds, gm, S, E); }
    SEAM(1);
    if (IN(2)) phase_kt(a, lds, tid);
    SEAM(2);
    if (IN(3)) { if (blockIdx.x < 128) phase_scan(a, lds, tid, wave, lane); else { phase_prep2(a, lds, (blockIdx.x - 128) * 8 + wave, (G - 128) * 8, wave, lane); __syncthreads(); } }
    SEAM(3);
    if (IN(4)) phase_merge(a, lds, tid, wave, lane);
    SEAM(4);
    if (IN(5)) { pg8::Gemm gm{(const bf16_t*)(a.ws + OFF_U), (const bf16_t*)(a.ws + OFF_WOT), MTOK, DM, DM}; pg8::StaticOrder S; S.init(MTOK, DM, G, (int)blockIdx.x);
        EpiRes<false> E{(bf16_t*)(a.ws + OFF_H1PRE), (const bf16_t*)(a.ws + OFF_H0), nullptr};
        pg8::gemm_phase<EpiRes<false>, pg8::StaticOrder, true, true>(lds, gm, S, E); }
    SEAM(5);
    if (IN(6)) { const bf16_t* src = (const bf16_t*)(a.ws + OFF_H1PRE); bf16_t* H1 = (bf16_t*)(a.ws + OFF_H1);
        for (int m = gw; m < MTOK; m += 2 * ngw) ln_row2<true, true>(src + (size_t)m * DM, src + (size_t)(m + ngw) * DM, H1 + (size_t)m * DM, H1 + (size_t)(m + ngw) * DM, a.ln1_g, a.ln1_b, lane); }
    SEAM(6);
    if (IN(7)) { phase_pconv(a, gw, ngw, lane);
        pg8::Gemm gm{(const bf16_t*)(a.ws + OFF_H1), (const bf16_t*)(a.out + DO_WGUT), MTOK, NGU, DM}; pg8::StaticOrder S; S.init(MTOK, NGU, G, (int)blockIdx.x);
        Epi5 E{(bf16_t*)(a.ws + OFF_ACT), (bf16_t*)(a.ws + OFF_GPG), a.b_pg};
        pg8::gemm_phase<Epi5, pg8::StaticOrder, true, true>(lds, gm, S, E); }
    SEAM(7);
    if (IN(9)) { pg8::Gemm gm{(const bf16_t*)(a.ws + OFF_ACT), (const bf16_t*)(a.out + DO_WDT), MTOK, DM, KX}; pg8::StaticOrder S; S.init(MTOK, DM, G, (int)blockIdx.x);
        EpiDown E{(bf16_t*)(a.ws + OFF_OUTPRE), (const bf16_t*)(a.ws + OFF_H1), (const bf16_t*)(a.ws + OFF_GPG)};
        pg8::gemm_phase<EpiDown, pg8::StaticOrder, true, true>(lds, gm, S, E); }
    SEAM(9);
    if (IN(10)) { const bf16_t* src = (const bf16_t*)(a.ws + OFF_OUTPRE); float* o = (float*)a.out;
        for (int m = gw; m < MTOK; m += 2 * ngw) ln_row2<false, true>(src + (size_t)m * DM, src + (size_t)(m + ngw) * DM, o + (size_t)m * DM, o + (size_t)(m + ngw) * DM, a.ln2_g, a.ln2_b, lane); }
    if (IN(11)) {
        float* o = (float*)a.out;
        if (a.pad == 0) { const bf16_t* src = (const bf16_t*)(a.ws + (size_t)a.coop * MiB);
            for (size_t i = (size_t)blockIdx.x * 512 + tid; i < (size_t)MTOK * DM; i += (size_t)G * 512) o[i] = __uint_as_float(((unsigned)src[i]) << 16); }
        else { const float* src = (const float*)(a.ws + (size_t)a.coop * MiB);
            for (size_t i = (size_t)blockIdx.x * 512 + tid; i < (size_t)MTOK * DM; i += (size_t)G * 512) o[i] = src[i]; }
    }
#undef IN
#undef SEAM
}

#ifndef N_LAUNCH_MODE
#define N_LAUNCH_MODE 1
#endif
extern "C" void kernel_launch(void* const* d_in, const int* in_sizes, int n_in, void* d_out, int out_size, void* d_ws, size_t ws_size, hipStream_t stream) {
    static int grid = 0;
    if (grid == 0) {
        if (n_in != 23 || out_size != MTOK * DM || ws_size < WS_NEED) { fprintf(stderr, "kernel_launch: unexpected shapes (n_in %d out %d ws %zu)\n", n_in, out_size, ws_size); grid = -1; return; }
        int dev = 0, cus = 0, per_cu = 0;
        hipGetDevice(&dev); hipDeviceGetAttribute(&cus, hipDeviceAttributeMultiprocessorCount, dev);
        if (hipFuncSetAttribute((const void*)mega, hipFuncAttributeMaxDynamicSharedMemorySize, LDS_BYTES) != hipSuccess) { fprintf(stderr, "kernel_launch: hipFuncSetAttribute failed\n"); grid = -1; return; }
        hipOccupancyMaxActiveBlocksPerMultiprocessor(&per_cu, (const void*)mega, 512, LDS_BYTES);
        (void)hipGetLastError();
        if (cus != 256 || per_cu < 1) { fprintf(stderr, "kernel_launch: needs 256 CUs with one resident block each (cus %d per_cu %d)\n", cus, per_cu); grid = -1; return; }
        grid = 256;
    }
    if (grid < 0) return;
    Args a{};
    const float** f = (const float**)&a;
    for (int i = 0; i < 23; ++i) f[i] = (const float*)d_in[i];
    a.out = (unsigned char*)d_out; a.ws = (unsigned char*)d_ws;
#if N_LAUNCH_MODE == 1
    a.ph_lo = 0; a.ph_hi = 11; a.coop = 1;
    if (hipMemsetAsync((char*)d_ws + OFF_CTL, 0, 65536, stream) != hipSuccess) { fprintf(stderr, "kernel_launch: memset failed\n"); return; }
    void* args[] = {&a};
    hipError_t e = hipLaunchCooperativeKernel((const void*)mega, dim3(grid), dim3(512), args, LDS_BYTES, stream);
    if (e != hipSuccess) fprintf(stderr, "cooperative launch failed: %s\n", hipGetErrorString(e));
#else
#ifndef DBG_STOP
#define DBG_STOP 10
#endif
#ifndef DBG_OFF_MIB
#define DBG_OFF_MIB 321
#endif
#ifndef DBG_F32
#define DBG_F32 0
#endif
#ifndef PROG
#define PROG {0, 1, 2, 3, 4, 5, 6, 7, 8, 9, 10}
#endif
    static const int prog[] = PROG;
    for (int pi = 0; pi < (int)(sizeof(prog) / sizeof(prog[0])); ++pi) { const int ph = prog[pi]; if (ph > DBG_STOP) break; a.ph_lo = ph; a.ph_hi = ph + 1; a.coop = 0;
        hipLaunchKernelGGL(mega, dim3(grid), dim3(512), LDS_BYTES, stream, a); }
    if (DBG_STOP < 10) { a.ph_lo = 11; a.ph_hi = 12; a.coop = DBG_OFF_MIB; a.pad = DBG_F32;
        hipLaunchKernelGGL(mega, dim3(grid), dim3(512), LDS_BYTES, stream, a); }
#endif
}
```

```cpp
#include <hip/hip_runtime.h>
#include <hip/hip_cooperative_groups.h>
#include <cstdio>
#include <cstdint>
#include <type_traits>
namespace cg = cooperative_groups;
namespace pg8 {
#define PG8_LAS __attribute__((address_space(3)))
typedef unsigned short bf16_t;
typedef short bf16x8 __attribute__((ext_vector_type(8)));
typedef float f32x4 __attribute__((ext_vector_type(4)));
typedef unsigned u32x4 __attribute__((ext_vector_type(4)));
constexpr int BM = 256, BK = 64, HALF = 128, HTB = HALF * BK * 2  , STAGE_BYTES = 8 * HTB, NXCD = 8, WGM = 8;

__host__ __device__ __forceinline__ int lds_byte(int r, int c) { const int st = (r >> 4) * 2 + (c >> 5), rr = r & 15, cc = c & 31, ob = rr * 64 + cc * 2; return st * 1024 + (ob ^ (((ob >> 9) & 1) << 5)); }
__host__ __device__ __forceinline__ void stage_rc(int b, int& R, int& C) { const int st = b / 1024, sb = b % 1024, swz = sb ^ (((sb >> 9) & 1) << 5); R = (st >> 1) * 16 + swz / 64; C = (st & 1) * 32 + (swz % 64) / 2; }
__host__ __device__ __forceinline__ int perm32(int rho) { const int n = rho >> 4, i = rho & 15; return 8 * (i >> 2) + 4 * n + (i & 3); }

struct Unit { int pm, pn; };
struct Gemm { const bf16_t* A; const bf16_t* Bt; int M, N, K; int ld = 0; size_t a_pn = 0; size_t b_pn = ~(size_t)0; };

struct StaticOrder {
    int nM, nN, nwg, G, c;
    __host__ __device__ void init(int M, int N, int G_, int c_) { nM = M / BM; nN = N / BM; nwg = nM * nN; G = G_; c = c_; }
    __host__ __device__ bool next(int i, Unit& u) const {
        const long L = (long)i * G + c; if (L >= nwg) return false;
        int wgid = (int)L; { const int q = nwg / NXCD, r = nwg % NXCD, xcd = wgid % NXCD, off = wgid / NXCD; wgid = (xcd < r ? xcd * (q + 1) : r * (q + 1) + (xcd - r) * q) + off; }
        const int nig = WGM * nN, gid = wgid / nig, fm = gid * WGM, gsz = (nM - fm) < WGM ? (nM - fm) : WGM;
        u.pm = fm + ((wgid % nig) % gsz); u.pn = (wgid % nig) / gsz; return true;
    }
    __device__ __forceinline__ void a_ready(const Unit&) const {}
    __device__ __forceinline__ void done(const Unit&) const {}
};
__device__ __forceinline__ unsigned cvt_pk_bf16(float lo, float hi) { unsigned r; asm volatile("v_cvt_pk_bf16_f32 %0, %1, %2" : "=v"(r) : "v"(lo), "v"(hi)); return r; }
typedef float f32x2 __attribute__((ext_vector_type(2)));
__device__ __forceinline__ f32x2 gelu_pk(f32x2 v) {
    const f32x2 av = __builtin_elementwise_abs(v), d = av * 0.2316418882f + 1.0f;
    f32x2 t; t.x = __builtin_amdgcn_rcpf(d.x); t.y = __builtin_amdgcn_rcpf(d.y);
    f32x2 q = t * 0.5307027145f + (-0.7265760135f); q = q * t + 0.7107068705f; q = q * t + (-0.142248368f); q = q * t + 0.127414796f; q = q * t;
    const f32x2 s = (v * v) * (-0.72134752044f);
    f32x2 e; e.x = __builtin_amdgcn_exp2f(s.x); e.y = __builtin_amdgcn_exp2f(s.y);
    const f32x2 m = v * (q * e), r = v - m;
    f32x2 o; o.x = v.x < 0.f ? m.x : r.x; o.y = v.y < 0.f ? m.y : r.y; return o;
}

template <class Epi, class Sched, bool ALIGN_EPI = false, bool SP2 = false>
__device__ __forceinline__ void gemm_phase(PG8_LAS unsigned char* lds, const Gemm g, const Sched& S, const Epi& E) {
    const int tid = threadIdx.x, wid = __builtin_amdgcn_readfirstlane(tid >> 6), lane = tid & 63, wr = wid >> 2, wc = wid & 3, fr = lane & 15, fq = lane >> 4;
    const int nt = g.K / BK, K = g.ld ? g.ld : g.K;
    unsigned voffA[2], voffB[2];
#pragma unroll
    for (int i = 0; i < 2; ++i) { int R, C; stage_rc(tid * 16 + i * 8192, R, C); const int Rb = Epi::PERM ? ((R & ~31) + perm32(R & 31)) : R;
        voffA[i] = (unsigned)(R * K + C) * 2u; voffB[i] = (unsigned)(Rb * K + C) * 2u; }
    const size_t kstep = (size_t)(BK * 2);
    const size_t hstep = (size_t)HALF * K * 2;
    const size_t tstep = 2 * hstep;
    const unsigned ldsw = (unsigned)wid * 1024u;
    const int aoff = lds_byte(wr * 64 + fr, fq * 8), boff = lds_byte(wc * 32 + fr, fq * 8);
#define PG8_SA(b, h) (((b) * 2 + (h)) * HTB)
#define PG8_SB(b, h) ((4 + (b) * 2 + (h)) * HTB)
#define PG8_STAGE(bufoff, gbase, voff) do { _Pragma("unroll") for (int _i = 0; _i < 2; ++_i) \
        __builtin_amdgcn_global_load_lds((const unsigned*)((const char*)(gbase) + (voff)[_i]), (PG8_LAS unsigned*)(lds + (bufoff) + ldsw + _i * 8192), 16, 0, 0); } while (0)
#define PG8_LDA(dst, b, h) do { _Pragma("unroll") for (int m = 0; m < 4; ++m) _Pragma("unroll") for (int k = 0; k < 2; ++k) dst[m][k] = *(const PG8_LAS bf16x8*)(lds + PG8_SA(b, h) + aoff + m * 2048 + k * 1024); } while (0)
#define PG8_LDB(dst, b, h) do { _Pragma("unroll") for (int n = 0; n < 2; ++n) _Pragma("unroll") for (int k = 0; k < 2; ++k) dst[n][k] = *(const PG8_LAS bf16x8*)(lds + PG8_SB(b, h) + boff + n * 2048 + k * 1024); } while (0)
#define PG8_MMA(ai, bj, At, Bt) do { __builtin_amdgcn_s_setprio(1); _Pragma("unroll") for (int m = 0; m < 4; ++m) _Pragma("unroll") for (int n = 0; n < 2; ++n) _Pragma("unroll") for (int k = 0; k < 2; ++k) \
        acc[ai][bj][m][n] = __builtin_amdgcn_mfma_f32_16x16x32_bf16(Bt[n][k], At[m][k], acc[ai][bj][m][n], 0, 0, 0); __builtin_amdgcn_s_setprio(0); } while (0)
#define PG8_WAIT_V(n) asm volatile("s_waitcnt vmcnt(" #n ")" ::: "memory")
#define PG8_WAIT_L(n) asm volatile("s_waitcnt lgkmcnt(" #n ")" ::: "memory")
#define PG8_BAR __builtin_amdgcn_s_barrier()
#define PG8_SCHED __builtin_amdgcn_sched_barrier(0)
    Unit cur, nxt; int ui = 0;
    if (!S.next(0, cur)) return;
    f32x4 acc[2][2][4][2];
#pragma unroll
    for (int a = 0; a < 2; ++a)
#pragma unroll
        for (int b = 0; b < 2; ++b)
#pragma unroll
            for (int m = 0; m < 4; ++m)
#pragma unroll
                for (int n = 0; n < 2; ++n) acc[a][b][m][n] = (f32x4){0.f, 0.f, 0.f, 0.f};
    bf16x8 At[4][2], B0[2][2], B1[2][2];
    const size_t bpn = g.b_pn == ~(size_t)0 ? tstep : g.b_pn;
    const char* cA = (const char*)g.A + (size_t)cur.pm * tstep + (size_t)cur.pn * g.a_pn; const char* cB = (const char*)g.Bt + (size_t)cur.pn * bpn;
    S.a_ready(cur);
    if constexpr (SP2) {
        PG8_STAGE(PG8_SB(0, 0), cB, voffB); PG8_STAGE(PG8_SB(0, 1), cB + hstep, voffB); PG8_STAGE(PG8_SA(0, 0), cA, voffA); PG8_STAGE(PG8_SA(0, 1), cA + hstep, voffA);
        if (wr == 1) PG8_BAR;
        PG8_WAIT_V(2); PG8_BAR;
        PG8_STAGE(PG8_SB(1, 0), cB + kstep, voffB); PG8_STAGE(PG8_SA(1, 0), cA + kstep, voffA); PG8_STAGE(PG8_SB(1, 1), cB + hstep + kstep, voffB);
        PG8_WAIT_V(6); PG8_BAR;
    } else {
        PG8_STAGE(PG8_SB(0, 0), cB, voffB); PG8_STAGE(PG8_SA(0, 0), cA, voffA); PG8_STAGE(PG8_SB(0, 1), cB + hstep, voffB); PG8_STAGE(PG8_SA(0, 1), cA + hstep, voffA);
        if (wr == 1) PG8_BAR;
        PG8_WAIT_V(4); PG8_BAR;
        PG8_STAGE(PG8_SB(1, 0), cB + kstep, voffB); PG8_STAGE(PG8_SA(1, 0), cA + kstep, voffA); PG8_STAGE(PG8_SB(1, 1), cB + hstep + kstep, voffB);
        PG8_WAIT_V(6); PG8_BAR;
    }
    for (;;) {
        const bool has_next = S.next(ui + 1, nxt);
        const char* nA = has_next ? (const char*)g.A + (size_t)nxt.pm * tstep + (size_t)nxt.pn * g.a_pn : cA; const char* nB = has_next ? (const char*)g.Bt + (size_t)nxt.pn * bpn : cB;
        for (int t = 0; t < nt; t += 2) {
            const bool last = (t == nt - 2);
            const char* a1 = cA + (size_t)(t + 1) * kstep;
            const char* a2 = last ? nA : cA + (size_t)(t + 2) * kstep; const char* b2 = last ? nB : cB + (size_t)(t + 2) * kstep;
            const char* a3 = a2 + kstep; const char* b3 = b2 + kstep;
            if (last && has_next) S.a_ready(nxt);
            if constexpr (Epi::HOOK_T > 0) { if (t == Epi::HOOK_T) E.hook(acc, cur, wr, wc, fr, fq); }
            if constexpr (SP2) {
            PG8_LDB(B0, 0, 0); PG8_LDB(B1, 0, 1); PG8_SCHED; PG8_LDA(At, 0, 0); PG8_STAGE(PG8_SA(1, 1), a1 + hstep, voffA);
            PG8_WAIT_V(8); PG8_WAIT_L(0); PG8_BAR; PG8_MMA(0, 0, At, B0); PG8_MMA(0, 1, At, B1); PG8_BAR; PG8_SCHED;
            PG8_LDA(At, 0, 1); PG8_STAGE(PG8_SB(0, 0), b2, voffB); PG8_STAGE(PG8_SB(0, 1), b2 + hstep, voffB); PG8_STAGE(PG8_SA(0, 0), a2, voffA);
            PG8_WAIT_V(8); PG8_WAIT_L(0); PG8_BAR; PG8_MMA(1, 0, At, B0); PG8_MMA(1, 1, At, B1); PG8_BAR; PG8_SCHED;
            PG8_LDB(B0, 1, 0); PG8_LDB(B1, 1, 1); PG8_SCHED; PG8_LDA(At, 1, 0); PG8_STAGE(PG8_SA(0, 1), a2 + hstep, voffA);
            PG8_WAIT_V(8); PG8_WAIT_L(0); PG8_BAR; PG8_MMA(0, 0, At, B0); PG8_MMA(0, 1, At, B1); PG8_BAR; PG8_SCHED;
            PG8_LDA(At, 1, 1); PG8_STAGE(PG8_SB(1, 0), b3, voffB); PG8_STAGE(PG8_SB(1, 1), b3 + hstep, voffB); PG8_STAGE(PG8_SA(1, 0), a3, voffA);
            PG8_WAIT_V(8); PG8_WAIT_L(0); PG8_BAR; PG8_MMA(1, 0, At, B0); PG8_MMA(1, 1, At, B1); PG8_BAR; PG8_SCHED;
            } else {
            PG8_LDB(B0, 0, 0); PG8_SCHED; PG8_LDA(At, 0, 0); PG8_STAGE(PG8_SA(1, 1), a1 + hstep, voffA);
            PG8_WAIT_L(8); PG8_BAR; PG8_WAIT_L(0); PG8_MMA(0, 0, At, B0); PG8_BAR; PG8_SCHED;
            PG8_LDB(B1, 0, 1); PG8_STAGE(PG8_SB(0, 0), b2, voffB);
            PG8_BAR; PG8_WAIT_L(0); PG8_MMA(0, 1, At, B1); PG8_BAR;
            PG8_LDA(At, 0, 1); PG8_STAGE(PG8_SA(0, 0), a2, voffA);
            PG8_BAR; PG8_WAIT_L(0); PG8_MMA(1, 0, At, B0); PG8_BAR; PG8_SCHED;
            PG8_STAGE(PG8_SB(0, 1), b2 + hstep, voffB);
            PG8_WAIT_V(6); PG8_BAR; PG8_MMA(1, 1, At, B1); PG8_BAR;
            PG8_LDB(B0, 1, 0); PG8_SCHED; PG8_LDA(At, 1, 0); PG8_STAGE(PG8_SA(0, 1), a2 + hstep, voffA);
            PG8_WAIT_L(8); PG8_BAR; PG8_WAIT_L(0); PG8_MMA(0, 0, At, B0); PG8_BAR; PG8_SCHED;
            PG8_LDB(B1, 1, 1); PG8_STAGE(PG8_SB(1, 0), b3, voffB);
            PG8_BAR; PG8_WAIT_L(0); PG8_MMA(0, 1, At, B1); PG8_BAR;
            PG8_LDA(At, 1, 1); PG8_STAGE(PG8_SA(1, 0), a3, voffA);
            PG8_BAR; PG8_WAIT_L(0); PG8_MMA(1, 0, At, B0); PG8_BAR; PG8_SCHED;
            PG8_STAGE(PG8_SB(1, 1), b3 + hstep, voffB);
            PG8_WAIT_V(6); PG8_BAR; PG8_MMA(1, 1, At, B1); PG8_BAR;
            }
        }
        if constexpr (ALIGN_EPI) { if (wr == 0) PG8_BAR; }
        if constexpr (!Epi::AFTER_DRAIN) { E(acc, cur, wr, wc, fr, fq); S.done(cur); }
        if (!has_next) break;
#pragma unroll
        for (int a = 0; a < 2; ++a)
#pragma unroll
            for (int b = 0; b < 2; ++b)
#pragma unroll
                for (int m = 0; m < 4; ++m)
#pragma unroll
                    for (int n = 0; n < 2; ++n) acc[a][b][m][n] = (f32x4){0.f, 0.f, 0.f, 0.f};
        cur = nxt; cA = nA; cB = nB; ++ui;
        if constexpr (ALIGN_EPI) { if (wr == 1) PG8_BAR; }
    }
    PG8_WAIT_V(0);
    if constexpr (!ALIGN_EPI) { if (wr == 0) PG8_BAR; }
    PG8_BAR;
    if constexpr (Epi::AFTER_DRAIN) { E.fused(acc, cur, wr, wc, fr, fq, lds, wid, lane); S.done(cur); }
#undef PG8_SA
#undef PG8_SB
#undef PG8_STAGE
#undef PG8_LDA
#undef PG8_LDB
#undef PG8_MMA
#undef PG8_WAIT_V
#undef PG8_WAIT_L
#undef PG8_BAR
#undef PG8_SCHED
}
}

#define LAS __attribute__((address_space(3)))
typedef unsigned short bf16_t;
typedef short bf16x8 __attribute__((ext_vector_type(8)));
typedef float f32x4 __attribute__((ext_vector_type(4)));
typedef unsigned u32x4 __attribute__((ext_vector_type(4)));
typedef unsigned u32x2 __attribute__((ext_vector_type(2)));

constexpr int KX = 5888  , MTOK = 32768, DM = 2048, NCHUNK = 512  , DFF = 5632, N1 = 14592, NGU = 13312;
constexpr float ALPHA = 1.189207115002721f, LN_EPS = 1e-5f;
constexpr size_t MiB = 1u << 20;
constexpr size_t OFF_W1T = 0, OFF_WOT = 57 * MiB, OFF_H0 = 65 * MiB, OFF_Q = 193 * MiB, OFF_K = 257 * MiB, OFF_V = 321 * MiB, OFF_OG = 449 * MiB,
                 OFF_U = 577 * MiB, OFF_Z = 705 * MiB, OFF_GA = 833 * MiB, OFF_FG = 961 * MiB, OFF_CTL = 969 * MiB, OFF_FG2 = 976 * MiB  , WS_NEED = 984 * MiB;
constexpr size_t OFF_H1PRE = OFF_V, OFF_H1 = OFF_Z, OFF_ACT = OFF_Q  , OFF_GPG = OFF_GA, OFF_OUTPRE = 0;
constexpr size_t DO_GB = 0, DO_PLEB = 0, DO_DEC = 128 * MiB, DO_WGUT = 130 * MiB, DO_WDT = 182 * MiB, DO_WPUT = 204 * MiB, DO_PB = 205 * MiB;
constexpr int LDS_BYTES = 153600, LDS_BARW = 153536;

struct Args {
    const float *x, *p, *ln0_g, *ln0_b, *w_in, *b_in, *w_f2, *b_f2, *gla_g, *gm_g, *gm_b, *w_s, *b_s, *w_o, *ln1_g, *ln1_b, *w_gu, *w_down, *w_pg, *b_pg, *w_pu, *ln2_g, *ln2_b;
    unsigned char* out; unsigned char* ws; int ph_lo, ph_hi, coop, pad;
};

typedef float f32x2_t __attribute__((ext_vector_type(2))); typedef __bf16 bf16x2_t __attribute__((ext_vector_type(2)));
__device__ __forceinline__ unsigned cvtpk_s(float lo, float hi) { f32x2_t v = {lo, hi}; bf16x2_t b = __builtin_convertvector(v, bf16x2_t); return __builtin_bit_cast(unsigned, b); }
__device__ __forceinline__ float bflo(unsigned w) { return __uint_as_float(w << 16); }
__device__ __forceinline__ float bfhi(unsigned w) { return __uint_as_float(w & 0xffff0000u); }
__device__ __forceinline__ float sigm(float x) { return __builtin_amdgcn_rcpf(1.f + __expf(-x)); }
__device__ __forceinline__ float wave_sum(float v) {
#pragma unroll
    for (int o = 1; o < 64; o <<= 1) v += __shfl_xor(v, o);
    return v;
}
#define LDS_WAIT() asm volatile("s_waitcnt lgkmcnt(0)" ::: "memory")

using pg8::Unit;
using pg8::gelu_pk;
typedef float f32x2 __attribute__((ext_vector_type(2)));

__device__ __forceinline__ void act8(f32x4& v0, f32x4& v1, int mode) {
    if (mode == 0) { v0 = v0 * 0.0625f; v1 = v1 * 0.0625f; }
    else if (mode == 2) {
#pragma unroll
        for (int j = 0; j < 4; ++j) { v0[j] = v0[j] * sigm(v0[j]); v1[j] = v1[j] * sigm(v1[j]); } }
    else if (mode == 3) { f32x2 a = gelu_pk((f32x2){v0[0], v0[1]}), b = gelu_pk((f32x2){v0[2], v0[3]}), c = gelu_pk((f32x2){v1[0], v1[1]}), d = gelu_pk((f32x2){v1[2], v1[3]});
        v0 = (f32x4){a.x, a.y, b.x, b.y}; v1 = (f32x4){c.x, c.y, d.x, d.y}; }
    else if (mode == 4) {
#pragma unroll
        for (int j = 0; j < 4; ++j) { v0[j] = sigm(v0[j]); v1[j] = sigm(v1[j]); } }
}

struct Epi1 {
    static constexpr bool PERM = true, AFTER_DRAIN = false; static constexpr int HOOK_T = 0;
    unsigned char* ws; unsigned char* dout; const float* b_in;
    __device__ __forceinline__ void operator()(const f32x4 (&acc)[2][2][4][2], const Unit& u, int wr, int wc, int fr, int fq) const {
        const int pn = u.pn; const int row0 = u.pm * 256 + wr * 64 + fr;
        if (pn == 56) {
            if (wc < 2) {
                float* FG = (float*)(ws + OFF_FG); const int c0 = wc * 32 + 8 * fq;
                const f32x4 b0 = *(const f32x4*)(b_in + 6144 + c0), b1 = *(const f32x4*)(b_in + 6144 + c0 + 4);
#pragma unroll
                for (int ai = 0; ai < 2; ++ai)
#pragma unroll
                    for (int m = 0; m < 4; ++m) { float* rp = FG + (size_t)(row0 + ai * 128 + m * 16) * 64 + c0;
                        *(f32x4*)rp = acc[ai][0][m][0] + b0; *(f32x4*)(rp + 4) = acc[ai][0][m][1] + b1; }
            }
            return;
        }
        const int cw = wc * 32 + 8 * fq;
        if (pn >= 16 && pn < 48) {
            const bool first = pn < 32; const int t = first ? pn - 16 : pn - 32;
            const float* bA = b_in + (first ? 4096 : 6208) + 128 * t + cw; const float* bB = b_in + (first ? 10304 : 12352) + 128 * t + cw;
            const f32x4 a0 = *(const f32x4*)bA, a1 = *(const f32x4*)(bA + 4), g0 = *(const f32x4*)bB, g1 = *(const f32x4*)(bB + 4);
            bf16_t* rowp0 = (bf16_t*)(ws + (first ? OFF_OG : OFF_U)) + (size_t)row0 * 2048 + 128 * t + cw;
            if (first) pair_body<2>(acc, a0, a1, g0, g1, rowp0); else pair_body<3>(acc, a0, a1, g0, g1, rowp0);
            return;
        }
        int mode, ldc, colt, bsrc; bf16_t* base;
        if (pn < 4) { mode = 0; base = (bf16_t*)(ws + OFF_Q); ldc = 1024; colt = pn * 256; bsrc = pn * 256; }
        else if (pn < 8) { mode = 1; base = (bf16_t*)(ws + OFF_K); ldc = 1024; colt = (pn - 4) * 256; bsrc = pn * 256; }
        else if (pn < 16) { mode = 1; base = (bf16_t*)(ws + OFF_V); ldc = 2048; colt = (pn - 8) * 256; bsrc = pn * 256; }
        else { mode = 3; base = (bf16_t*)(ws + OFF_Z); ldc = 2048; colt = (pn - 48) * 256; bsrc = 8256 + (pn - 48) * 256; }
        f32x4 bv[2][2];
#pragma unroll
        for (int bj = 0; bj < 2; ++bj)
#pragma unroll
            for (int n = 0; n < 2; ++n) bv[bj][n] = *(const f32x4*)(b_in + bsrc + bj * 128 + (mode == 0 ? wc * 32 + 4 * fq + 16 * n : cw + 4 * n));
        bf16_t* rowp0 = base + (size_t)row0 * ldc + colt + cw;
        switch (mode) {
            case 0: body<0>(acc, bv, rowp0, ldc); break;
            case 1: body<1>(acc, bv, rowp0, ldc); break;
            default: body<3>(acc, bv, rowp0, ldc); break;
        }
    }
    template <int MODE> __device__ __forceinline__ void body(const f32x4 (&acc)[2][2][4][2], const f32x4 (&bv)[2][2], bf16_t* rowp0, int ldc) const {
#pragma unroll
        for (int ai = 0; ai < 2; ++ai)
#pragma unroll
            for (int m = 0; m < 4; ++m) { bf16_t* rowp = rowp0 + (size_t)(ai * 128 + m * 16) * ldc;
#pragma unroll
                for (int bj = 0; bj < 2; ++bj) { f32x4 v0 = acc[ai][bj][m][0] + bv[bj][0], v1 = acc[ai][bj][m][1] + bv[bj][1];
                    act8(v0, v1, MODE);
                    u32x4 w; w.x = cvtpk_s(v0[0], v0[1]); w.y = cvtpk_s(v0[2], v0[3]); w.z = cvtpk_s(v1[0], v1[1]); w.w = cvtpk_s(v1[2], v1[3]);
                    *(u32x4*)(rowp + bj * 128) = w; } }
    }
    template <int MODE> __device__ __forceinline__ void pair_body(const f32x4 (&acc)[2][2][4][2], const f32x4 a0, const f32x4 a1, const f32x4 g0, const f32x4 g1, bf16_t* rowp0) const {
#pragma unroll
        for (int ai = 0; ai < 2; ++ai)
#pragma unroll
            for (int m = 0; m < 4; ++m) { f32x4 v0 = acc[ai][0][m][0] + a0, v1 = acc[ai][0][m][1] + a1, s0 = acc[ai][1][m][0] + g0, s1 = acc[ai][1][m][1] + g1;
                act8(v0, v1, MODE); act8(s0, s1, 4);
                v0 = v0 * s0; v1 = v1 * s1;
                u32x4 w; w.x = cvtpk_s(v0[0], v0[1]); w.y = cvtpk_s(v0[2], v0[3]); w.z = cvtpk_s(v1[0], v1[1]); w.w = cvtpk_s(v1[2], v1[3]);
                *(u32x4*)(rowp0 + (size_t)(ai * 128 + m * 16) * 2048) = w; }
    }
};

struct EpiFg {
    static constexpr bool PERM = true, AFTER_DRAIN = false; static constexpr int HOOK_T = 0;
    float* P0; float* P1;
    __device__ __forceinline__ void operator()(const f32x4 (&acc)[2][2][4][2], const Unit& u, int wr, int wc, int fr, int fq) const {
        if (wc >= 2) return;
        float* FG = u.pn ? P1 : P0; const int row0 = u.pm * 256 + wr * 64 + fr, c0 = wc * 32 + 8 * fq;
#pragma unroll
        for (int ai = 0; ai < 2; ++ai)
#pragma unroll
            for (int m = 0; m < 4; ++m) { float* rp = FG + (size_t)(row0 + ai * 128 + m * 16) * 64 + c0; *(f32x4*)rp = acc[ai][0][m][0]; *(f32x4*)(rp + 4) = acc[ai][0][m][1]; }
    }
};

template <bool HAS_P> struct EpiRes {
    static constexpr bool PERM = true, AFTER_DRAIN = false; static constexpr int HOOK_T = 0;
    bf16_t* out; const bf16_t* R; const bf16_t* P;
    __device__ __forceinline__ void operator()(const f32x4 (&acc)[2][2][4][2], const Unit& u, int wr, int wc, int fr, int fq) const {
        const int row0 = u.pm * 256 + wr * 64 + fr, col0 = u.pn * 256 + wc * 32 + 8 * fq;
#pragma unroll
        for (int ai = 0; ai < 2; ++ai)
#pragma unroll
            for (int mh = 0; mh < 2; ++mh) {
                u32x4 rr[2][2], qq[2][2];
#pragma unroll
                for (int m2 = 0; m2 < 2; ++m2)
#pragma unroll
                    for (int bj = 0; bj < 2; ++bj) { const size_t off = (size_t)(row0 + ai * 128 + (2 * mh + m2) * 16) * DM + col0 + bj * 128;
                        rr[m2][bj] = *(const u32x4*)(R + off); if (HAS_P) qq[m2][bj] = *(const u32x4*)(P + off); }
#pragma unroll
                for (int m2 = 0; m2 < 2; ++m2)
#pragma unroll
                    for (int bj = 0; bj < 2; ++bj) { const int m = 2 * mh + m2; const size_t off = (size_t)(row0 + ai * 128 + m * 16) * DM + col0 + bj * 128; const u32x4 r = rr[m2][bj];
                        f32x4 v0 = acc[ai][bj][m][0], v1 = acc[ai][bj][m][1];
                        v0 += (f32x4){bflo(r.x), bfhi(r.x), bflo(r.y), bfhi(r.y)} * ALPHA; v1 += (f32x4){bflo(r.z), bfhi(r.z), bflo(r.w), bfhi(r.w)} * ALPHA;
                        if (HAS_P) { const u32x4 q = qq[m2][bj];
                            v0 += (f32x4){bflo(q.x), bfhi(q.x), bflo(q.y), bfhi(q.y)}; v1 += (f32x4){bflo(q.z), bfhi(q.z), bflo(q.w), bfhi(q.w)}; }
                        u32x4 w; w.x = cvtpk_s(v0[0], v0[1]); w.y = cvtpk_s(v0[2], v0[3]); w.z = cvtpk_s(v1[0], v1[1]); w.w = cvtpk_s(v1[2], v1[3]);
                        *(u32x4*)(out + off) = w; }
                asm volatile("" ::: "memory");
            }
    }
};

struct EpiDown {
    static constexpr bool PERM = true, AFTER_DRAIN = false; static constexpr int HOOK_T = 4;
    bf16_t* out; const bf16_t* R; const bf16_t* G;
    __device__ __forceinline__ void hook(f32x4 (&acc)[2][2][4][2], const Unit& u, int wr, int wc, int fr, int fq) const {
        unsigned zoff; asm volatile("v_mov_b32 %0, 0" : "=v"(zoff));
        const bf16_t* gp = G + (size_t)(u.pm * 256 + wr * 64 + fr) * DM + u.pn * 256 + wc * 32 + 8 * fq + zoff;
#pragma unroll
        for (int ai = 0; ai < 2; ++ai)
#pragma unroll
            for (int mh = 0; mh < 2; ++mh) {
                u32x4 rr[2][2];
#pragma unroll
                for (int m2 = 0; m2 < 2; ++m2)
#pragma unroll
                    for (int bj = 0; bj < 2; ++bj) rr[m2][bj] = *(const u32x4*)(gp + (size_t)(ai * 128 + (2 * mh + m2) * 16) * DM + bj * 128);
#pragma unroll
                for (int m2 = 0; m2 < 2; ++m2)
#pragma unroll
                    for (int bj = 0; bj < 2; ++bj) { const u32x4 r = rr[m2][bj]; const int m = 2 * mh + m2;
                        acc[ai][bj][m][0] *= (f32x4){bflo(r.x), bfhi(r.x), bflo(r.y), bfhi(r.y)}; acc[ai][bj][m][1] *= (f32x4){bflo(r.z), bfhi(r.z), bflo(r.w), bfhi(r.w)}; }
                asm volatile("" ::: "memory");
            }
    }
    __device__ __forceinline__ void operator()(const f32x4 (&acc)[2][2][4][2], const Unit& u, int wr, int wc, int fr, int fq) const {
        const int row0 = u.pm * 256 + wr * 64 + fr, col0 = u.pn * 256 + wc * 32 + 8 * fq;
#pragma unroll
        for (int ai = 0; ai < 2; ++ai)
#pragma unroll
            for (int m = 0; m < 4; ++m)
#pragma unroll
                for (int bj = 0; bj < 2; ++bj) { const size_t off = (size_t)(row0 + ai * 128 + m * 16) * DM + col0 + bj * 128; const u32x4 r = *(const u32x4*)(R + off);
                    f32x4 v0 = acc[ai][bj][m][0], v1 = acc[ai][bj][m][1];
                    v0 += (f32x4){bflo(r.x), bfhi(r.x), bflo(r.y), bfhi(r.y)} * ALPHA; v1 += (f32x4){bflo(r.z), bfhi(r.z), bflo(r.w), bfhi(r.w)} * ALPHA;
                    u32x4 w; w.x = cvtpk_s(v0[0], v0[1]); w.y = cvtpk_s(v0[2], v0[3]); w.z = cvtpk_s(v1[0], v1[1]); w.w = cvtpk_s(v1[2], v1[3]);
                    *(u32x4*)(out + off) = w; }
    }
};

struct Epi5 {
    static constexpr bool PERM = true, AFTER_DRAIN = false; static constexpr int HOOK_T = 0;
    bf16_t* ACT; bf16_t* GPG; const float* b_pg;
    __device__ __forceinline__ void operator()(const f32x4 (&acc)[2][2][4][2], const Unit& u, int wr, int wc, int fr, int fq) const {
        const int pn = u.pn; const int row0 = u.pm * 256 + wr * 64 + fr, cw = wc * 32 + 8 * fq;
        if (pn < 44) {
#pragma unroll
            for (int ai = 0; ai < 2; ++ai)
#pragma unroll
                for (int m = 0; m < 4; ++m) { bf16_t* rowp = ACT + (size_t)(row0 + ai * 128 + m * 16) * KX + 256 + pn * 128 + cw;
                    f32x4 g0 = acc[ai][0][m][0], g1 = acc[ai][0][m][1]; const f32x4 u0 = acc[ai][1][m][0], u1 = acc[ai][1][m][1];
#pragma unroll
                    for (int j = 0; j < 4; ++j) { g0[j] = g0[j] * sigm(g0[j]) * u0[j]; g1[j] = g1[j] * sigm(g1[j]) * u1[j]; }
                    u32x4 w; w.x = cvtpk_s(g0[0], g0[1]); w.y = cvtpk_s(g0[2], g0[3]); w.z = cvtpk_s(g1[0], g1[1]); w.w = cvtpk_s(g1[2], g1[3]);
                    *(u32x4*)rowp = w; }
        } else {
            const int colt = (pn - 44) * 256;
            f32x4 bv[2][2];
#pragma unroll
            for (int bj = 0; bj < 2; ++bj)
#pragma unroll
                for (int n = 0; n < 2; ++n) bv[bj][n] = *(const f32x4*)(b_pg + colt + bj * 128 + cw + 4 * n);
#pragma unroll
            for (int ai = 0; ai < 2; ++ai)
#pragma unroll
                for (int m = 0; m < 4; ++m) { bf16_t* rowp = GPG + (size_t)(row0 + ai * 128 + m * 16) * DM + colt + cw;
#pragma unroll
                    for (int bj = 0; bj < 2; ++bj) { f32x4 v0 = acc[ai][bj][m][0] + bv[bj][0], v1 = acc[ai][bj][m][1] + bv[bj][1];
                        act8(v0, v1, 4);
                        u32x4 w; w.x = cvtpk_s(v0[0], v0[1]); w.y = cvtpk_s(v0[2], v0[3]); w.z = cvtpk_s(v1[0], v1[1]); w.w = cvtpk_s(v1[2], v1[3]);
                        *(u32x4*)(rowp + bj * 128) = w; } }
        }
    }
};

struct EpiPle {
    static constexpr bool PERM = true, AFTER_DRAIN = false; static constexpr int HOOK_T = 0;
    bf16_t* O; const bf16_t* G;
    __device__ __forceinline__ void operator()(const f32x4 (&acc)[2][2][4][2], const Unit& u, int wr, int wc, int fr, int fq) const {
        const int row0 = u.pm * 256 + wr * 64 + fr, col0 = u.pn * 256 + wc * 32 + 8 * fq;
#pragma unroll
        for (int ai = 0; ai < 2; ++ai) {
            u32x4 rr[4][2];
#pragma unroll
            for (int m = 0; m < 4; ++m)
#pragma unroll
                for (int bj = 0; bj < 2; ++bj) rr[m][bj] = *(const u32x4*)(G + (size_t)(row0 + ai * 128 + m * 16) * DM + col0 + bj * 128);
#pragma unroll
            for (int m = 0; m < 4; ++m)
#pragma unroll
                for (int bj = 0; bj < 2; ++bj) { const size_t off = (size_t)(row0 + ai * 128 + m * 16) * DM + col0 + bj * 128; const u32x4 r = rr[m][bj];
                    const f32x4 v0 = acc[ai][bj][m][0] * (f32x4){bflo(r.x), bfhi(r.x), bflo(r.y), bfhi(r.y)}, v1 = acc[ai][bj][m][1] * (f32x4){bflo(r.z), bfhi(r.z), bflo(r.w), bfhi(r.w)};
                    u32x4 w; w.x = cvtpk_s(v0[0], v0[1]); w.y = cvtpk_s(v0[2], v0[3]); w.z = cvtpk_s(v1[0], v1[1]); w.w = cvtpk_s(v1[2], v1[3]);
                    *(u32x4*)(O + off) = w; }
            asm volatile("" ::: "memory");
        }
    }
};

__device__ __forceinline__ int dkmap32(int pos) { const int qq = pos >> 3, jj = pos & 7; return jj < 4 ? 4 * qq + jj : 16 + 4 * qq + (jj - 4); }
__device__ __forceinline__ void tr_item(const float* W, int ldw, int srccol0, int k0, bf16_t* WT, int ldt, int dstrow0, LAS float* scr, int lane, bool zero, int dk0 = 0, bool qperm = false) {
    if (!zero) {
        f32x4 tv[8];
#pragma unroll
        for (int i = 0; i < 8; ++i) tv[i] = *(const f32x4*)(W + (size_t)(k0 + 8 * i + (lane >> 3)) * ldw + srccol0 + 4 * (lane & 7));
#pragma unroll
        for (int i = 0; i < 8; ++i) { LAS float* d = scr + (8 * i + (lane >> 3)) * 33 + 4 * (lane & 7); d[0] = tv[i][0]; d[1] = tv[i][1]; d[2] = tv[i][2]; d[3] = tv[i][3]; }
    }
    LDS_WAIT();
    const int c = lane & 7;
#pragma unroll
    for (int j = 0; j < 4; ++j) { const int n = (lane >> 3) + 8 * j; const LAS float* s = scr + (8 * c) * 33 + (qperm ? dkmap32(n) : n);
        u32x4 o; o.x = cvtpk_s(s[0 * 33], s[1 * 33]); o.y = cvtpk_s(s[2 * 33], s[3 * 33]); o.z = cvtpk_s(s[4 * 33], s[5 * 33]); o.w = cvtpk_s(s[6 * 33], s[7 * 33]);
        if (zero) o = (u32x4){0u, 0u, 0u, 0u};
        *(u32x4*)(WT + (size_t)(dstrow0 + n) * ldt + dk0 + k0 + 8 * c) = o; }
    LDS_WAIT();
}
template <bool OUT_BF16> __device__ __forceinline__ void ln_row(const float* in, void* outp, const float* g, const float* b, int lane) {
    const f32x4* xr = (const f32x4*)in + lane;
    f32x4 v[8]; float s = 0.f;
#pragma unroll
    for (int j = 0; j < 8; ++j) { v[j] = xr[64 * j]; s += (v[j][0] + v[j][1]) + (v[j][2] + v[j][3]); }
    const float mean = wave_sum(s) * (1.f / DM); float s2 = 0.f;
#pragma unroll
    for (int j = 0; j < 8; ++j) { v[j] = v[j] - mean; s2 += (v[j][0] * v[j][0] + v[j][1] * v[j][1]) + (v[j][2] * v[j][2] + v[j][3] * v[j][3]); }
    const float rstd = 1.f / sqrtf(wave_sum(s2) * (1.f / DM) + LN_EPS);
#pragma unroll
    for (int j = 0; j < 8; ++j) { const f32x4 gg = ((const f32x4*)g)[64 * j + lane], bb = ((const f32x4*)b)[64 * j + lane]; const f32x4 o = v[j] * rstd * gg + bb;
        if (OUT_BF16) { u32x2 w; w.x = cvtpk_s(o[0], o[1]); w.y = cvtpk_s(o[2], o[3]); ((u32x2*)outp)[64 * j + lane] = w; }
        else ((f32x4*)outp)[64 * j + lane] = o; }
}
template <bool OUT_BF16, bool IN_BF16 = false> __device__ __forceinline__ void ln_row2(const void* in0, const void* in1, void* out0, void* out1, const float* g, const float* b, int lane) {
    f32x4 v[8], w[8]; float s = 0.f, t = 0.f;
    if (IN_BF16) { const u32x2* x0 = (const u32x2*)in0 + lane; const u32x2* x1 = (const u32x2*)in1 + lane; u32x2 a0[8], a1[8];
#pragma unroll
        for (int j = 0; j < 8; ++j) { a0[j] = x0[64 * j]; a1[j] = x1[64 * j]; }
#pragma unroll
        for (int j = 0; j < 8; ++j) { v[j] = (f32x4){bflo(a0[j].x), bfhi(a0[j].x), bflo(a0[j].y), bfhi(a0[j].y)}; w[j] = (f32x4){bflo(a1[j].x), bfhi(a1[j].x), bflo(a1[j].y), bfhi(a1[j].y)}; }
    } else { const f32x4* x0 = (const f32x4*)in0 + lane; const f32x4* x1 = (const f32x4*)in1 + lane;
#pragma unroll
        for (int j = 0; j < 8; ++j) { v[j] = x0[64 * j]; w[j] = x1[64 * j]; } }
#pragma unroll
    for (int j = 0; j < 8; ++j) { s += (v[j][0] + v[j][1]) + (v[j][2] + v[j][3]); t += (w[j][0] + w[j][1]) + (w[j][2] + w[j][3]); }
#pragma unroll
    for (int o = 1; o < 64; o <<= 1) { s += __shfl_xor(s, o); t += __shfl_xor(t, o); }
    const float m0 = s * (1.f / DM), m1 = t * (1.f / DM); float s2 = 0.f, t2 = 0.f;
#pragma unroll
    for (int j = 0; j < 8; ++j) { v[j] = v[j] - m0; w[j] = w[j] - m1; s2 += (v[j][0] * v[j][0] + v[j][1] * v[j][1]) + (v[j][2] * v[j][2] + v[j][3] * v[j][3]); t2 += (w[j][0] * w[j][0] + w[j][1] * w[j][1]) + (w[j][2] * w[j][2] + w[j][3] * w[j][3]); }
#pragma unroll
    for (int o = 1; o < 64; o <<= 1) { s2 += __shfl_xor(s2, o); t2 += __shfl_xor(t2, o); }
    const float r0 = 1.f / sqrtf(s2 * (1.f / DM) + LN_EPS), r1 = 1.f / sqrtf(t2 * (1.f / DM) + LN_EPS);
#pragma unroll
    for (int j = 0; j < 8; ++j) { const f32x4 gg = ((const f32x4*)g)[64 * j + lane], bb = ((const f32x4*)b)[64 * j + lane]; const f32x4 o0 = v[j] * r0 * gg + bb, o1 = w[j] * r1 * gg + bb;
        if (OUT_BF16) { u32x2 p; p.x = cvtpk_s(o0[0], o0[1]); p.y = cvtpk_s(o0[2], o0[3]); ((u32x2*)out0)[64 * j + lane] = p; p.x = cvtpk_s(o1[0], o1[1]); p.y = cvtpk_s(o1[2], o1[3]); ((u32x2*)out1)[64 * j + lane] = p; }
        else { ((f32x4*)out0)[64 * j + lane] = o0; ((f32x4*)out1)[64 * j + lane] = o1; } }
}

template <bool OUT_BF16, bool IN_BF16> __device__ __forceinline__ void ln_stream(const void* in, void* out, const float* g, const float* b, int gw, int ngw, int lane) {
    typedef typename std::conditional<IN_BF16, u32x2, f32x4>::type raw_t;
    f32x4 gg[8], bb[8];
#pragma unroll
    for (int j = 0; j < 8; ++j) { gg[j] = ((const f32x4*)g)[64 * j + lane]; bb[j] = ((const f32x4*)b)[64 * j + lane]; }
    raw_t cur[2][8], nxt[2][8];
    const int nit = MTOK / (2 * ngw);
#define LN_LOAD(dst, it) do { _Pragma("unroll") for (int r = 0; r < 2; ++r) { const raw_t* rp = (const raw_t*)((const char*)in + (size_t)(gw + (2 * (it) + r) * ngw) * DM * (IN_BF16 ? 2 : 4)) + lane; \
        _Pragma("unroll") for (int j = 0; j < 8; ++j) dst[r][j] = rp[64 * j]; } } while (0)
    LN_LOAD(cur, 0);
    for (int it = 0; it < nit; ++it) {
        if (it + 1 < nit) LN_LOAD(nxt, it + 1);
        f32x4 v[2][8]; float s[2], s2[2];
#pragma unroll
        for (int r = 0; r < 2; ++r) { s[r] = 0.f;
#pragma unroll
            for (int j = 0; j < 8; ++j) { if constexpr (IN_BF16) { const u32x2 w = *(const u32x2*)&cur[r][j]; v[r][j] = (f32x4){bflo(w.x), bfhi(w.x), bflo(w.y), bfhi(w.y)}; } else v[r][j] = *(const f32x4*)&cur[r][j];
                s[r] += (v[r][j][0] + v[r][j][1]) + (v[r][j][2] + v[r][j][3]); } }
#pragma unroll
        for (int o = 1; o < 64; o <<= 1) { s[0] += __shfl_xor(s[0], o); s[1] += __shfl_xor(s[1], o); }
#pragma unroll
        for (int r = 0; r < 2; ++r) { const float mean = s[r] * (1.f / DM); s2[r] = 0.f;
#pragma unroll
            for (int j = 0; j < 8; ++j) { v[r][j] = v[r][j] - mean; s2[r] += (v[r][j][0] * v[r][j][0] + v[r][j][1] * v[r][j][1]) + (v[r][j][2] * v[r][j][2] + v[r][j][3] * v[r][j][3]); } }
#pragma unroll
        for (int o = 1; o < 64; o <<= 1) { s2[0] += __shfl_xor(s2[0], o); s2[1] += __shfl_xor(s2[1], o); }
#pragma unroll
        for (int r = 0; r < 2; ++r) { const float rstd = 1.f / sqrtf(s2[r] * (1.f / DM) + LN_EPS); const size_t row = (size_t)(gw + (2 * it + r) * ngw);
#pragma unroll
            for (int j = 0; j < 8; ++j) { const f32x4 o = v[r][j] * rstd * gg[j] + bb[j];
                if (OUT_BF16) { u32x2 pk; pk.x = cvtpk_s(o[0], o[1]); pk.y = cvtpk_s(o[2], o[3]); ((u32x2*)((bf16_t*)out + row * DM))[64 * j + lane] = pk; }
                else ((f32x4*)((float*)out + row * DM))[64 * j + lane] = o; } }
#pragma unroll
        for (int r = 0; r < 2; ++r)
#pragma unroll
            for (int j = 0; j < 8; ++j) cur[r][j] = nxt[r][j];
    }
#undef LN_LOAD
}

__device__ __forceinline__ void phase_prep(const Args& a, LAS unsigned char* lds, int gw, int ngw, int wave, int lane) {
    LAS float* scr = (LAS float*)(lds + wave * 8448);
    bf16_t* W1T = (bf16_t*)(a.ws + OFF_W1T); bf16_t* WOT = (bf16_t*)(a.ws + OFF_WOT);
    constexpr int I1 = 32 * (N1 / 32), IO = 32 * 64;
    for (int it = gw; it < I1; it += ngw) {
        if (it < I1) { const int kb = it / (N1 / 32), nb = it % (N1 / 32), n0 = nb * 32;
            const bool zero = n0 >= 14400; int src;
            if (n0 < 4096) src = n0;
            else if (n0 < 8192) { const int t = (n0 - 4096) >> 8, wi = n0 & 255; src = wi < 128 ? 4096 + 128 * t + wi : 10304 + 128 * t + (wi - 128); }
            else if (n0 < 12288) { const int t = (n0 - 8192) >> 8, wi = n0 & 255; src = wi < 128 ? 6208 + 128 * t + wi : 12352 + 128 * t + (wi - 128); }
            else if (n0 < 14336) src = 8256 + (n0 - 12288);
            else src = 6144 + (n0 - 14336);
            tr_item(a.w_in, 14400, zero ? 0 : src, kb * 64, W1T, 2048, n0, scr, lane, zero, 0, n0 < 1024); }
        else { const int r = it - I1, kb = r / 64, nb = r % 64; tr_item(a.w_o, 2048, nb * 32, kb * 64, WOT, 2048, nb * 32, scr, lane, false); }
    }
    bf16_t* H0 = (bf16_t*)(a.ws + OFF_H0);
    ln_stream<true, false>(a.x, H0, a.ln0_g, a.ln0_b, gw, ngw, lane);
}
__device__ __forceinline__ void phase_prep2(const Args& a, LAS unsigned char* lds, int gw, int ngw, int wave, int lane) {
    LAS float* scr = (LAS float*)(lds + wave * 8448);
    bf16_t* WGUT = (bf16_t*)(a.out + DO_WGUT); bf16_t* WDT = (bf16_t*)(a.out + DO_WDT);
    constexpr int IG = 32 * (NGU / 32), ID = 88 * 64, IP = 4 * 64;
    { bf16_t* WOT = (bf16_t*)(a.ws + OFF_WOT);
      for (int r = gw; r < 32 * 64; r += ngw) { const int kb = r / 64, nb = r % 64; tr_item(a.w_o, 2048, nb * 32, kb * 64, WOT, 2048, nb * 32, scr, lane, false); } }
    for (int it = gw; it < IG + ID + IP; it += ngw) {
        if (it < IG) { const int kb = it / (NGU / 32), nb = it % (NGU / 32), n0 = nb * 32, t = n0 >> 8, wi = n0 & 255;
            if (t < 44) tr_item(a.w_gu, 2 * DFF, wi < 128 ? t * 128 + wi : DFF + t * 128 + (wi - 128), kb * 64, WGUT, 2048, n0, scr, lane, false);
            else tr_item(a.w_pg, 2048, (t - 44) * 256 + wi, kb * 64, WGUT, 2048, n0, scr, lane, false); }
        else if (it < IG + ID) { const int r = it - IG, kb = r / 64, nb = r % 64; tr_item(a.w_down, 2048, nb * 32, kb * 64, WDT, KX, nb * 32, scr, lane, false, 256); }
        else { const int r = it - IG - ID, kb = r / 64, nb = r % 64; tr_item(a.w_pu, 2048, nb * 32, kb * 64, WDT, KX, nb * 32, scr, lane, false, 0); }
    }
}
__device__ __forceinline__ void phase_pconv(const Args& a, int gw, int ngw, int lane) {
    bf16_t* ACT = (bf16_t*)(a.ws + OFF_ACT);
    for (int i = gw * 64 + lane; i < MTOK * 64; i += ngw * 64) { const int m = i >> 6, c4 = (i & 63) * 4; const f32x4 v = *(const f32x4*)(a.p + (size_t)m * 256 + c4);
        u32x2 w; w.x = cvtpk_s(v[0], v[1]); w.y = cvtpk_s(v[2], v[3]); *(u32x2*)(ACT + (size_t)m * KX + c4) = w; }
}

__device__ __forceinline__ void phase_kt(const Args& a, LAS unsigned char* lds, int tid) {
    LAS float* fgs = (LAS float*)(lds + 131072);
    bf16_t* Kb = (bf16_t*)(a.ws + OFF_K); const float* FG = (const float*)(a.ws + OFF_FG); const float* FG2 = (const float*)(a.ws + OFF_FG2); float* DEC = (float*)(a.out + DO_DEC);
    const int col2 = 2 * tid, h = col2 >> 8, d = col2 & 255;
    float w0[16], w1[16];
#pragma unroll
    for (int r = 0; r < 16; ++r) { const float2 t = *(const float2*)(a.w_f2 + (h * 16 + r) * 256 + d); w0[r] = t.x; w1[r] = t.y; }
    const float2 bb = *(const float2*)(a.b_f2 + h * 256 + d);
    for (int it = blockIdx.x; it < NCHUNK; it += gridDim.x) {
        const size_t row0 = (size_t)it * 64;
        __syncthreads();
#pragma unroll
        for (int i = 0; i < 2; ++i) { const int p = tid + 512 * i; ((LAS f32x4*)fgs)[p] = ((const f32x4*)(FG + row0 * 64))[p] + ((const f32x4*)(FG2 + row0 * 64))[p] + *(const f32x4*)(a.b_in + 6144 + 4 * (p & 15)); }
        __syncthreads();
        float run0 = 0.f, run1 = 0.f;
        unsigned kwc[8], kwn[8];
#pragma unroll
        for (int tt = 0; tt < 8; ++tt) { kwc[tt] = *(const unsigned*)(Kb + (row0 + 56 + tt) * 1024 + col2); kwn[tt] = 0u; }
        for (int tg = 7; tg >= 0; --tg) {
            if (tg > 0) {
#pragma unroll
                for (int tt = 0; tt < 8; ++tt) kwn[tt] = *(const unsigned*)(Kb + (row0 + (tg - 1) * 8 + tt) * 1024 + col2); }
            float v0[8], v1[8];
#pragma unroll
            for (int tt = 7; tt >= 0; --tt) { const int t = tg * 8 + tt;
                const LAS f32x4* fp = (const LAS f32x4*)(fgs + t * 64 + h * 16);
                float f0 = bb.x, f1 = bb.y;
#pragma unroll
                for (int r4 = 0; r4 < 4; ++r4) { const f32x4 fv = fp[r4];
#pragma unroll
                    for (int j = 0; j < 4; ++j) { f0 += fv[j] * w0[r4 * 4 + j]; f1 += fv[j] * w1[r4 * 4 + j]; } }
                const float la0 = (fminf(f0, 0.f) - __logf(1.f + __expf(-fabsf(f0)))) * 0.0625f, la1 = (fminf(f1, 0.f) - __logf(1.f + __expf(-fabsf(f1)))) * 0.0625f;
                const unsigned kw = kwc[tt];
                v0[tt] = bflo(kw) * __expf(run0); v1[tt] = bfhi(kw) * __expf(run1);
                run0 += la0; run1 += la1; }
            u32x4 p0, p1;
            p0.x = cvtpk_s(v0[0], v0[1]); p0.y = cvtpk_s(v0[2], v0[3]); p0.z = cvtpk_s(v0[4], v0[5]); p0.w = cvtpk_s(v0[6], v0[7]);
            p1.x = cvtpk_s(v1[0], v1[1]); p1.y = cvtpk_s(v1[2], v1[3]); p1.z = cvtpk_s(v1[4], v1[5]); p1.w = cvtpk_s(v1[6], v1[7]);
            *(LAS u32x4*)(lds + col2 * 128 + ((tg ^ (col2 & 7)) << 4)) = p0;
            *(LAS u32x4*)(lds + (col2 + 1) * 128 + ((tg ^ ((col2 + 1) & 7)) << 4)) = p1;
#pragma unroll
            for (int tt = 0; tt < 8; ++tt) kwc[tt] = kwn[tt];
        }
        *(float2*)(DEC + (size_t)it * 1024 + col2) = make_float2(__expf(run0), __expf(run1));
        __syncthreads();
#pragma unroll
        for (int i = 0; i < 16; ++i) { const int p = tid + 512 * i, c = p >> 3, s = p & 7;
            *(u32x4*)(Kb + (size_t)it * 65536 + c * 64 + s * 8) = *(const LAS u32x4*)(lds + c * 128 + ((s ^ (c & 7)) << 4)); }
    }
    __syncthreads();
}

__device__ __forceinline__ void phase_scan(const Args& a, LAS unsigned char* lds, int tid, int wave, int lane) {
    const int bx = blockIdx.x, xcd = bx & 7, jj = bx >> 3, bh = xcd * 2 + (jj >> 3), b = bh >> 2, h = bh & 3, dvb = jj & 7, l15 = lane & 15, q = lane >> 4;
    constexpr int KTB = 0, QB = 65536, VB = 131072, DB = 147456;
    const bf16_t* KT = (const bf16_t*)(a.ws + OFF_K) + (size_t)(b * 128) * 65536 + h * 16384;
    const bf16_t* Qg = (const bf16_t*)(a.ws + OFF_Q) + (size_t)(b * 8192) * 1024 + h * 256;
    bf16_t* Vg = (bf16_t*)(a.ws + OFF_V) + (size_t)(b * 8192) * 2048 + h * 512 + dvb * 64;
    const float* DEC = (const float*)(a.out + DO_DEC) + (size_t)(b * 128) * 1024 + h * 256;
#define SBAR() do { asm volatile("s_waitcnt lgkmcnt(0)" ::: "memory"); __builtin_amdgcn_s_barrier(); asm volatile("" ::: "memory"); } while (0)
    if (wave >= 4) {
        const int lw = wave - 4;
        const unsigned kvo = (unsigned)(((lane >> 3) * 64 + (((lane & 7) ^ ((lane >> 3) & 7)) << 3)) * 2);
        unsigned qvo[8];
#pragma unroll
        for (int i = 0; i < 8; ++i) { const int frl = 2 * i + (lane >> 5); qvo[i] = (unsigned)(((lw * 16 + frl) * 1024 + (((lane & 31) ^ (frl & 15)) << 3)) * 2); }
        const unsigned vvo = (unsigned)(((lane >> 3) * 2048 + (lane & 7) * 8) * 2);
#define G1(cc) do { const int c_ = (cc) > 127 ? 127 : (cc); const char* qb_ = (const char*)(Qg + (size_t)c_ * 65536); LAS unsigned char* d_ = lds + QB + ((cc) & 1) * 32768 + lw * 8192; \
            _Pragma("unroll") for (int i = 0; i < 8; ++i) __builtin_amdgcn_global_load_lds((const unsigned*)(qb_ + qvo[i]), (LAS unsigned*)(d_ + i * 1024), 16, 0, 0); } while (0)
#define G2(cc) do { const int c_ = (cc) > 127 ? 127 : (cc); const char* kb_ = (const char*)(KT + (size_t)c_ * 65536) + lw * 8192; LAS unsigned char* d_ = lds + KTB + ((cc) & 1) * 32768 + lw * 8192; \
            _Pragma("unroll") for (int i = 0; i < 8; ++i) __builtin_amdgcn_global_load_lds((const unsigned*)(kb_ + i * 1024 + kvo), (LAS unsigned*)(d_ + i * 1024), 16, 0, 0); \
            const char* vb_ = (const char*)(Vg + (size_t)(c_ * 64 + lw * 16) * 2048); LAS unsigned char* dv_ = lds + VB + ((cc) & 1) * 8192 + lw * 2048; \
            _Pragma("unroll") for (int i = 0; i < 2; ++i) __builtin_amdgcn_global_load_lds((const unsigned*)(vb_ + (size_t)i * 8 * 2048 * 2 + vvo), (LAS unsigned*)(dv_ + i * 1024), 16, 0, 0); \
            __builtin_amdgcn_global_load_lds((const unsigned*)(DEC + (size_t)c_ * 1024 + lw * 64 + lane), (LAS unsigned*)(lds + DB + ((cc) & 1) * 1024 + lw * 256), 4, 0, 0); } while (0)
        G2(0); G1(0); G2(1);
        for (int c = 0; c < 128; ++c) {
            asm volatile("s_waitcnt vmcnt(19)" ::: "memory");
            SBAR();
            G1(c + 1);
            asm volatile("s_waitcnt vmcnt(19)" ::: "memory");
            SBAR();
            G2(c + 2);
        }
        asm volatile("s_waitcnt vmcnt(0)" ::: "memory");
#undef G1
#undef G2
    } else {
        const unsigned ovo = (unsigned)((l15 * 2048 + 16 * wave + 4 * q) * 2);
        __builtin_amdgcn_s_setprio(2);
        f32x4 accS[16];
#pragma unroll
        for (int i = 0; i < 16; ++i) accS[i] = (f32x4){0.f, 0.f, 0.f, 0.f};
        for (int c = 0; c < 128; ++c) {
            LAS unsigned char* KTs = lds + KTB + (c & 1) * 32768; LAS unsigned char* Qs = lds + QB + (c & 1) * 32768;
            const LAS unsigned short* Vs = (const LAS unsigned short*)(lds + VB + (c & 1) * 8192); LAS float* DECs = (LAS float*)(lds + DB + (c & 1) * 1024);
            SBAR();
            bf16x8 vb0, vb1;
            { const LAS unsigned short* vp = Vs + (8 * q) * 64 + 16 * wave + l15; unsigned w0[4], w1[4];
#pragma unroll
              for (int e = 0; e < 4; ++e) { w0[e] = (unsigned)vp[(2 * e) * 64] | ((unsigned)vp[(2 * e + 1) * 64] << 16); w1[e] = (unsigned)vp[(32 + 2 * e) * 64] | ((unsigned)vp[(32 + 2 * e + 1) * 64] << 16); }
              vb0 = __builtin_bit_cast(bf16x8, (u32x4){w0[0], w0[1], w0[2], w0[3]}); vb1 = __builtin_bit_cast(bf16x8, (u32x4){w1[0], w1[1], w1[2], w1[3]}); }
#define SCAN_KTLD(A0, A1, D, bt) do { _Pragma("unroll") for (int t = 0; t < 4; ++t) { const int dk = 16 * (4 * (bt) + t) + l15; \
                A0[t] = *(const LAS bf16x8*)(KTs + dk * 128 + ((q ^ (dk & 7)) << 4)); A1[t] = *(const LAS bf16x8*)(KTs + dk * 128 + (((4 + q) ^ (dk & 7)) << 4)); \
                D[t] = *(const LAS f32x4*)(DECs + 16 * (4 * (bt) + t) + 4 * q); } } while (0)
#define SCAN_KTMM(A0, A1, D, bt) do { _Pragma("unroll") for (int t = 0; t < 4; ++t) accS[4 * (bt) + t] = __builtin_amdgcn_mfma_f32_16x16x32_bf16(A0[t], vb0, accS[4 * (bt) + t] * D[t], 0, 0, 0); \
            _Pragma("unroll") for (int t = 0; t < 4; ++t) accS[4 * (bt) + t] = __builtin_amdgcn_mfma_f32_16x16x32_bf16(A1[t], vb1, accS[4 * (bt) + t], 0, 0, 0); } while (0)
            {
                bf16x8 xa0[4], xa1[4], ya0[4], ya1[4]; f32x4 xd[4], yd[4];
                SCAN_KTLD(xa0, xa1, xd, 0); __builtin_amdgcn_sched_barrier(0);
                SCAN_KTLD(ya0, ya1, yd, 1); __builtin_amdgcn_sched_barrier(0);
                SCAN_KTMM(xa0, xa1, xd, 0); __builtin_amdgcn_sched_barrier(0);
                SCAN_KTLD(xa0, xa1, xd, 2); __builtin_amdgcn_sched_barrier(0);
                SCAN_KTMM(ya0, ya1, yd, 1); __builtin_amdgcn_sched_barrier(0);
                SCAN_KTLD(ya0, ya1, yd, 3); __builtin_amdgcn_sched_barrier(0);
                SCAN_KTMM(xa0, xa1, xd, 2); __builtin_amdgcn_sched_barrier(0);
                SCAN_KTMM(ya0, ya1, yd, 3); __builtin_amdgcn_sched_barrier(0);
            }
            bf16x8 sf[8];
#pragma unroll
            for (int ks = 0; ks < 8; ++ks) { u32x4 w; w.x = cvtpk_s(accS[2 * ks][0], accS[2 * ks][1]); w.y = cvtpk_s(accS[2 * ks][2], accS[2 * ks][3]);
                w.z = cvtpk_s(accS[2 * ks + 1][0], accS[2 * ks + 1][1]); w.w = cvtpk_s(accS[2 * ks + 1][2], accS[2 * ks + 1][3]); sf[ks] = __builtin_bit_cast(bf16x8, w); }
            SBAR();
            f32x4 o[4];
#pragma unroll
            for (int ft = 0; ft < 4; ++ft) o[ft] = (f32x4){0.f, 0.f, 0.f, 0.f};
#define SCAN_QLD(Q, kb) do { _Pragma("unroll") for (int k2 = 0; k2 < 2; ++k2) _Pragma("unroll") for (int ft = 0; ft < 4; ++ft) { const int fr = 16 * ft + l15, pc = 4 * (2 * (kb) + k2) + q; \
                Q[k2 * 4 + ft] = *(const LAS u32x4*)(Qs + fr * 512 + ((pc ^ (fr & 15)) << 4)); } } while (0)
#define SCAN_QMM(Q, kb) do { _Pragma("unroll") for (int k2 = 0; k2 < 2; ++k2) _Pragma("unroll") for (int ft = 0; ft < 4; ++ft) \
                o[ft] = __builtin_amdgcn_mfma_f32_16x16x32_bf16(sf[2 * (kb) + k2], __builtin_bit_cast(bf16x8, Q[k2 * 4 + ft]), o[ft], 0, 0, 0); } while (0)
            {
                u32x4 xq[8], yq[8];
                SCAN_QLD(xq, 0); __builtin_amdgcn_sched_barrier(0);
                SCAN_QLD(yq, 1); __builtin_amdgcn_sched_barrier(0);
                SCAN_QMM(xq, 0); __builtin_amdgcn_sched_barrier(0);
                SCAN_QLD(xq, 2); __builtin_amdgcn_sched_barrier(0);
                SCAN_QMM(yq, 1); __builtin_amdgcn_sched_barrier(0);
                SCAN_QLD(yq, 3); __builtin_amdgcn_sched_barrier(0);
                SCAN_QMM(xq, 2); __builtin_amdgcn_sched_barrier(0);
                SCAN_QMM(yq, 3); __builtin_amdgcn_sched_barrier(0);
            }
#undef SCAN_KTLD
#undef SCAN_KTMM
#undef SCAN_QLD
#undef SCAN_QMM
#pragma unroll
            for (int ft = 0; ft < 4; ++ft) { u32x2 w; w.x = cvtpk_s(o[ft][0], o[ft][1]); w.y = cvtpk_s(o[ft][2], o[ft][3]);
                *(u32x2*)((char*)(Vg + (size_t)(c * 64 + 16 * ft) * 2048) + ovo) = w; }
        }
        __builtin_amdgcn_s_setprio(0);
    }
    SBAR();
#undef SBAR
}

__device__ __forceinline__ void phase_merge(const Args& a, LAS unsigned char* lds, int tid, int wave, int lane) {
    const int g = blockIdx.x & 3, l15 = lane & 15, q = lane >> 4;
    LAS unsigned char* Ws = lds; LAS unsigned char* ZT = lds + 32768; LAS float* SG = (LAS float*)(lds + 65536); LAS float* MU = (LAS float*)(lds + 65536 + 67584); LAS float* RS = MU + 128; LAS float* RO = MU + 256;
    const bf16_t* Zb = (const bf16_t*)(a.ws + OFF_Z); const bf16_t* Ob = (const bf16_t*)(a.ws + OFF_V); const bf16_t* OGb = (const bf16_t*)(a.ws + OFF_OG);
    bf16_t* Ub = (bf16_t*)(a.ws + OFF_U);
    for (int p = tid; p < 4096; p += 512) { const int i = p >> 5, j4 = (p & 31) * 4; f32x4 v = *(const f32x4*)(a.w_s + (size_t)g * 16384 + i * 128 + j4);
        if ((j4 >> 6) > (i >> 6)) v = (f32x4){0.f, 0.f, 0.f, 0.f};
        u32x2 w; w.x = cvtpk_s(v[0], v[1]); w.y = cvtpk_s(v[2], v[3]);
        *(LAS u32x2*)(Ws + i * 256 + (((j4 >> 3) ^ (i & 7)) << 4) + (j4 & 4) * 2) = w; }
    for (int item = blockIdx.x; item < 1024; item += gridDim.x) {
        const int nb = item >> 2; const size_t row0 = (size_t)nb * 128; const int colg = g * 512;
        __syncthreads();
#pragma unroll 4
        for (int rr = 0; rr < 16; ++rr) { const int i = wave * 16 + rr; const size_t off = (row0 + i) * DM + colg + lane * 8;
            const u32x4 zw = *(const u32x4*)(Zb + off), ow = *(const u32x4*)(Ob + off);
            float z[8] = {bflo(zw.x), bfhi(zw.x), bflo(zw.y), bfhi(zw.y), bflo(zw.z), bfhi(zw.z), bflo(zw.w), bfhi(zw.w)};
            const float o[8] = {bflo(ow.x), bfhi(ow.x), bflo(ow.y), bfhi(ow.y), bflo(ow.z), bfhi(ow.z), bflo(ow.w), bfhi(ow.w)};
            float s = 0.f, so = 0.f;
#pragma unroll
            for (int e = 0; e < 8; ++e) { s += z[e]; so += o[e] * o[e]; }
            const float mean = wave_sum(s) * (1.f / 512.f); so = wave_sum(so); float s2 = 0.f;
#pragma unroll
            for (int e = 0; e < 8; ++e) { const float dd = z[e] - mean; s2 += dd * dd; }
            s2 = wave_sum(s2);
            if (lane == 0) { MU[i] = mean; RS[i] = 1.f / sqrtf(s2 * (1.f / 512.f) + LN_EPS); RO[i] = 1.f / sqrtf(so * (1.f / 512.f) + LN_EPS); } }
        __syncthreads();
        for (int cc = 0; cc < 4; ++cc) {
            const int colc = colg + cc * 128;
            u32x4 uw4[4], ow4[4], gw4[4];
#pragma unroll
            for (int k = 0; k < 4; ++k) { const int p = tid + 512 * k, i = p >> 4, c8 = (p & 15) * 8; const size_t off = (row0 + i) * DM + colc + c8;
                uw4[k] = *(const u32x4*)(Ub + off); ow4[k] = *(const u32x4*)(Ob + off); gw4[k] = *(const u32x4*)(OGb + off); }
#pragma unroll
            for (int i = 0; i < 4; ++i) { const int p = tid + 512 * i, j = p >> 4, c8 = (p & 15) * 8;
                const u32x4 zw = *(const u32x4*)(Zb + (row0 + j) * DM + colc + c8);
                const float z[8] = {bflo(zw.x), bfhi(zw.x), bflo(zw.y), bfhi(zw.y), bflo(zw.z), bfhi(zw.z), bflo(zw.w), bfhi(zw.w)};
                const float mu = MU[j], rs = RS[j];
                const f32x4 g0 = *(const f32x4*)(a.gm_g + colc + c8), g1 = *(const f32x4*)(a.gm_g + colc + c8 + 4), b0 = *(const f32x4*)(a.gm_b + colc + c8), b1 = *(const f32x4*)(a.gm_b + colc + c8 + 4);
#pragma unroll
                for (int e = 0; e < 8; ++e) { const float gg = e < 4 ? g0[e & 3] : g1[e & 3], bb = e < 4 ? b0[e & 3] : b1[e & 3]; const float zn = (z[e] - mu) * rs * gg + bb;
                    const int c = c8 + e; const unsigned short val = (unsigned short)(cvtpk_s(zn, 0.f) & 0xffffu);
                    *(LAS unsigned short*)(ZT + c * 256 + (((j >> 3) ^ (c & 7)) << 4) + (j & 7) * 2) = val; } }
            __syncthreads();
            {
                const int c = 16 * wave + l15; bf16x8 zf[4];
#pragma unroll
                for (int ks = 0; ks < 4; ++ks) zf[ks] = *(const LAS bf16x8*)(ZT + c * 256 + (((4 * ks + q) ^ (c & 7)) << 4));
#pragma unroll
                for (int it = 0; it < 8; ++it) { const int i = 16 * it + l15; f32x4 acc = (f32x4){0.f, 0.f, 0.f, 0.f};
#pragma unroll
                    for (int ks = 0; ks < 4; ++ks) { if (it < 4 && ks >= 2) continue;
                        const bf16x8 wf = *(const LAS bf16x8*)(Ws + i * 256 + (((4 * ks + q) ^ (i & 7)) << 4));
                        acc = __builtin_amdgcn_mfma_f32_16x16x32_bf16(wf, zf[ks], acc, 0, 0, 0); }
#pragma unroll
                    for (int r = 0; r < 4; ++r) SG[(16 * it + 4 * q + r) * 132 + c] = acc[r]; }
            }
            __syncthreads();
#pragma unroll
            for (int k = 0; k < 4; ++k) { const int p = tid + 512 * k, i = p >> 4, c8 = (p & 15) * 8; const size_t off = (row0 + i) * DM + colc + c8;
                const u32x4 uw = uw4[k], ow = ow4[k], gw = gw4[k];
                const f32x4 s0 = *(const LAS f32x4*)(SG + i * 132 + c8), s1 = *(const LAS f32x4*)(SG + i * 132 + c8 + 4);
                const f32x4 n0 = *(const f32x4*)(a.gla_g + colc + c8), n1 = *(const f32x4*)(a.gla_g + colc + c8 + 4);
                const float bs = a.b_s[g * 128 + i], ro = RO[i];
                const unsigned uu[4] = {uw.x, uw.y, uw.z, uw.w}, oo[4] = {ow.x, ow.y, ow.z, ow.w}, gg[4] = {gw.x, gw.y, gw.z, gw.w};
                float m[8];
#pragma unroll
                for (int e = 0; e < 8; ++e) { const int wi = e >> 1; const bool hi = e & 1;
                    const float uv = hi ? bfhi(uu[wi]) : bflo(uu[wi]), ov = hi ? bfhi(oo[wi]) : bflo(oo[wi]), gv = hi ? bfhi(gg[wi]) : bflo(gg[wi]);
                    const float sg = (e < 4 ? s0[e & 3] : s1[e & 3]) + bs, ng = e < 4 ? n0[e & 3] : n1[e & 3];
                    m[e] = gv * (ov * ro * ng) + uv * sg; }
                u32x4 w; w.x = cvtpk_s(m[0], m[1]); w.y = cvtpk_s(m[2], m[3]); w.z = cvtpk_s(m[4], m[5]); w.w = cvtpk_s(m[6], m[7]);
                *(u32x4*)(Ub + off) = w; }
        }
    }
    __syncthreads();
}

typedef __attribute__((address_space(1))) unsigned gu32;
#define XB_TMO      128
#define XB_XCNT(j)  (256  + 64 * (j))
#define XB_XSUB(j)  (1280 + 64 * (j))
#define XB_XGEN(j)  (2304 + 64 * (j))
#define XB_TOP      3328
#define XB_TOPGEN   3392
#define XCD_BAR_WORDS 3456
#define XB_SPIN_CAP (1u << 18)

__device__ __forceinline__ unsigned xb_ld(unsigned* p)              { return __hip_atomic_load(p, __ATOMIC_RELAXED, __HIP_MEMORY_SCOPE_AGENT); }
__device__ __forceinline__ unsigned xb_add(unsigned* p, unsigned v) { return __hip_atomic_fetch_add(p, v, __ATOMIC_RELAXED, __HIP_MEMORY_SCOPE_AGENT); }
__device__ __forceinline__ unsigned xb_xcc_id() { return (unsigned)__builtin_amdgcn_s_getreg((3 << 11) | 20) & 0xFu; }
#define XB_SPIN(cond, bar) do { unsigned _sp = 0; while (cond) { __builtin_amdgcn_s_sleep(1); \
    if ((++_sp & 255u) == 0u) { if (xb_ld(&(bar)[XB_TMO])) break; if (_sp > XB_SPIN_CAP) { atomicAdd(&(bar)[XB_TMO], 1u); break; } } } } while (0)

struct XcdBarrier {
    unsigned* bar; unsigned x;
    volatile LAS unsigned* st;
};

__device__ __forceinline__ XcdBarrier xcd_barrier_post(unsigned* bar, volatile LAS unsigned* st) {
    XcdBarrier b; b.bar = bar; b.x = xb_xcc_id(); b.st = st;
    if (threadIdx.x == 0) (void)xb_add(&bar[XB_XCNT(b.x)], 1u);
    return b;
}
__device__ __forceinline__ void xcd_barrier_complete(unsigned* bar, unsigned x, unsigned& nloc, unsigned& nx) {
    const unsigned G = gridDim.x * gridDim.y * gridDim.z;
    unsigned sum, cnt, mine, sp = 0u;
    for (;;) {
        sum = 0u; cnt = 0u; mine = 0u;
#pragma unroll
        for (unsigned j = 0; j < 16; ++j) { const unsigned c = xb_ld(&bar[XB_XCNT(j)]); sum += c; cnt += (c > 0u) ? 1u : 0u; mine = (j == x) ? c : mine; }
        if (sum == G) break;
        __builtin_amdgcn_s_sleep(1);
        if ((++sp & 255u) == 0u) { if (xb_ld(&bar[XB_TMO])) break; if (sp > XB_SPIN_CAP) { atomicAdd(&bar[XB_TMO], 1u); break; } }
    }
    nloc = mine > 0u ? mine : 1u; nx = cnt > 0u ? cnt : 1u;
}

__device__ __forceinline__ void xcd_barrier(const XcdBarrier& b) {
    asm volatile("s_waitcnt vmcnt(0)" ::: "memory");
    __syncthreads();
    if (threadIdx.x == 0) {
        unsigned* bar = b.bar;
        __builtin_amdgcn_s_waitcnt(0);
        unsigned nloc = b.st[0], nx = b.st[1];
        if (nloc == 0u) { xcd_barrier_complete(bar, b.x, nloc, nx); b.st[0] = nloc; b.st[1] = nx; }
        const unsigned old = xb_add(&bar[XB_XSUB(b.x)], 1u);
        const unsigned gen = old / nloc;
        if (old + 1u == (gen + 1u) * nloc) {
            __builtin_amdgcn_fence(__ATOMIC_RELEASE, "agent");
            asm volatile("s_waitcnt vmcnt(0)" ::: "memory");
            const unsigned og = xb_add(&bar[XB_TOP], 1u);
            const unsigned tg = og / nx;
            if (og + 1u == (tg + 1u) * nx) xb_add(&bar[XB_TOPGEN], 1u);
            else XB_SPIN(xb_ld(&bar[XB_TOPGEN]) == tg, bar);
            __builtin_amdgcn_fence(__ATOMIC_ACQUIRE, "agent");
            xb_add(&bar[XB_XGEN(b.x)], 1u);
            asm volatile("s_waitcnt vmcnt(0)" ::: "memory");
        } else {
            XB_SPIN(xb_ld(&bar[XB_XGEN(b.x)]) == gen, bar);
            __builtin_amdgcn_fence(__ATOMIC_ACQUIRE, "agent");
            asm volatile("s_waitcnt vmcnt(0)" ::: "memory");
        }
    }
    __syncthreads();
}


__global__ void __launch_bounds__(512, 2) mega(Args a) {
    extern __shared__ __attribute__((aligned(16))) unsigned char lds_raw[];
    LAS unsigned char* lds = (LAS unsigned char*)lds_raw;
    const int tid = threadIdx.x, lane = tid & 63, wave = __builtin_amdgcn_readfirstlane(tid >> 6);
    const int G = gridDim.x, gw = blockIdx.x * 8 + wave, ngw = G * 8;
    const int lo = a.ph_lo, hi = a.ph_hi;
    if (tid < 16) ((LAS unsigned*)(lds + LDS_BARW))[tid] = 0u;
    __syncthreads();
    XcdBarrier bar; bar.bar = (unsigned*)(a.ws + OFF_CTL); bar.x = 0; bar.st = nullptr;
    if (a.coop) bar = xcd_barrier_post((unsigned*)(a.ws + OFF_CTL), (volatile LAS unsigned*)(lds + LDS_BARW));
#define IN(k) (lo <= (k) && (k) < hi)
#ifndef PROF_SEC
#define PROF_SEC 0
#endif
#ifndef PROF_WG
#define PROF_WG 0
#endif
    unsigned long long bacc = 0ull;
#define SEAM(k) do { if (IN(k) && IN((k) + 1)) { unsigned long long tb_ = 0ull; if (PROF_SEC == 20 && (k) != 0) tb_ = __builtin_amdgcn_s_memrealtime(); if ((k) == 0) cg::this_grid().sync(); else xcd_barrier(bar); \
        if (PROF_SEC == 20 && (k) != 0) bacc += __builtin_amdgcn_s_memrealtime() - tb_; } } while (0)
    if (IN(0)) { phase_prep(a, lds, gw, ngw, wave, lane); __syncthreads(); }
    SEAM(0);
    if (IN(1)) { { pg8::Gemm gm{(const bf16_t*)(a.ws + OFF_H0), (const bf16_t*)(a.ws + OFF_W1T), MTOK, 14336, DM}; pg8::StaticOrder S; S.init(MTOK, 14336, G, (int)blockIdx.x);
          Epi1 E{a.ws, a.out, a.b_in};
          pg8::gemm_phase<Epi1, pg8::StaticOrder, true, true>(lds, gm, S, E); }
        { pg8::Gemm gm{(const bf16_t*)(a.ws + OFF_H0), (const bf16_t*)(a.ws + OFF_W1T) + (size_t)14336 * DM, MTOK, 512, 1024, DM, (size_t)2048, (size_t)2048}; pg8::StaticOrder S; S.init(MTOK, 512, G, (int)blockIdx.x);
          EpiFg E{(float*)(a.ws + OFF_FG), (float*)(a.ws + OFF_FG2)};
          pg8::gemm_phase<EpiFg, pg8::StaticOrder, true, true>(lds, gm, S, E); } }
    SEAM(1);
    if (IN(2)) phase_kt(a, lds, tid);
    SEAM(2);
    if (IN(3)) { if (blockIdx.x < 128) phase_scan(a, lds, tid, wave, lane); else { phase_prep2(a, lds, (blockIdx.x - 128) * 8 + wave, (G - 128) * 8, wave, lane); __syncthreads(); } }
    SEAM(3);
    if (IN(4)) phase_merge(a, lds, tid, wave, lane);
    SEAM(4);
    if (IN(5)) { pg8::Gemm gm{(const bf16_t*)(a.ws + OFF_U), (const bf16_t*)(a.ws + OFF_WOT), MTOK, DM, DM}; pg8::StaticOrder S; S.init(MTOK, DM, G, (int)blockIdx.x);
        EpiRes<false> E{(bf16_t*)(a.ws + OFF_H1PRE), (const bf16_t*)(a.ws + OFF_H0), nullptr};
        pg8::gemm_phase<EpiRes<false>, pg8::StaticOrder, true, true>(lds, gm, S, E); }
    SEAM(5);
    if (IN(6)) { const bf16_t* src = (const bf16_t*)(a.ws + OFF_H1PRE); bf16_t* H1 = (bf16_t*)(a.ws + OFF_H1);
        ln_stream<true, true>(src, H1, a.ln1_g, a.ln1_b, gw, ngw, lane); }
    SEAM(6);
    if (IN(7)) { phase_pconv(a, gw, ngw, lane);
        pg8::Gemm gm{(const bf16_t*)(a.ws + OFF_H1), (const bf16_t*)(a.out + DO_WGUT), MTOK, NGU, DM}; pg8::StaticOrder S; S.init(MTOK, NGU, G, (int)blockIdx.x);
        Epi5 E{(bf16_t*)(a.ws + OFF_ACT), (bf16_t*)(a.ws + OFF_GPG), a.b_pg};
        pg8::gemm_phase<Epi5, pg8::StaticOrder, true, true>(lds, gm, S, E); }
    SEAM(7);
    if (IN(9)) { pg8::Gemm gm{(const bf16_t*)(a.ws + OFF_ACT), (const bf16_t*)(a.out + DO_WDT), MTOK, DM, KX}; pg8::StaticOrder S; S.init(MTOK, DM, G, (int)blockIdx.x);
        EpiDown E{(bf16_t*)(a.ws + OFF_OUTPRE), (const bf16_t*)(a.ws + OFF_H1), (const bf16_t*)(a.ws + OFF_GPG)};
        pg8::gemm_phase<EpiDown, pg8::StaticOrder, true, true>(lds, gm, S, E); }
    SEAM(9);
    if (IN(10)) { const bf16_t* src = (const bf16_t*)(a.ws + OFF_OUTPRE); float* o = (float*)a.out;
        ln_stream<false, true>(src, o, a.ln2_g, a.ln2_b, gw, ngw, lane);
        if (PROF_SEC == 20) { __syncthreads(); if (blockIdx.x == PROF_WG && wave == 0) { const float d = (float)bacc * 0.01f * 5e-4f;
#pragma unroll 1
                for (int k = 0; k < 16; ++k) if (lane == 0) o[(size_t)(gw + k * ngw) * DM] += (k & 1) ? -d : d; } } }
    if (IN(11)) {
        float* o = (float*)a.out;
        if (a.pad == 0) { const bf16_t* src = (const bf16_t*)(a.ws + (size_t)a.coop * MiB);
            for (size_t i = (size_t)blockIdx.x * 512 + tid; i < (size_t)MTOK * DM; i += (size_t)G * 512) o[i] = __uint_as_float(((unsigned)src[i]) << 16); }
        else { const float* src = (const float*)(a.ws + (size_t)a.coop * MiB);
            for (size_t i = (size_t)blockIdx.x * 512 + tid; i < (size_t)MTOK * DM; i += (size_t)G * 512) o[i] = src[i]; }
    }
#undef IN
#undef SEAM
}

#ifndef N_LAUNCH_MODE
#define N_LAUNCH_MODE 1
#endif
extern "C" void kernel_launch(void* const* d_in, const int* in_sizes, int n_in, void* d_out, int out_size, void* d_ws, size_t ws_size, hipStream_t stream) {
    static int grid = 0;
    if (grid == 0) {
        if (n_in != 23 || out_size != MTOK * DM || ws_size < WS_NEED) { fprintf(stderr, "kernel_launch: unexpected shapes (n_in %d out %d ws %zu)\n", n_in, out_size, ws_size); grid = -1; return; }
        int dev = 0, cus = 0, per_cu = 0;
        hipGetDevice(&dev); hipDeviceGetAttribute(&cus, hipDeviceAttributeMultiprocessorCount, dev);
        if (hipFuncSetAttribute((const void*)mega, hipFuncAttributeMaxDynamicSharedMemorySize, LDS_BYTES) != hipSuccess) { fprintf(stderr, "kernel_launch: hipFuncSetAttribute failed\n"); grid = -1; return; }
        hipOccupancyMaxActiveBlocksPerMultiprocessor(&per_cu, (const void*)mega, 512, LDS_BYTES);
        (void)hipGetLastError();
        if (cus != 256 || per_cu < 1) { fprintf(stderr, "kernel_launch: needs 256 CUs with one resident block each (cus %d per_cu %d)\n", cus, per_cu); grid = -1; return; }
        grid = 256;
    }
    if (grid < 0) return;
    Args a{};
    const float** f = (const float**)&a;
    for (int i = 0; i < 23; ++i) f[i] = (const float*)d_in[i];
    a.out = (unsigned char*)d_out; a.ws = (unsigned char*)d_ws;
#if N_LAUNCH_MODE == 1
    a.ph_lo = 0; a.ph_hi = 11; a.coop = 1;
    if (hipMemsetAsync((char*)d_ws + OFF_CTL, 0, 65536, stream) != hipSuccess) { fprintf(stderr, "kernel_launch: memset failed\n"); return; }
    void* args[] = {&a};
    hipError_t e = hipLaunchCooperativeKernel((const void*)mega, dim3(grid), dim3(512), args, LDS_BYTES, stream);
    if (e != hipSuccess) fprintf(stderr, "cooperative launch failed: %s\n", hipGetErrorString(e));
#else
#ifndef DBG_STOP
#define DBG_STOP 10
#endif
#ifndef DBG_OFF_MIB
#define DBG_OFF_MIB 321
#endif
#ifndef DBG_F32
#define DBG_F32 0
#endif
#ifndef PROG
#define PROG {0, 1, 2, 3, 4, 5, 6, 7, 8, 9, 10}
#endif
    static const int prog[] = PROG;
    for (int pi = 0; pi < (int)(sizeof(prog) / sizeof(prog[0])); ++pi) { const int ph = prog[pi]; if (ph > DBG_STOP) break; a.ph_lo = ph; a.ph_hi = ph + 1; a.coop = 0;
        hipLaunchKernelGGL(mega, dim3(grid), dim3(512), LDS_BYTES, stream, a); }
    if (DBG_STOP < 10) { a.ph_lo = 11; a.ph_hi = 12; a.coop = DBG_OFF_MIB; a.pad = DBG_F32;
        hipLaunchKernelGGL(mega, dim3(grid), dim3(512), LDS_BYTES, stream, a); }
#endif
}
```

```cpp
#include <hip/hip_runtime.h>
#include <hip/hip_cooperative_groups.h>
#include <cstdio>
#include <cstdint>
#include <type_traits>
namespace cg = cooperative_groups;
namespace pg8 {
#define PG8_LAS __attribute__((address_space(3)))
typedef unsigned short bf16_t;
typedef short bf16x8 __attribute__((ext_vector_type(8)));
typedef float f32x4 __attribute__((ext_vector_type(4)));
typedef unsigned u32x4 __attribute__((ext_vector_type(4)));
constexpr int BM = 256, BK = 64, HALF = 128, HTB = HALF * BK * 2  , STAGE_BYTES = 8 * HTB, NXCD = 8, WGM = 8;

__host__ __device__ __forceinline__ int lds_byte(int r, int c) { const int st = (r >> 4) * 2 + (c >> 5), rr = r & 15, cc = c & 31, ob = rr * 64 + cc * 2; return st * 1024 + (ob ^ (((ob >> 9) & 1) << 5)); }
__host__ __device__ __forceinline__ void stage_rc(int b, int& R, int& C) { const int st = b / 1024, sb = b % 1024, swz = sb ^ (((sb >> 9) & 1) << 5); R = (st >> 1) * 16 + swz / 64; C = (st & 1) * 32 + (swz % 64) / 2; }
__host__ __device__ __forceinline__ int perm32(int rho) { const int n = rho >> 4, i = rho & 15; return 8 * (i >> 2) + 4 * n + (i & 3); }

struct Unit { int pm, pn; };
struct Gemm { const bf16_t* A; const bf16_t* Bt; int M, N, K; int ld = 0; size_t a_pn = 0; size_t b_pn = ~(size_t)0; };

struct StaticOrder {
    int nM, nN, nwg, G, c;
    __host__ __device__ void init(int M, int N, int G_, int c_) { nM = M / BM; nN = N / BM; nwg = nM * nN; G = G_; c = c_; }
    __host__ __device__ bool next(int i, Unit& u) const {
        const long L = (long)i * G + c; if (L >= nwg) return false;
        int wgid = (int)L; { const int q = nwg / NXCD, r = nwg % NXCD, xcd = wgid % NXCD, off = wgid / NXCD; wgid = (xcd < r ? xcd * (q + 1) : r * (q + 1) + (xcd - r) * q) + off; }
        const int nig = WGM * nN, gid = wgid / nig, fm = gid * WGM, gsz = (nM - fm) < WGM ? (nM - fm) : WGM;
        u.pm = fm + ((wgid % nig) % gsz); u.pn = (wgid % nig) / gsz; return true;
    }
    __device__ __forceinline__ void a_ready(const Unit&) const {}
    __device__ __forceinline__ void done(const Unit&) const {}
};
__device__ __forceinline__ unsigned cvt_pk_bf16(float lo, float hi) { unsigned r; asm volatile("v_cvt_pk_bf16_f32 %0, %1, %2" : "=v"(r) : "v"(lo), "v"(hi)); return r; }
typedef float f32x2 __attribute__((ext_vector_type(2)));
__device__ __forceinline__ f32x2 gelu_pk(f32x2 v) {
    const f32x2 av = __builtin_elementwise_abs(v), d = av * 0.2316418882f + 1.0f;
    f32x2 t; t.x = __builtin_amdgcn_rcpf(d.x); t.y = __builtin_amdgcn_rcpf(d.y);
    f32x2 q = t * 0.5307027145f + (-0.7265760135f); q = q * t + 0.7107068705f; q = q * t + (-0.142248368f); q = q * t + 0.127414796f; q = q * t;
    const f32x2 s = (v * v) * (-0.72134752044f);
    f32x2 e; e.x = __builtin_amdgcn_exp2f(s.x); e.y = __builtin_amdgcn_exp2f(s.y);
    const f32x2 m = v * (q * e), r = v - m;
    f32x2 o; o.x = v.x < 0.f ? m.x : r.x; o.y = v.y < 0.f ? m.y : r.y; return o;
}

template <class Epi, class Sched, bool ALIGN_EPI = false, bool SP2 = false>
__device__ __forceinline__ void gemm_phase(PG8_LAS unsigned char* lds, const Gemm g, const Sched& S, const Epi& E) {
    const int tid = threadIdx.x, wid = __builtin_amdgcn_readfirstlane(tid >> 6), lane = tid & 63, wr = wid >> 2, wc = wid & 3, fr = lane & 15, fq = lane >> 4;
    const int nt = g.K / BK, K = g.ld ? g.ld : g.K;
    unsigned voffA[2], voffB[2];
#pragma unroll
    for (int i = 0; i < 2; ++i) { int R, C; stage_rc(tid * 16 + i * 8192, R, C); const int Rb = Epi::PERM ? ((R & ~31) + perm32(R & 31)) : R;
        voffA[i] = (unsigned)(R * K + C) * 2u; voffB[i] = (unsigned)(Rb * K + C) * 2u; }
    const size_t kstep = (size_t)(BK * 2);
    const size_t hstep = (size_t)HALF * K * 2;
    const size_t tstep = 2 * hstep;
    const unsigned ldsw = (unsigned)wid * 1024u;
    const int aoff = lds_byte(wr * 64 + fr, fq * 8), boff = lds_byte(wc * 32 + fr, fq * 8);
#define PG8_SA(b, h) (((b) * 2 + (h)) * HTB)
#define PG8_SB(b, h) ((4 + (b) * 2 + (h)) * HTB)
#define PG8_STAGE(bufoff, gbase, voff) do { _Pragma("unroll") for (int _i = 0; _i < 2; ++_i) \
        __builtin_amdgcn_global_load_lds((const unsigned*)((const char*)(gbase) + (voff)[_i]), (PG8_LAS unsigned*)(lds + (bufoff) + ldsw + _i * 8192), 16, 0, 0); } while (0)
#define PG8_LDA(dst, b, h) do { _Pragma("unroll") for (int m = 0; m < 4; ++m) _Pragma("unroll") for (int k = 0; k < 2; ++k) dst[m][k] = *(const PG8_LAS bf16x8*)(lds + PG8_SA(b, h) + aoff + m * 2048 + k * 1024); } while (0)
#define PG8_LDB(dst, b, h) do { _Pragma("unroll") for (int n = 0; n < 2; ++n) _Pragma("unroll") for (int k = 0; k < 2; ++k) dst[n][k] = *(const PG8_LAS bf16x8*)(lds + PG8_SB(b, h) + boff + n * 2048 + k * 1024); } while (0)
#define PG8_MMA(ai, bj, At, Bt) do { __builtin_amdgcn_s_setprio(1); _Pragma("unroll") for (int m = 0; m < 4; ++m) _Pragma("unroll") for (int n = 0; n < 2; ++n) _Pragma("unroll") for (int k = 0; k < 2; ++k) \
        acc[ai][bj][m][n] = __builtin_amdgcn_mfma_f32_16x16x32_bf16(Bt[n][k], At[m][k], acc[ai][bj][m][n], 0, 0, 0); __builtin_amdgcn_s_setprio(0); } while (0)
#define PG8_WAIT_V(n) asm volatile("s_waitcnt vmcnt(" #n ")" ::: "memory")
#define PG8_WAIT_L(n) asm volatile("s_waitcnt lgkmcnt(" #n ")" ::: "memory")
#define PG8_BAR __builtin_amdgcn_s_barrier()
#define PG8_SCHED __builtin_amdgcn_sched_barrier(0)
    Unit cur, nxt; int ui = 0;
    if (!S.next(0, cur)) return;
    f32x4 acc[2][2][4][2];
#pragma unroll
    for (int a = 0; a < 2; ++a)
#pragma unroll
        for (int b = 0; b < 2; ++b)
#pragma unroll
            for (int m = 0; m < 4; ++m)
#pragma unroll
                for (int n = 0; n < 2; ++n) acc[a][b][m][n] = (f32x4){0.f, 0.f, 0.f, 0.f};
    bf16x8 At[4][2], B0[2][2], B1[2][2];
    const size_t bpn = g.b_pn == ~(size_t)0 ? tstep : g.b_pn;
    const char* cA = (const char*)g.A + (size_t)cur.pm * tstep + (size_t)cur.pn * g.a_pn; const char* cB = (const char*)g.Bt + (size_t)cur.pn * bpn;
    S.a_ready(cur);
    if constexpr (SP2) {
        PG8_STAGE(PG8_SB(0, 0), cB, voffB); PG8_STAGE(PG8_SB(0, 1), cB + hstep, voffB); PG8_STAGE(PG8_SA(0, 0), cA, voffA); PG8_STAGE(PG8_SA(0, 1), cA + hstep, voffA);
        if (wr == 1) PG8_BAR;
        PG8_WAIT_V(2); PG8_BAR;
        PG8_STAGE(PG8_SB(1, 0), cB + kstep, voffB); PG8_STAGE(PG8_SA(1, 0), cA + kstep, voffA); PG8_STAGE(PG8_SB(1, 1), cB + hstep + kstep, voffB);
        PG8_WAIT_V(6); PG8_BAR;
    } else {
        PG8_STAGE(PG8_SB(0, 0), cB, voffB); PG8_STAGE(PG8_SA(0, 0), cA, voffA); PG8_STAGE(PG8_SB(0, 1), cB + hstep, voffB); PG8_STAGE(PG8_SA(0, 1), cA + hstep, voffA);
        if (wr == 1) PG8_BAR;
        PG8_WAIT_V(4); PG8_BAR;
        PG8_STAGE(PG8_SB(1, 0), cB + kstep, voffB); PG8_STAGE(PG8_SA(1, 0), cA + kstep, voffA); PG8_STAGE(PG8_SB(1, 1), cB + hstep + kstep, voffB);
        PG8_WAIT_V(6); PG8_BAR;
    }
    for (;;) {
        const bool has_next = S.next(ui + 1, nxt);
        const char* nA = has_next ? (const char*)g.A + (size_t)nxt.pm * tstep + (size_t)nxt.pn * g.a_pn : cA; const char* nB = has_next ? (const char*)g.Bt + (size_t)nxt.pn * bpn : cB;
        for (int t = 0; t < nt; t += 2) {
            const bool last = (t == nt - 2);
            const char* a1 = cA + (size_t)(t + 1) * kstep;
            const char* a2 = last ? nA : cA + (size_t)(t + 2) * kstep; const char* b2 = last ? nB : cB + (size_t)(t + 2) * kstep;
            const char* a3 = a2 + kstep; const char* b3 = b2 + kstep;
            if (last && has_next) S.a_ready(nxt);
            if constexpr (Epi::HOOK_T > 0) { if (t == Epi::HOOK_T) E.hook(acc, cur, wr, wc, fr, fq); }
            if constexpr (SP2) {
            PG8_LDB(B0, 0, 0); PG8_LDB(B1, 0, 1); PG8_SCHED; PG8_LDA(At, 0, 0); PG8_STAGE(PG8_SA(1, 1), a1 + hstep, voffA);
            PG8_WAIT_V(8); PG8_WAIT_L(0); PG8_BAR; PG8_MMA(0, 0, At, B0); PG8_MMA(0, 1, At, B1); PG8_BAR; PG8_SCHED;
            PG8_LDA(At, 0, 1); PG8_STAGE(PG8_SB(0, 0), b2, voffB); PG8_STAGE(PG8_SB(0, 1), b2 + hstep, voffB); PG8_STAGE(PG8_SA(0, 0), a2, voffA);
            PG8_WAIT_V(8); PG8_WAIT_L(0); PG8_BAR; PG8_MMA(1, 0, At, B0); PG8_MMA(1, 1, At, B1); PG8_BAR; PG8_SCHED;
            PG8_LDB(B0, 1, 0); PG8_LDB(B1, 1, 1); PG8_SCHED; PG8_LDA(At, 1, 0); PG8_STAGE(PG8_SA(0, 1), a2 + hstep, voffA);
            PG8_WAIT_V(8); PG8_WAIT_L(0); PG8_BAR; PG8_MMA(0, 0, At, B0); PG8_MMA(0, 1, At, B1); PG8_BAR; PG8_SCHED;
            PG8_LDA(At, 1, 1); PG8_STAGE(PG8_SB(1, 0), b3, voffB); PG8_STAGE(PG8_SB(1, 1), b3 + hstep, voffB); PG8_STAGE(PG8_SA(1, 0), a3, voffA);
            PG8_WAIT_V(8); PG8_WAIT_L(0); PG8_BAR; PG8_MMA(1, 0, At, B0); PG8_MMA(1, 1, At, B1); PG8_BAR; PG8_SCHED;
            } else {
            PG8_LDB(B0, 0, 0); PG8_SCHED; PG8_LDA(At, 0, 0); PG8_STAGE(PG8_SA(1, 1), a1 + hstep, voffA);
            PG8_WAIT_L(8); PG8_BAR; PG8_WAIT_L(0); PG8_MMA(0, 0, At, B0); PG8_BAR; PG8_SCHED;
            PG8_LDB(B1, 0, 1); PG8_STAGE(PG8_SB(0, 0), b2, voffB);
            PG8_BAR; PG8_WAIT_L(0); PG8_MMA(0, 1, At, B1); PG8_BAR;
            PG8_LDA(At, 0, 1); PG8_STAGE(PG8_SA(0, 0), a2, voffA);
            PG8_BAR; PG8_WAIT_L(0); PG8_MMA(1, 0, At, B0); PG8_BAR; PG8_SCHED;
            PG8_STAGE(PG8_SB(0, 1), b2 + hstep, voffB);
            PG8_WAIT_V(6); PG8_BAR; PG8_MMA(1, 1, At, B1); PG8_BAR;
            PG8_LDB(B0, 1, 0); PG8_SCHED; PG8_LDA(At, 1, 0); PG8_STAGE(PG8_SA(0, 1), a2 + hstep, voffA);
            PG8_WAIT_L(8); PG8_BAR; PG8_WAIT_L(0); PG8_MMA(0, 0, At, B0); PG8_BAR; PG8_SCHED;
            PG8_LDB(B1, 1, 1); PG8_STAGE(PG8_SB(1, 0), b3, voffB);
            PG8_BAR; PG8_WAIT_L(0); PG8_MMA(0, 1, At, B1); PG8_BAR;
            PG8_LDA(At, 1, 1); PG8_STAGE(PG8_SA(1, 0), a3, voffA);
            PG8_BAR; PG8_WAIT_L(0); PG8_MMA(1, 0, At, B0); PG8_BAR; PG8_SCHED;
            PG8_STAGE(PG8_SB(1, 1), b3 + hstep, voffB);
            PG8_WAIT_V(6); PG8_BAR; PG8_MMA(1, 1, At, B1); PG8_BAR;
            }
        }
        if constexpr (ALIGN_EPI) { if (wr == 0) PG8_BAR; }
        if constexpr (!Epi::AFTER_DRAIN) { E(acc, cur, wr, wc, fr, fq); S.done(cur); }
        if (!has_next) break;
#pragma unroll
        for (int a = 0; a < 2; ++a)
#pragma unroll
            for (int b = 0; b < 2; ++b)
#pragma unroll
                for (int m = 0; m < 4; ++m)
#pragma unroll
                    for (int n = 0; n < 2; ++n) acc[a][b][m][n] = (f32x4){0.f, 0.f, 0.f, 0.f};
        cur = nxt; cA = nA; cB = nB; ++ui;
        if constexpr (ALIGN_EPI) { if (wr == 1) PG8_BAR; }
    }
    PG8_WAIT_V(0);
    if constexpr (!ALIGN_EPI) { if (wr == 0) PG8_BAR; }
    PG8_BAR;
    if constexpr (Epi::AFTER_DRAIN) { E.fused(acc, cur, wr, wc, fr, fq, lds, wid, lane); S.done(cur); }
#undef PG8_SA
#undef PG8_SB
#undef PG8_STAGE
#undef PG8_LDA
#undef PG8_LDB
#undef PG8_MMA
#undef PG8_WAIT_V
#undef PG8_WAIT_L
#undef PG8_BAR
#undef PG8_SCHED
}
}

#define LAS __attribute__((address_space(3)))
typedef unsigned short bf16_t;
typedef short bf16x8 __attribute__((ext_vector_type(8)));
typedef float f32x4 __attribute__((ext_vector_type(4)));
typedef unsigned u32x4 __attribute__((ext_vector_type(4)));
typedef unsigned u32x2 __attribute__((ext_vector_type(2)));

constexpr int KX = 5888  , MTOK = 32768, DM = 2048, NCHUNK = 512  , DFF = 5632, N1 = 14592, NGU = 13312;
constexpr float ALPHA = 1.189207115002721f, LN_EPS = 1e-5f;
constexpr size_t MiB = 1u << 20;
constexpr size_t OFF_W1T = 0, OFF_WOT = 57 * MiB, OFF_H0 = 65 * MiB, OFF_Q = 193 * MiB, OFF_K = 257 * MiB, OFF_V = 321 * MiB, OFF_OG = 449 * MiB,
                 OFF_U = 577 * MiB, OFF_Z = 705 * MiB, OFF_GA = 833 * MiB, OFF_FG = 961 * MiB, OFF_CTL = 969 * MiB, OFF_FG2 = 976 * MiB  , WS_NEED = 984 * MiB;
constexpr size_t OFF_H1PRE = OFF_V, OFF_H1 = OFF_Z, OFF_ACT = OFF_Q  , OFF_GPG = OFF_GA, OFF_OUTPRE = 0;
constexpr size_t DO_GB = 0, DO_PLEB = 0, DO_DEC = 128 * MiB, DO_WGUT = 130 * MiB, DO_WDT = 182 * MiB, DO_WPUT = 204 * MiB, DO_PB = 205 * MiB;
constexpr int LDS_BYTES = 153600, LDS_BARW = 153536;

struct Args {
    const float *x, *p, *ln0_g, *ln0_b, *w_in, *b_in, *w_f2, *b_f2, *gla_g, *gm_g, *gm_b, *w_s, *b_s, *w_o, *ln1_g, *ln1_b, *w_gu, *w_down, *w_pg, *b_pg, *w_pu, *ln2_g, *ln2_b;
    unsigned char* out; unsigned char* ws; int ph_lo, ph_hi, coop, pad;
};

typedef float f32x2_t __attribute__((ext_vector_type(2))); typedef __bf16 bf16x2_t __attribute__((ext_vector_type(2)));
__device__ __forceinline__ unsigned cvtpk_s(float lo, float hi) { f32x2_t v = {lo, hi}; bf16x2_t b = __builtin_convertvector(v, bf16x2_t); return __builtin_bit_cast(unsigned, b); }
__device__ __forceinline__ float bflo(unsigned w) { return __uint_as_float(w << 16); }
__device__ __forceinline__ float bfhi(unsigned w) { return __uint_as_float(w & 0xffff0000u); }
__device__ __forceinline__ float sigm(float x) { return __builtin_amdgcn_rcpf(1.f + __expf(-x)); }
#define WS_DPP(x, ctrl, rm) __builtin_bit_cast(float, __builtin_amdgcn_update_dpp(0, __builtin_bit_cast(int, (x)), (ctrl), (rm), 0xf, false))
__device__ __forceinline__ float wave_sum(float v) {
    v += WS_DPP(v, 0xb1, 0xf); v += WS_DPP(v, 0x4e, 0xf); v += WS_DPP(v, 0x124, 0xf); v += WS_DPP(v, 0x128, 0xf); v += WS_DPP(v, 0x142, 0xa); v += WS_DPP(v, 0x143, 0xc);
    return __builtin_bit_cast(float, __builtin_amdgcn_readlane(__builtin_bit_cast(int, v), 63));
}
#define LDS_WAIT() asm volatile("s_waitcnt lgkmcnt(0)" ::: "memory")

using pg8::Unit;
using pg8::gelu_pk;
typedef float f32x2 __attribute__((ext_vector_type(2)));

__device__ __forceinline__ void act8(f32x4& v0, f32x4& v1, int mode) {
    if (mode == 0) { v0 = v0 * 0.0625f; v1 = v1 * 0.0625f; }
    else if (mode == 2) {
#pragma unroll
        for (int j = 0; j < 4; ++j) { v0[j] = v0[j] * sigm(v0[j]); v1[j] = v1[j] * sigm(v1[j]); } }
    else if (mode == 3) { f32x2 a = gelu_pk((f32x2){v0[0], v0[1]}), b = gelu_pk((f32x2){v0[2], v0[3]}), c = gelu_pk((f32x2){v1[0], v1[1]}), d = gelu_pk((f32x2){v1[2], v1[3]});
        v0 = (f32x4){a.x, a.y, b.x, b.y}; v1 = (f32x4){c.x, c.y, d.x, d.y}; }
    else if (mode == 4) {
#pragma unroll
        for (int j = 0; j < 4; ++j) { v0[j] = sigm(v0[j]); v1[j] = sigm(v1[j]); } }
}

struct Epi1 {
    static constexpr bool PERM = true, AFTER_DRAIN = false; static constexpr int HOOK_T = 0;
    unsigned char* ws; unsigned char* dout; const float* b_in;
    __device__ __forceinline__ void operator()(const f32x4 (&acc)[2][2][4][2], const Unit& u, int wr, int wc, int fr, int fq) const {
        const int pn = u.pn; const int row0 = u.pm * 256 + wr * 64 + fr;
        if (pn == 56) {
            if (wc < 2) {
                float* FG = (float*)(ws + OFF_FG); const int c0 = wc * 32 + 8 * fq;
                const f32x4 b0 = *(const f32x4*)(b_in + 6144 + c0), b1 = *(const f32x4*)(b_in + 6144 + c0 + 4);
#pragma unroll
                for (int ai = 0; ai < 2; ++ai)
#pragma unroll
                    for (int m = 0; m < 4; ++m) { float* rp = FG + (size_t)(row0 + ai * 128 + m * 16) * 64 + c0;
                        *(f32x4*)rp = acc[ai][0][m][0] + b0; *(f32x4*)(rp + 4) = acc[ai][0][m][1] + b1; }
            }
            return;
        }
        const int cw = wc * 32 + 8 * fq;
        if (pn >= 16 && pn < 48) {
            const bool first = pn < 32; const int t = first ? pn - 16 : pn - 32;
            const float* bA = b_in + (first ? 4096 : 6208) + 128 * t + cw; const float* bB = b_in + (first ? 10304 : 12352) + 128 * t + cw;
            const f32x4 a0 = *(const f32x4*)bA, a1 = *(const f32x4*)(bA + 4), g0 = *(const f32x4*)bB, g1 = *(const f32x4*)(bB + 4);
            bf16_t* rowp0 = (bf16_t*)(ws + (first ? OFF_OG : OFF_U)) + (size_t)row0 * 2048 + 128 * t + cw;
            if (first) pair_body<2>(acc, a0, a1, g0, g1, rowp0); else pair_body<3>(acc, a0, a1, g0, g1, rowp0);
            return;
        }
        int mode, ldc, colt, bsrc; bf16_t* base;
        if (pn < 4) { mode = 0; base = (bf16_t*)(ws + OFF_Q); ldc = 1024; colt = pn * 256; bsrc = pn * 256; }
        else if (pn < 8) { mode = 1; base = (bf16_t*)(ws + OFF_K); ldc = 1024; colt = (pn - 4) * 256; bsrc = pn * 256; }
        else if (pn < 16) { mode = 1; base = (bf16_t*)(ws + OFF_V); ldc = 2048; colt = (pn - 8) * 256; bsrc = pn * 256; }
        else { mode = 3; base = (bf16_t*)(ws + OFF_Z); ldc = 2048; colt = (pn - 48) * 256; bsrc = 8256 + (pn - 48) * 256; }
        f32x4 bv[2][2];
#pragma unroll
        for (int bj = 0; bj < 2; ++bj)
#pragma unroll
            for (int n = 0; n < 2; ++n) bv[bj][n] = *(const f32x4*)(b_in + bsrc + bj * 128 + (mode == 0 ? wc * 32 + 4 * fq + 16 * n : cw + 4 * n));
        bf16_t* rowp0 = base + (size_t)row0 * ldc + colt + cw;
        switch (mode) {
            case 0: body<0>(acc, bv, rowp0, ldc); break;
            case 1: body<1>(acc, bv, rowp0, ldc); break;
            default: body<3>(acc, bv, rowp0, ldc); break;
        }
    }
    template <int MODE> __device__ __forceinline__ void body(const f32x4 (&acc)[2][2][4][2], const f32x4 (&bv)[2][2], bf16_t* rowp0, int ldc) const {
#pragma unroll
        for (int ai = 0; ai < 2; ++ai)
#pragma unroll
            for (int m = 0; m < 4; ++m) { bf16_t* rowp = rowp0 + (size_t)(ai * 128 + m * 16) * ldc;
#pragma unroll
                for (int bj = 0; bj < 2; ++bj) { f32x4 v0 = acc[ai][bj][m][0] + bv[bj][0], v1 = acc[ai][bj][m][1] + bv[bj][1];
                    act8(v0, v1, MODE);
                    u32x4 w; w.x = cvtpk_s(v0[0], v0[1]); w.y = cvtpk_s(v0[2], v0[3]); w.z = cvtpk_s(v1[0], v1[1]); w.w = cvtpk_s(v1[2], v1[3]);
                    *(u32x4*)(rowp + bj * 128) = w; } }
    }
    template <int MODE> __device__ __forceinline__ void pair_body(const f32x4 (&acc)[2][2][4][2], const f32x4 a0, const f32x4 a1, const f32x4 g0, const f32x4 g1, bf16_t* rowp0) const {
#pragma unroll
        for (int ai = 0; ai < 2; ++ai)
#pragma unroll
            for (int m = 0; m < 4; ++m) { f32x4 v0 = acc[ai][0][m][0] + a0, v1 = acc[ai][0][m][1] + a1, s0 = acc[ai][1][m][0] + g0, s1 = acc[ai][1][m][1] + g1;
                act8(v0, v1, MODE); act8(s0, s1, 4);
                v0 = v0 * s0; v1 = v1 * s1;
                u32x4 w; w.x = cvtpk_s(v0[0], v0[1]); w.y = cvtpk_s(v0[2], v0[3]); w.z = cvtpk_s(v1[0], v1[1]); w.w = cvtpk_s(v1[2], v1[3]);
                *(u32x4*)(rowp0 + (size_t)(ai * 128 + m * 16) * 2048) = w; }
    }
};

struct EpiFg {
    static constexpr bool PERM = true, AFTER_DRAIN = false; static constexpr int HOOK_T = 0;
    float* P0; float* P1;
    __device__ __forceinline__ void operator()(const f32x4 (&acc)[2][2][4][2], const Unit& u, int wr, int wc, int fr, int fq) const {
        if (wc >= 2) return;
        float* FG = u.pn ? P1 : P0; const int row0 = u.pm * 256 + wr * 64 + fr, c0 = wc * 32 + 8 * fq;
#pragma unroll
        for (int ai = 0; ai < 2; ++ai)
#pragma unroll
            for (int m = 0; m < 4; ++m) { float* rp = FG + (size_t)(row0 + ai * 128 + m * 16) * 64 + c0; *(f32x4*)rp = acc[ai][0][m][0]; *(f32x4*)(rp + 4) = acc[ai][0][m][1]; }
    }
};

template <bool HAS_P> struct EpiRes {
    static constexpr bool PERM = true, AFTER_DRAIN = false; static constexpr int HOOK_T = 0;
    bf16_t* out; const bf16_t* R; const bf16_t* P;
    __device__ __forceinline__ void operator()(const f32x4 (&acc)[2][2][4][2], const Unit& u, int wr, int wc, int fr, int fq) const {
        const int row0 = u.pm * 256 + wr * 64 + fr, col0 = u.pn * 256 + wc * 32 + 8 * fq;
#pragma unroll
        for (int ai = 0; ai < 2; ++ai)
#pragma unroll
            for (int mh = 0; mh < 2; ++mh) {
                u32x4 rr[2][2], qq[2][2];
#pragma unroll
                for (int m2 = 0; m2 < 2; ++m2)
#pragma unroll
                    for (int bj = 0; bj < 2; ++bj) { const size_t off = (size_t)(row0 + ai * 128 + (2 * mh + m2) * 16) * DM + col0 + bj * 128;
                        rr[m2][bj] = *(const u32x4*)(R + off); if (HAS_P) qq[m2][bj] = *(const u32x4*)(P + off); }
#pragma unroll
                for (int m2 = 0; m2 < 2; ++m2)
#pragma unroll
                    for (int bj = 0; bj < 2; ++bj) { const int m = 2 * mh + m2; const size_t off = (size_t)(row0 + ai * 128 + m * 16) * DM + col0 + bj * 128; const u32x4 r = rr[m2][bj];
                        f32x4 v0 = acc[ai][bj][m][0], v1 = acc[ai][bj][m][1];
                        v0 += (f32x4){bflo(r.x), bfhi(r.x), bflo(r.y), bfhi(r.y)} * ALPHA; v1 += (f32x4){bflo(r.z), bfhi(r.z), bflo(r.w), bfhi(r.w)} * ALPHA;
                        if (HAS_P) { const u32x4 q = qq[m2][bj];
                            v0 += (f32x4){bflo(q.x), bfhi(q.x), bflo(q.y), bfhi(q.y)}; v1 += (f32x4){bflo(q.z), bfhi(q.z), bflo(q.w), bfhi(q.w)}; }
                        u32x4 w; w.x = cvtpk_s(v0[0], v0[1]); w.y = cvtpk_s(v0[2], v0[3]); w.z = cvtpk_s(v1[0], v1[1]); w.w = cvtpk_s(v1[2], v1[3]);
                        *(u32x4*)(out + off) = w; }
                asm volatile("" ::: "memory");
            }
    }
};

struct EpiDown {
    static constexpr bool PERM = true, AFTER_DRAIN = false; static constexpr int HOOK_T = 4;
    bf16_t* out; const bf16_t* R; const bf16_t* G;
    __device__ __forceinline__ void hook(f32x4 (&acc)[2][2][4][2], const Unit& u, int wr, int wc, int fr, int fq) const {
        unsigned zoff; asm volatile("v_mov_b32 %0, 0" : "=v"(zoff));
        const bf16_t* gp = G + (size_t)(u.pm * 256 + wr * 64 + fr) * DM + u.pn * 256 + wc * 32 + 8 * fq + zoff;
#pragma unroll
        for (int ai = 0; ai < 2; ++ai)
#pragma unroll
            for (int mh = 0; mh < 2; ++mh) {
                u32x4 rr[2][2];
#pragma unroll
                for (int m2 = 0; m2 < 2; ++m2)
#pragma unroll
                    for (int bj = 0; bj < 2; ++bj) rr[m2][bj] = *(const u32x4*)(gp + (size_t)(ai * 128 + (2 * mh + m2) * 16) * DM + bj * 128);
#pragma unroll
                for (int m2 = 0; m2 < 2; ++m2)
#pragma unroll
                    for (int bj = 0; bj < 2; ++bj) { const u32x4 r = rr[m2][bj]; const int m = 2 * mh + m2;
                        acc[ai][bj][m][0] *= (f32x4){bflo(r.x), bfhi(r.x), bflo(r.y), bfhi(r.y)}; acc[ai][bj][m][1] *= (f32x4){bflo(r.z), bfhi(r.z), bflo(r.w), bfhi(r.w)}; }
                asm volatile("" ::: "memory");
            }
    }
    __device__ __forceinline__ void operator()(const f32x4 (&acc)[2][2][4][2], const Unit& u, int wr, int wc, int fr, int fq) const {
        const int row0 = u.pm * 256 + wr * 64 + fr, col0 = u.pn * 256 + wc * 32 + 8 * fq;
#pragma unroll
        for (int ai = 0; ai < 2; ++ai)
#pragma unroll
            for (int m = 0; m < 4; ++m)
#pragma unroll
                for (int bj = 0; bj < 2; ++bj) { const size_t off = (size_t)(row0 + ai * 128 + m * 16) * DM + col0 + bj * 128; const u32x4 r = *(const u32x4*)(R + off);
                    f32x4 v0 = acc[ai][bj][m][0], v1 = acc[ai][bj][m][1];
                    v0 += (f32x4){bflo(r.x), bfhi(r.x), bflo(r.y), bfhi(r.y)} * ALPHA; v1 += (f32x4){bflo(r.z), bfhi(r.z), bflo(r.w), bfhi(r.w)} * ALPHA;
                    u32x4 w; w.x = cvtpk_s(v0[0], v0[1]); w.y = cvtpk_s(v0[2], v0[3]); w.z = cvtpk_s(v1[0], v1[1]); w.w = cvtpk_s(v1[2], v1[3]);
                    *(u32x4*)(out + off) = w; }
    }
};

struct Epi5 {
    static constexpr bool PERM = true, AFTER_DRAIN = false; static constexpr int HOOK_T = 0;
    bf16_t* ACT; bf16_t* GPG; const float* b_pg;
    __device__ __forceinline__ void operator()(const f32x4 (&acc)[2][2][4][2], const Unit& u, int wr, int wc, int fr, int fq) const {
        const int pn = u.pn; const int row0 = u.pm * 256 + wr * 64 + fr, cw = wc * 32 + 8 * fq;
        if (pn < 44) {
#pragma unroll
            for (int ai = 0; ai < 2; ++ai)
#pragma unroll
                for (int m = 0; m < 4; ++m) { bf16_t* rowp = ACT + (size_t)(row0 + ai * 128 + m * 16) * KX + 256 + pn * 128 + cw;
                    f32x4 g0 = acc[ai][0][m][0], g1 = acc[ai][0][m][1]; const f32x4 u0 = acc[ai][1][m][0], u1 = acc[ai][1][m][1];
#pragma unroll
                    for (int j = 0; j < 4; ++j) { g0[j] = g0[j] * sigm(g0[j]) * u0[j]; g1[j] = g1[j] * sigm(g1[j]) * u1[j]; }
                    u32x4 w; w.x = cvtpk_s(g0[0], g0[1]); w.y = cvtpk_s(g0[2], g0[3]); w.z = cvtpk_s(g1[0], g1[1]); w.w = cvtpk_s(g1[2], g1[3]);
                    *(u32x4*)rowp = w; }
        } else {
            const int colt = (pn - 44) * 256;
            f32x4 bv[2][2];
#pragma unroll
            for (int bj = 0; bj < 2; ++bj)
#pragma unroll
                for (int n = 0; n < 2; ++n) bv[bj][n] = *(const f32x4*)(b_pg + colt + bj * 128 + cw + 4 * n);
#pragma unroll
            for (int ai = 0; ai < 2; ++ai)
#pragma unroll
                for (int m = 0; m < 4; ++m) { bf16_t* rowp = GPG + (size_t)(row0 + ai * 128 + m * 16) * DM + colt + cw;
#pragma unroll
                    for (int bj = 0; bj < 2; ++bj) { f32x4 v0 = acc[ai][bj][m][0] + bv[bj][0], v1 = acc[ai][bj][m][1] + bv[bj][1];
                        act8(v0, v1, 4);
                        u32x4 w; w.x = cvtpk_s(v0[0], v0[1]); w.y = cvtpk_s(v0[2], v0[3]); w.z = cvtpk_s(v1[0], v1[1]); w.w = cvtpk_s(v1[2], v1[3]);
                        *(u32x4*)(rowp + bj * 128) = w; } }
        }
    }
};

struct EpiPle {
    static constexpr bool PERM = true, AFTER_DRAIN = false; static constexpr int HOOK_T = 0;
    bf16_t* O; const bf16_t* G;
    __device__ __forceinline__ void operator()(const f32x4 (&acc)[2][2][4][2], const Unit& u, int wr, int wc, int fr, int fq) const {
        const int row0 = u.pm * 256 + wr * 64 + fr, col0 = u.pn * 256 + wc * 32 + 8 * fq;
#pragma unroll
        for (int ai = 0; ai < 2; ++ai) {
            u32x4 rr[4][2];
#pragma unroll
            for (int m = 0; m < 4; ++m)
#pragma unroll
                for (int bj = 0; bj < 2; ++bj) rr[m][bj] = *(const u32x4*)(G + (size_t)(row0 + ai * 128 + m * 16) * DM + col0 + bj * 128);
#pragma unroll
            for (int m = 0; m < 4; ++m)
#pragma unroll
                for (int bj = 0; bj < 2; ++bj) { const size_t off = (size_t)(row0 + ai * 128 + m * 16) * DM + col0 + bj * 128; const u32x4 r = rr[m][bj];
                    const f32x4 v0 = acc[ai][bj][m][0] * (f32x4){bflo(r.x), bfhi(r.x), bflo(r.y), bfhi(r.y)}, v1 = acc[ai][bj][m][1] * (f32x4){bflo(r.z), bfhi(r.z), bflo(r.w), bfhi(r.w)};
                    u32x4 w; w.x = cvtpk_s(v0[0], v0[1]); w.y = cvtpk_s(v0[2], v0[3]); w.z = cvtpk_s(v1[0], v1[1]); w.w = cvtpk_s(v1[2], v1[3]);
                    *(u32x4*)(O + off) = w; }
            asm volatile("" ::: "memory");
        }
    }
};

__device__ __forceinline__ int dkmap32(int pos) { const int qq = pos >> 3, jj = pos & 7; return jj < 4 ? 4 * qq + jj : 16 + 4 * qq + (jj - 4); }
__device__ __forceinline__ void tr_item(const float* W, int ldw, int srccol0, int k0, bf16_t* WT, int ldt, int dstrow0, LAS float* scr, int lane, bool zero, int dk0 = 0, bool qperm = false) {
    if (!zero) {
        f32x4 tv[8];
#pragma unroll
        for (int i = 0; i < 8; ++i) tv[i] = *(const f32x4*)(W + (size_t)(k0 + 8 * i + (lane >> 3)) * ldw + srccol0 + 4 * (lane & 7));
#pragma unroll
        for (int i = 0; i < 8; ++i) { LAS float* d = scr + (8 * i + (lane >> 3)) * 33 + 4 * (lane & 7); d[0] = tv[i][0]; d[1] = tv[i][1]; d[2] = tv[i][2]; d[3] = tv[i][3]; }
    }
    LDS_WAIT();
    const int c = lane & 7;
#pragma unroll
    for (int j = 0; j < 4; ++j) { const int n = (lane >> 3) + 8 * j; const LAS float* s = scr + (8 * c) * 33 + (qperm ? dkmap32(n) : n);
        u32x4 o; o.x = cvtpk_s(s[0 * 33], s[1 * 33]); o.y = cvtpk_s(s[2 * 33], s[3 * 33]); o.z = cvtpk_s(s[4 * 33], s[5 * 33]); o.w = cvtpk_s(s[6 * 33], s[7 * 33]);
        if (zero) o = (u32x4){0u, 0u, 0u, 0u};
        *(u32x4*)(WT + (size_t)(dstrow0 + n) * ldt + dk0 + k0 + 8 * c) = o; }
    LDS_WAIT();
}
template <bool OUT_BF16> __device__ __forceinline__ void ln_row(const float* in, void* outp, const float* g, const float* b, int lane) {
    const f32x4* xr = (const f32x4*)in + lane;
    f32x4 v[8]; float s = 0.f;
#pragma unroll
    for (int j = 0; j < 8; ++j) { v[j] = xr[64 * j]; s += (v[j][0] + v[j][1]) + (v[j][2] + v[j][3]); }
    const float mean = wave_sum(s) * (1.f / DM); float s2 = 0.f;
#pragma unroll
    for (int j = 0; j < 8; ++j) { v[j] = v[j] - mean; s2 += (v[j][0] * v[j][0] + v[j][1] * v[j][1]) + (v[j][2] * v[j][2] + v[j][3] * v[j][3]); }
    const float rstd = 1.f / sqrtf(wave_sum(s2) * (1.f / DM) + LN_EPS);
#pragma unroll
    for (int j = 0; j < 8; ++j) { const f32x4 gg = ((const f32x4*)g)[64 * j + lane], bb = ((const f32x4*)b)[64 * j + lane]; const f32x4 o = v[j] * rstd * gg + bb;
        if (OUT_BF16) { u32x2 w; w.x = cvtpk_s(o[0], o[1]); w.y = cvtpk_s(o[2], o[3]); ((u32x2*)outp)[64 * j + lane] = w; }
        else ((f32x4*)outp)[64 * j + lane] = o; }
}
template <bool OUT_BF16, bool IN_BF16 = false> __device__ __forceinline__ void ln_row2(const void* in0, const void* in1, void* out0, void* out1, const float* g, const float* b, int lane) {
    f32x4 v[8], w[8]; float s = 0.f, t = 0.f;
    if (IN_BF16) { const u32x2* x0 = (const u32x2*)in0 + lane; const u32x2* x1 = (const u32x2*)in1 + lane; u32x2 a0[8], a1[8];
#pragma unroll
        for (int j = 0; j < 8; ++j) { a0[j] = x0[64 * j]; a1[j] = x1[64 * j]; }
#pragma unroll
        for (int j = 0; j < 8; ++j) { v[j] = (f32x4){bflo(a0[j].x), bfhi(a0[j].x), bflo(a0[j].y), bfhi(a0[j].y)}; w[j] = (f32x4){bflo(a1[j].x), bfhi(a1[j].x), bflo(a1[j].y), bfhi(a1[j].y)}; }
    } else { const f32x4* x0 = (const f32x4*)in0 + lane; const f32x4* x1 = (const f32x4*)in1 + lane;
#pragma unroll
        for (int j = 0; j < 8; ++j) { v[j] = x0[64 * j]; w[j] = x1[64 * j]; } }
#pragma unroll
    for (int j = 0; j < 8; ++j) { s += (v[j][0] + v[j][1]) + (v[j][2] + v[j][3]); t += (w[j][0] + w[j][1]) + (w[j][2] + w[j][3]); }
#pragma unroll
    for (int o = 1; o < 64; o <<= 1) { s += __shfl_xor(s, o); t += __shfl_xor(t, o); }
    const float m0 = s * (1.f / DM), m1 = t * (1.f / DM); float s2 = 0.f, t2 = 0.f;
#pragma unroll
    for (int j = 0; j < 8; ++j) { v[j] = v[j] - m0; w[j] = w[j] - m1; s2 += (v[j][0] * v[j][0] + v[j][1] * v[j][1]) + (v[j][2] * v[j][2] + v[j][3] * v[j][3]); t2 += (w[j][0] * w[j][0] + w[j][1] * w[j][1]) + (w[j][2] * w[j][2] + w[j][3] * w[j][3]); }
#pragma unroll
    for (int o = 1; o < 64; o <<= 1) { s2 += __shfl_xor(s2, o); t2 += __shfl_xor(t2, o); }
    const float r0 = 1.f / sqrtf(s2 * (1.f / DM) + LN_EPS), r1 = 1.f / sqrtf(t2 * (1.f / DM) + LN_EPS);
#pragma unroll
    for (int j = 0; j < 8; ++j) { const f32x4 gg = ((const f32x4*)g)[64 * j + lane], bb = ((const f32x4*)b)[64 * j + lane]; const f32x4 o0 = v[j] * r0 * gg + bb, o1 = w[j] * r1 * gg + bb;
        if (OUT_BF16) { u32x2 p; p.x = cvtpk_s(o0[0], o0[1]); p.y = cvtpk_s(o0[2], o0[3]); ((u32x2*)out0)[64 * j + lane] = p; p.x = cvtpk_s(o1[0], o1[1]); p.y = cvtpk_s(o1[2], o1[3]); ((u32x2*)out1)[64 * j + lane] = p; }
        else { ((f32x4*)out0)[64 * j + lane] = o0; ((f32x4*)out1)[64 * j + lane] = o1; } }
}

template <bool OUT_BF16, bool IN_BF16> __device__ __forceinline__ void ln_stream(const void* in, void* out, const float* g, const float* b, int gw, int ngw, int lane) {
    typedef typename std::conditional<IN_BF16, u32x2, f32x4>::type raw_t;
    f32x4 gg[8], bb[8];
#pragma unroll
    for (int j = 0; j < 8; ++j) { gg[j] = ((const f32x4*)g)[64 * j + lane]; bb[j] = ((const f32x4*)b)[64 * j + lane]; }
    raw_t cur[2][8], nxt[2][8];
    const int nit = MTOK / (2 * ngw);
#define LN_LOAD(dst, it) do { _Pragma("unroll") for (int r = 0; r < 2; ++r) { const raw_t* rp = (const raw_t*)((const char*)in + (size_t)(gw + (2 * (it) + r) * ngw) * DM * (IN_BF16 ? 2 : 4)) + lane; \
        _Pragma("unroll") for (int j = 0; j < 8; ++j) dst[r][j] = rp[64 * j]; } } while (0)
    LN_LOAD(cur, 0);
    for (int it = 0; it < nit; ++it) {
        if (it + 1 < nit) LN_LOAD(nxt, it + 1);
        f32x4 v[2][8]; float s[2], s2[2];
#pragma unroll
        for (int r = 0; r < 2; ++r) { s[r] = 0.f;
#pragma unroll
            for (int j = 0; j < 8; ++j) { if constexpr (IN_BF16) { const u32x2 w = *(const u32x2*)&cur[r][j]; v[r][j] = (f32x4){bflo(w.x), bfhi(w.x), bflo(w.y), bfhi(w.y)}; } else v[r][j] = *(const f32x4*)&cur[r][j];
                s[r] += (v[r][j][0] + v[r][j][1]) + (v[r][j][2] + v[r][j][3]); } }
        s[0] = wave_sum(s[0]); s[1] = wave_sum(s[1]);
#pragma unroll
        for (int r = 0; r < 2; ++r) { const float mean = s[r] * (1.f / DM); s2[r] = 0.f;
#pragma unroll
            for (int j = 0; j < 8; ++j) { v[r][j] = v[r][j] - mean; s2[r] += (v[r][j][0] * v[r][j][0] + v[r][j][1] * v[r][j][1]) + (v[r][j][2] * v[r][j][2] + v[r][j][3] * v[r][j][3]); } }
        s2[0] = wave_sum(s2[0]); s2[1] = wave_sum(s2[1]);
#pragma unroll
        for (int r = 0; r < 2; ++r) { const float rstd = 1.f / sqrtf(s2[r] * (1.f / DM) + LN_EPS); const size_t row = (size_t)(gw + (2 * it + r) * ngw);
#pragma unroll
            for (int j = 0; j < 8; ++j) { const f32x4 o = v[r][j] * rstd * gg[j] + bb[j];
                if (OUT_BF16) { u32x2 pk; pk.x = cvtpk_s(o[0], o[1]); pk.y = cvtpk_s(o[2], o[3]); ((u32x2*)((bf16_t*)out + row * DM))[64 * j + lane] = pk; }
                else ((f32x4*)((float*)out + row * DM))[64 * j + lane] = o; } }
#pragma unroll
        for (int r = 0; r < 2; ++r)
#pragma unroll
            for (int j = 0; j < 8; ++j) cur[r][j] = nxt[r][j];
    }
#undef LN_LOAD
}

__device__ __forceinline__ void phase_prep(const Args& a, LAS unsigned char* lds, int gw, int ngw, int wave, int lane) {
    LAS float* scr = (LAS float*)(lds + wave * 8448);
    bf16_t* W1T = (bf16_t*)(a.ws + OFF_W1T); bf16_t* WOT = (bf16_t*)(a.ws + OFF_WOT);
    constexpr int I1 = 32 * (N1 / 32), IO = 32 * 64;
    for (int it = gw; it < I1; it += ngw) {
        if (it < I1) { const int kb = it / (N1 / 32), nb = it % (N1 / 32), n0 = nb * 32;
            const bool zero = n0 >= 14400; int src;
            if (n0 < 4096) src = n0;
            else if (n0 < 8192) { const int t = (n0 - 4096) >> 8, wi = n0 & 255; src = wi < 128 ? 4096 + 128 * t + wi : 10304 + 128 * t + (wi - 128); }
            else if (n0 < 12288) { const int t = (n0 - 8192) >> 8, wi = n0 & 255; src = wi < 128 ? 6208 + 128 * t + wi : 12352 + 128 * t + (wi - 128); }
            else if (n0 < 14336) src = 8256 + (n0 - 12288);
            else src = 6144 + (n0 - 14336);
            tr_item(a.w_in, 14400, zero ? 0 : src, kb * 64, W1T, 2048, n0, scr, lane, zero, 0, n0 < 1024); }
        else { const int r = it - I1, kb = r / 64, nb = r % 64; tr_item(a.w_o, 2048, nb * 32, kb * 64, WOT, 2048, nb * 32, scr, lane, false); }
    }
    bf16_t* H0 = (bf16_t*)(a.ws + OFF_H0);
    ln_stream<true, false>(a.x, H0, a.ln0_g, a.ln0_b, gw, ngw, lane);
}
__device__ __forceinline__ void phase_prep2(const Args& a, LAS unsigned char* lds, int gw, int ngw, int wave, int lane) {
    LAS float* scr = (LAS float*)(lds + wave * 8448);
    bf16_t* WGUT = (bf16_t*)(a.out + DO_WGUT); bf16_t* WDT = (bf16_t*)(a.out + DO_WDT);
    constexpr int IG = 32 * (NGU / 32), ID = 88 * 64, IP = 4 * 64;
    { bf16_t* WOT = (bf16_t*)(a.ws + OFF_WOT);
      for (int r = gw; r < 32 * 64; r += ngw) { const int kb = r / 64, nb = r % 64; tr_item(a.w_o, 2048, nb * 32, kb * 64, WOT, 2048, nb * 32, scr, lane, false); } }
    for (int it = gw; it < IG + ID + IP; it += ngw) {
        if (it < IG) { const int kb = it / (NGU / 32), nb = it % (NGU / 32), n0 = nb * 32, t = n0 >> 8, wi = n0 & 255;
            if (t < 44) tr_item(a.w_gu, 2 * DFF, wi < 128 ? t * 128 + wi : DFF + t * 128 + (wi - 128), kb * 64, WGUT, 2048, n0, scr, lane, false);
            else tr_item(a.w_pg, 2048, (t - 44) * 256 + wi, kb * 64, WGUT, 2048, n0, scr, lane, false); }
        else if (it < IG + ID) { const int r = it - IG, kb = r / 64, nb = r % 64; tr_item(a.w_down, 2048, nb * 32, kb * 64, WDT, KX, nb * 32, scr, lane, false, 256); }
        else { const int r = it - IG - ID, kb = r / 64, nb = r % 64; tr_item(a.w_pu, 2048, nb * 32, kb * 64, WDT, KX, nb * 32, scr, lane, false, 0); }
    }
}
__device__ __forceinline__ void phase_pconv(const Args& a, int gw, int ngw, int lane) {
    bf16_t* ACT = (bf16_t*)(a.ws + OFF_ACT);
    for (int i = gw * 64 + lane; i < MTOK * 64; i += ngw * 64) { const int m = i >> 6, c4 = (i & 63) * 4; const f32x4 v = *(const f32x4*)(a.p + (size_t)m * 256 + c4);
        u32x2 w; w.x = cvtpk_s(v[0], v[1]); w.y = cvtpk_s(v[2], v[3]); *(u32x2*)(ACT + (size_t)m * KX + c4) = w; }
}

__device__ __forceinline__ void phase_kt(const Args& a, LAS unsigned char* lds, int tid) {
    LAS float* fgs = (LAS float*)(lds + 131072);
    bf16_t* Kb = (bf16_t*)(a.ws + OFF_K); const float* FG = (const float*)(a.ws + OFF_FG); const float* FG2 = (const float*)(a.ws + OFF_FG2); float* DEC = (float*)(a.out + DO_DEC);
    const int col2 = 2 * tid, h = col2 >> 8, d = col2 & 255;
    float w0[16], w1[16];
#pragma unroll
    for (int r = 0; r < 16; ++r) { const float2 t = *(const float2*)(a.w_f2 + (h * 16 + r) * 256 + d); w0[r] = t.x; w1[r] = t.y; }
    const float2 bb = *(const float2*)(a.b_f2 + h * 256 + d);
    for (int it = blockIdx.x; it < NCHUNK; it += gridDim.x) {
        const size_t row0 = (size_t)it * 64;
        __syncthreads();
#pragma unroll
        for (int i = 0; i < 2; ++i) { const int p = tid + 512 * i; ((LAS f32x4*)fgs)[p] = ((const f32x4*)(FG + row0 * 64))[p] + ((const f32x4*)(FG2 + row0 * 64))[p] + *(const f32x4*)(a.b_in + 6144 + 4 * (p & 15)); }
        __syncthreads();
        float run0 = 0.f, run1 = 0.f;
        unsigned kwc[8], kwn[8];
#pragma unroll
        for (int tt = 0; tt < 8; ++tt) { kwc[tt] = *(const unsigned*)(Kb + (row0 + 56 + tt) * 1024 + col2); kwn[tt] = 0u; }
        for (int tg = 7; tg >= 0; --tg) {
            if (tg > 0) {
#pragma unroll
                for (int tt = 0; tt < 8; ++tt) kwn[tt] = *(const unsigned*)(Kb + (row0 + (tg - 1) * 8 + tt) * 1024 + col2); }
            float v0[8], v1[8];
#pragma unroll
            for (int tt = 7; tt >= 0; --tt) { const int t = tg * 8 + tt;
                const LAS f32x4* fp = (const LAS f32x4*)(fgs + t * 64 + h * 16);
                float f0 = bb.x, f1 = bb.y;
#pragma unroll
                for (int r4 = 0; r4 < 4; ++r4) { const f32x4 fv = fp[r4];
#pragma unroll
                    for (int j = 0; j < 4; ++j) { f0 += fv[j] * w0[r4 * 4 + j]; f1 += fv[j] * w1[r4 * 4 + j]; } }
                const float la0 = (fminf(f0, 0.f) - __logf(1.f + __expf(-fabsf(f0)))) * 0.0625f, la1 = (fminf(f1, 0.f) - __logf(1.f + __expf(-fabsf(f1)))) * 0.0625f;
                const unsigned kw = kwc[tt];
                v0[tt] = bflo(kw) * __expf(run0); v1[tt] = bfhi(kw) * __expf(run1);
                run0 += la0; run1 += la1; }
            u32x4 p0, p1;
            p0.x = cvtpk_s(v0[0], v0[1]); p0.y = cvtpk_s(v0[2], v0[3]); p0.z = cvtpk_s(v0[4], v0[5]); p0.w = cvtpk_s(v0[6], v0[7]);
            p1.x = cvtpk_s(v1[0], v1[1]); p1.y = cvtpk_s(v1[2], v1[3]); p1.z = cvtpk_s(v1[4], v1[5]); p1.w = cvtpk_s(v1[6], v1[7]);
            *(LAS u32x4*)(lds + col2 * 128 + ((tg ^ (col2 & 7)) << 4)) = p0;
            *(LAS u32x4*)(lds + (col2 + 1) * 128 + ((tg ^ ((col2 + 1) & 7)) << 4)) = p1;
#pragma unroll
            for (int tt = 0; tt < 8; ++tt) kwc[tt] = kwn[tt];
        }
        *(float2*)(DEC + (size_t)it * 1024 + col2) = make_float2(__expf(run0), __expf(run1));
        __syncthreads();
#pragma unroll
        for (int i = 0; i < 16; ++i) { const int p = tid + 512 * i, c = p >> 3, s = p & 7;
            *(u32x4*)(Kb + (size_t)it * 65536 + c * 64 + s * 8) = *(const LAS u32x4*)(lds + c * 128 + ((s ^ (c & 7)) << 4)); }
    }
    __syncthreads();
}

__device__ __forceinline__ void phase_scan(const Args& a, LAS unsigned char* lds, int tid, int wave, int lane) {
    const int bx = blockIdx.x, xcd = bx & 7, jj = bx >> 3, bh = xcd * 2 + (jj >> 3), b = bh >> 2, h = bh & 3, dvb = jj & 7, l15 = lane & 15, q = lane >> 4;
    constexpr int KTB = 0, QB = 65536, VB = 131072, DB = 147456;
    const bf16_t* KT = (const bf16_t*)(a.ws + OFF_K) + (size_t)(b * 128) * 65536 + h * 16384;
    const bf16_t* Qg = (const bf16_t*)(a.ws + OFF_Q) + (size_t)(b * 8192) * 1024 + h * 256;
    bf16_t* Vg = (bf16_t*)(a.ws + OFF_V) + (size_t)(b * 8192) * 2048 + h * 512 + dvb * 64;
    const float* DEC = (const float*)(a.out + DO_DEC) + (size_t)(b * 128) * 1024 + h * 256;
#define SBAR() do { asm volatile("s_waitcnt lgkmcnt(0)" ::: "memory"); __builtin_amdgcn_s_barrier(); asm volatile("" ::: "memory"); } while (0)
    if (wave >= 4) {
        const int lw = wave - 4;
        const unsigned kvo = (unsigned)(((lane >> 3) * 64 + (((lane & 7) ^ ((lane >> 3) & 7)) << 3)) * 2);
        unsigned qvo[8];
#pragma unroll
        for (int i = 0; i < 8; ++i) { const int frl = 2 * i + (lane >> 5); qvo[i] = (unsigned)(((lw * 16 + frl) * 1024 + (((lane & 31) ^ (frl & 15)) << 3)) * 2); }
        const unsigned vvo = (unsigned)(((lane >> 3) * 2048 + (lane & 7) * 8) * 2);
#define G1(cc) do { const int c_ = (cc) > 127 ? 127 : (cc); const char* qb_ = (const char*)(Qg + (size_t)c_ * 65536); LAS unsigned char* d_ = lds + QB + ((cc) & 1) * 32768 + lw * 8192; \
            _Pragma("unroll") for (int i = 0; i < 8; ++i) __builtin_amdgcn_global_load_lds((const unsigned*)(qb_ + qvo[i]), (LAS unsigned*)(d_ + i * 1024), 16, 0, 0); } while (0)
#define G2(cc) do { const int c_ = (cc) > 127 ? 127 : (cc); const char* kb_ = (const char*)(KT + (size_t)c_ * 65536) + lw * 8192; LAS unsigned char* d_ = lds + KTB + ((cc) & 1) * 32768 + lw * 8192; \
            _Pragma("unroll") for (int i = 0; i < 8; ++i) __builtin_amdgcn_global_load_lds((const unsigned*)(kb_ + i * 1024 + kvo), (LAS unsigned*)(d_ + i * 1024), 16, 0, 0); \
            const char* vb_ = (const char*)(Vg + (size_t)(c_ * 64 + lw * 16) * 2048); LAS unsigned char* dv_ = lds + VB + ((cc) & 1) * 8192 + lw * 2048; \
            _Pragma("unroll") for (int i = 0; i < 2; ++i) __builtin_amdgcn_global_load_lds((const unsigned*)(vb_ + (size_t)i * 8 * 2048 * 2 + vvo), (LAS unsigned*)(dv_ + i * 1024), 16, 0, 0); \
            __builtin_amdgcn_global_load_lds((const unsigned*)(DEC + (size_t)c_ * 1024 + lw * 64 + lane), (LAS unsigned*)(lds + DB + ((cc) & 1) * 1024 + lw * 256), 4, 0, 0); } while (0)
        G2(0); G1(0); G2(1);
        for (int c = 0; c < 128; ++c) {
            asm volatile("s_waitcnt vmcnt(19)" ::: "memory");
            SBAR();
            G1(c + 1);
            asm volatile("s_waitcnt vmcnt(19)" ::: "memory");
            SBAR();
            G2(c + 2);
        }
        asm volatile("s_waitcnt vmcnt(0)" ::: "memory");
#undef G1
#undef G2
    } else {
        const unsigned ovo = (unsigned)((l15 * 2048 + 16 * wave + 4 * q) * 2);
        __builtin_amdgcn_s_setprio(2);
        f32x4 accS[16];
#pragma unroll
        for (int i = 0; i < 16; ++i) accS[i] = (f32x4){0.f, 0.f, 0.f, 0.f};
        for (int c = 0; c < 128; ++c) {
            LAS unsigned char* KTs = lds + KTB + (c & 1) * 32768; LAS unsigned char* Qs = lds + QB + (c & 1) * 32768;
            const LAS unsigned short* Vs = (const LAS unsigned short*)(lds + VB + (c & 1) * 8192); LAS float* DECs = (LAS float*)(lds + DB + (c & 1) * 1024);
            SBAR();
            bf16x8 vb0, vb1;
            { const LAS unsigned short* vp = Vs + (8 * q) * 64 + 16 * wave + l15; unsigned w0[4], w1[4];
#pragma unroll
              for (int e = 0; e < 4; ++e) { w0[e] = (unsigned)vp[(2 * e) * 64] | ((unsigned)vp[(2 * e + 1) * 64] << 16); w1[e] = (unsigned)vp[(32 + 2 * e) * 64] | ((unsigned)vp[(32 + 2 * e + 1) * 64] << 16); }
              vb0 = __builtin_bit_cast(bf16x8, (u32x4){w0[0], w0[1], w0[2], w0[3]}); vb1 = __builtin_bit_cast(bf16x8, (u32x4){w1[0], w1[1], w1[2], w1[3]}); }
#define SCAN_KTLD(A0, A1, D, bt) do { _Pragma("unroll") for (int t = 0; t < 4; ++t) { const int dk = 16 * (4 * (bt) + t) + l15; \
                A0[t] = *(const LAS bf16x8*)(KTs + dk * 128 + ((q ^ (dk & 7)) << 4)); A1[t] = *(const LAS bf16x8*)(KTs + dk * 128 + (((4 + q) ^ (dk & 7)) << 4)); \
                D[t] = *(const LAS f32x4*)(DECs + 16 * (4 * (bt) + t) + 4 * q); } } while (0)
#define SCAN_KTMM(A0, A1, D, bt) do { _Pragma("unroll") for (int t = 0; t < 4; ++t) accS[4 * (bt) + t] = __builtin_amdgcn_mfma_f32_16x16x32_bf16(A0[t], vb0, accS[4 * (bt) + t] * D[t], 0, 0, 0); \
            _Pragma("unroll") for (int t = 0; t < 4; ++t) accS[4 * (bt) + t] = __builtin_amdgcn_mfma_f32_16x16x32_bf16(A1[t], vb1, accS[4 * (bt) + t], 0, 0, 0); } while (0)
            {
                bf16x8 xa0[4], xa1[4], ya0[4], ya1[4]; f32x4 xd[4], yd[4];
                SCAN_KTLD(xa0, xa1, xd, 0); __builtin_amdgcn_sched_barrier(0);
                SCAN_KTLD(ya0, ya1, yd, 1); __builtin_amdgcn_sched_barrier(0);
                SCAN_KTMM(xa0, xa1, xd, 0); __builtin_amdgcn_sched_barrier(0);
                SCAN_KTLD(xa0, xa1, xd, 2); __builtin_amdgcn_sched_barrier(0);
                SCAN_KTMM(ya0, ya1, yd, 1); __builtin_amdgcn_sched_barrier(0);
                SCAN_KTLD(ya0, ya1, yd, 3); __builtin_amdgcn_sched_barrier(0);
                SCAN_KTMM(xa0, xa1, xd, 2); __builtin_amdgcn_sched_barrier(0);
                SCAN_KTMM(ya0, ya1, yd, 3); __builtin_amdgcn_sched_barrier(0);
            }
            bf16x8 sf[8];
#pragma unroll
            for (int ks = 0; ks < 8; ++ks) { u32x4 w; w.x = cvtpk_s(accS[2 * ks][0], accS[2 * ks][1]); w.y = cvtpk_s(accS[2 * ks][2], accS[2 * ks][3]);
                w.z = cvtpk_s(accS[2 * ks + 1][0], accS[2 * ks + 1][1]); w.w = cvtpk_s(accS[2 * ks + 1][2], accS[2 * ks + 1][3]); sf[ks] = __builtin_bit_cast(bf16x8, w); }
            SBAR();
            f32x4 o[4];
#pragma unroll
            for (int ft = 0; ft < 4; ++ft) o[ft] = (f32x4){0.f, 0.f, 0.f, 0.f};
#define SCAN_QLD(Q, kb) do { _Pragma("unroll") for (int k2 = 0; k2 < 2; ++k2) _Pragma("unroll") for (int ft = 0; ft < 4; ++ft) { const int fr = 16 * ft + l15, pc = 4 * (2 * (kb) + k2) + q; \
                Q[k2 * 4 + ft] = *(const LAS u32x4*)(Qs + fr * 512 + ((pc ^ (fr & 15)) << 4)); } } while (0)
#define SCAN_QMM(Q, kb) do { _Pragma("unroll") for (int k2 = 0; k2 < 2; ++k2) _Pragma("unroll") for (int ft = 0; ft < 4; ++ft) \
                o[ft] = __builtin_amdgcn_mfma_f32_16x16x32_bf16(sf[2 * (kb) + k2], __builtin_bit_cast(bf16x8, Q[k2 * 4 + ft]), o[ft], 0, 0, 0); } while (0)
            {
                u32x4 xq[8], yq[8];
                SCAN_QLD(xq, 0); __builtin_amdgcn_sched_barrier(0);
                SCAN_QLD(yq, 1); __builtin_amdgcn_sched_barrier(0);
                SCAN_QMM(xq, 0); __builtin_amdgcn_sched_barrier(0);
                SCAN_QLD(xq, 2); __builtin_amdgcn_sched_barrier(0);
                SCAN_QMM(yq, 1); __builtin_amdgcn_sched_barrier(0);
                SCAN_QLD(yq, 3); __builtin_amdgcn_sched_barrier(0);
                SCAN_QMM(xq, 2); __builtin_amdgcn_sched_barrier(0);
                SCAN_QMM(yq, 3); __builtin_amdgcn_sched_barrier(0);
            }
#undef SCAN_KTLD
#undef SCAN_KTMM
#undef SCAN_QLD
#undef SCAN_QMM
#pragma unroll
            for (int ft = 0; ft < 4; ++ft) { u32x2 w; w.x = cvtpk_s(o[ft][0], o[ft][1]); w.y = cvtpk_s(o[ft][2], o[ft][3]);
                *(u32x2*)((char*)(Vg + (size_t)(c * 64 + 16 * ft) * 2048) + ovo) = w; }
        }
        __builtin_amdgcn_s_setprio(0);
    }
    SBAR();
#undef SBAR
}

__device__ __forceinline__ void phase_merge(const Args& a, LAS unsigned char* lds, int tid, int wave, int lane) {
    const int g = blockIdx.x & 3, l15 = lane & 15, q = lane >> 4;
    LAS unsigned char* Ws = lds; LAS unsigned char* ZT = lds + 32768; LAS float* SG = (LAS float*)(lds + 65536); LAS float* MU = (LAS float*)(lds + 65536 + 67584); LAS float* RS = MU + 128; LAS float* RO = MU + 256;
    const bf16_t* Zb = (const bf16_t*)(a.ws + OFF_Z); const bf16_t* Ob = (const bf16_t*)(a.ws + OFF_V); const bf16_t* OGb = (const bf16_t*)(a.ws + OFF_OG);
    bf16_t* Ub = (bf16_t*)(a.ws + OFF_U);
    for (int p = tid; p < 4096; p += 512) { const int i = p >> 5, j4 = (p & 31) * 4; f32x4 v = *(const f32x4*)(a.w_s + (size_t)g * 16384 + i * 128 + j4);
        if ((j4 >> 6) > (i >> 6)) v = (f32x4){0.f, 0.f, 0.f, 0.f};
        u32x2 w; w.x = cvtpk_s(v[0], v[1]); w.y = cvtpk_s(v[2], v[3]);
        *(LAS u32x2*)(Ws + i * 256 + (((j4 >> 3) ^ (i & 7)) << 4) + (j4 & 4) * 2) = w; }
    for (int item = blockIdx.x; item < 1024; item += gridDim.x) {
        const int nb = item >> 2; const size_t row0 = (size_t)nb * 128; const int colg = g * 512;
        __syncthreads();
#pragma unroll 4
        for (int rr = 0; rr < 16; ++rr) { const int i = wave * 16 + rr; const size_t off = (row0 + i) * DM + colg + lane * 8;
            const u32x4 zw = *(const u32x4*)(Zb + off), ow = *(const u32x4*)(Ob + off);
            float z[8] = {bflo(zw.x), bfhi(zw.x), bflo(zw.y), bfhi(zw.y), bflo(zw.z), bfhi(zw.z), bflo(zw.w), bfhi(zw.w)};
            const float o[8] = {bflo(ow.x), bfhi(ow.x), bflo(ow.y), bfhi(ow.y), bflo(ow.z), bfhi(ow.z), bflo(ow.w), bfhi(ow.w)};
            float s = 0.f, so = 0.f;
#pragma unroll
            for (int e = 0; e < 8; ++e) { s += z[e]; so += o[e] * o[e]; }
            const float mean = wave_sum(s) * (1.f / 512.f); so = wave_sum(so); float s2 = 0.f;
#pragma unroll
            for (int e = 0; e < 8; ++e) { const float dd = z[e] - mean; s2 += dd * dd; }
            s2 = wave_sum(s2);
            if (lane == 0) { MU[i] = mean; RS[i] = 1.f / sqrtf(s2 * (1.f / 512.f) + LN_EPS); RO[i] = 1.f / sqrtf(so * (1.f / 512.f) + LN_EPS); } }
        __syncthreads();
        for (int cc = 0; cc < 4; ++cc) {
            const int colc = colg + cc * 128;
            u32x4 uw4[4], ow4[4], gw4[4];
#pragma unroll
            for (int k = 0; k < 4; ++k) { const int p = tid + 512 * k, i = p >> 4, c8 = (p & 15) * 8; const size_t off = (row0 + i) * DM + colc + c8;
                uw4[k] = *(const u32x4*)(Ub + off); ow4[k] = *(const u32x4*)(Ob + off); gw4[k] = *(const u32x4*)(OGb + off); }
#pragma unroll
            for (int i = 0; i < 4; ++i) { const int p = tid + 512 * i, j = p >> 4, c8 = (p & 15) * 8;
                const u32x4 zw = *(const u32x4*)(Zb + (row0 + j) * DM + colc + c8);
                const float z[8] = {bflo(zw.x), bfhi(zw.x), bflo(zw.y), bfhi(zw.y), bflo(zw.z), bfhi(zw.z), bflo(zw.w), bfhi(zw.w)};
                const float mu = MU[j], rs = RS[j];
                const f32x4 g0 = *(const f32x4*)(a.gm_g + colc + c8), g1 = *(const f32x4*)(a.gm_g + colc + c8 + 4), b0 = *(const f32x4*)(a.gm_b + colc + c8), b1 = *(const f32x4*)(a.gm_b + colc + c8 + 4);
#pragma unroll
                for (int e = 0; e < 8; ++e) { const float gg = e < 4 ? g0[e & 3] : g1[e & 3], bb = e < 4 ? b0[e & 3] : b1[e & 3]; const float zn = (z[e] - mu) * rs * gg + bb;
                    const int c = c8 + e; const unsigned short val = (unsigned short)(cvtpk_s(zn, 0.f) & 0xffffu);
                    *(LAS unsigned short*)(ZT + c * 256 + (((j >> 3) ^ (c & 7)) << 4) + (j & 7) * 2) = val; } }
            __syncthreads();
            {
                const int c = 16 * wave + l15; bf16x8 zf[4];
#pragma unroll
                for (int ks = 0; ks < 4; ++ks) zf[ks] = *(const LAS bf16x8*)(ZT + c * 256 + (((4 * ks + q) ^ (c & 7)) << 4));
#pragma unroll
                for (int it = 0; it < 8; ++it) { const int i = 16 * it + l15; f32x4 acc = (f32x4){0.f, 0.f, 0.f, 0.f};
#pragma unroll
                    for (int ks = 0; ks < 4; ++ks) { if (it < 4 && ks >= 2) continue;
                        const bf16x8 wf = *(const LAS bf16x8*)(Ws + i * 256 + (((4 * ks + q) ^ (i & 7)) << 4));
                        acc = __builtin_amdgcn_mfma_f32_16x16x32_bf16(wf, zf[ks], acc, 0, 0, 0); }
#pragma unroll
                    for (int r = 0; r < 4; ++r) SG[(16 * it + 4 * q + r) * 132 + c] = acc[r]; }
            }
            __syncthreads();
#pragma unroll
            for (int k = 0; k < 4; ++k) { const int p = tid + 512 * k, i = p >> 4, c8 = (p & 15) * 8; const size_t off = (row0 + i) * DM + colc + c8;
                const u32x4 uw = uw4[k], ow = ow4[k], gw = gw4[k];
                const f32x4 s0 = *(const LAS f32x4*)(SG + i * 132 + c8), s1 = *(const LAS f32x4*)(SG + i * 132 + c8 + 4);
                const f32x4 n0 = *(const f32x4*)(a.gla_g + colc + c8), n1 = *(const f32x4*)(a.gla_g + colc + c8 + 4);
                const float bs = a.b_s[g * 128 + i], ro = RO[i];
                const unsigned uu[4] = {uw.x, uw.y, uw.z, uw.w}, oo[4] = {ow.x, ow.y, ow.z, ow.w}, gg[4] = {gw.x, gw.y, gw.z, gw.w};
                float m[8];
#pragma unroll
                for (int e = 0; e < 8; ++e) { const int wi = e >> 1; const bool hi = e & 1;
                    const float uv = hi ? bfhi(uu[wi]) : bflo(uu[wi]), ov = hi ? bfhi(oo[wi]) : bflo(oo[wi]), gv = hi ? bfhi(gg[wi]) : bflo(gg[wi]);
                    const float sg = (e < 4 ? s0[e & 3] : s1[e & 3]) + bs, ng = e < 4 ? n0[e & 3] : n1[e & 3];
                    m[e] = gv * (ov * ro * ng) + uv * sg; }
                u32x4 w; w.x = cvtpk_s(m[0], m[1]); w.y = cvtpk_s(m[2], m[3]); w.z = cvtpk_s(m[4], m[5]); w.w = cvtpk_s(m[6], m[7]);
                *(u32x4*)(Ub + off) = w; }
        }
    }
    __syncthreads();
}

typedef __attribute__((address_space(1))) unsigned gu32;
#define XB_TMO      128
#define XB_XCNT(j)  (256  + 64 * (j))
#define XB_XSUB(j)  (1280 + 64 * (j))
#define XB_XGEN(j)  (2304 + 64 * (j))
#define XB_TOP      3328
#define XB_TOPGEN   3392
#define XCD_BAR_WORDS 3456
#define XB_SPIN_CAP (1u << 18)

__device__ __forceinline__ unsigned xb_ld(unsigned* p)              { return __hip_atomic_load(p, __ATOMIC_RELAXED, __HIP_MEMORY_SCOPE_AGENT); }
__device__ __forceinline__ unsigned xb_add(unsigned* p, unsigned v) { return __hip_atomic_fetch_add(p, v, __ATOMIC_RELAXED, __HIP_MEMORY_SCOPE_AGENT); }
__device__ __forceinline__ unsigned xb_xcc_id() { return (unsigned)__builtin_amdgcn_s_getreg((3 << 11) | 20) & 0xFu; }
#define XB_SPIN(cond, bar) do { unsigned _sp = 0; while (cond) { __builtin_amdgcn_s_sleep(1); \
    if ((++_sp & 255u) == 0u) { if (xb_ld(&(bar)[XB_TMO])) break; if (_sp > XB_SPIN_CAP) { atomicAdd(&(bar)[XB_TMO], 1u); break; } } } } while (0)

struct XcdBarrier {
    unsigned* bar; unsigned x;
    volatile LAS unsigned* st;
};

__device__ __forceinline__ XcdBarrier xcd_barrier_post(unsigned* bar, volatile LAS unsigned* st) {
    XcdBarrier b; b.bar = bar; b.x = xb_xcc_id(); b.st = st;
    if (threadIdx.x == 0) (void)xb_add(&bar[XB_XCNT(b.x)], 1u);
    return b;
}
__device__ __forceinline__ void xcd_barrier_complete(unsigned* bar, unsigned x, unsigned& nloc, unsigned& nx) {
    const unsigned G = gridDim.x * gridDim.y * gridDim.z;
    unsigned sum, cnt, mine, sp = 0u;
    for (;;) {
        sum = 0u; cnt = 0u; mine = 0u;
#pragma unroll
        for (unsigned j = 0; j < 16; ++j) { const unsigned c = xb_ld(&bar[XB_XCNT(j)]); sum += c; cnt += (c > 0u) ? 1u : 0u; mine = (j == x) ? c : mine; }
        if (sum == G) break;
        __builtin_amdgcn_s_sleep(1);
        if ((++sp & 255u) == 0u) { if (xb_ld(&bar[XB_TMO])) break; if (sp > XB_SPIN_CAP) { atomicAdd(&bar[XB_TMO], 1u); break; } }
    }
    nloc = mine > 0u ? mine : 1u; nx = cnt > 0u ? cnt : 1u;
}

__device__ __forceinline__ void xcd_barrier(const XcdBarrier& b) {
    asm volatile("s_waitcnt vmcnt(0)" ::: "memory");
    __syncthreads();
    if (threadIdx.x == 0) {
        unsigned* bar = b.bar;
        __builtin_amdgcn_s_waitcnt(0);
        unsigned nloc = b.st[0], nx = b.st[1];
        if (nloc == 0u) { xcd_barrier_complete(bar, b.x, nloc, nx); b.st[0] = nloc; b.st[1] = nx; }
        const unsigned old = xb_add(&bar[XB_XSUB(b.x)], 1u);
        const unsigned gen = old / nloc;
        if (old + 1u == (gen + 1u) * nloc) {
            __builtin_amdgcn_fence(__ATOMIC_RELEASE, "agent");
            asm volatile("s_waitcnt vmcnt(0)" ::: "memory");
            const unsigned og = xb_add(&bar[XB_TOP], 1u);
            const unsigned tg = og / nx;
            if (og + 1u == (tg + 1u) * nx) xb_add(&bar[XB_TOPGEN], 1u);
            else XB_SPIN(xb_ld(&bar[XB_TOPGEN]) == tg, bar);
            __builtin_amdgcn_fence(__ATOMIC_ACQUIRE, "agent");
            xb_add(&bar[XB_XGEN(b.x)], 1u);
            asm volatile("s_waitcnt vmcnt(0)" ::: "memory");
        } else {
            XB_SPIN(xb_ld(&bar[XB_XGEN(b.x)]) == gen, bar);
            __builtin_amdgcn_fence(__ATOMIC_ACQUIRE, "agent");
            asm volatile("s_waitcnt vmcnt(0)" ::: "memory");
        }
    }
    __syncthreads();
}


__global__ void __launch_bounds__(512, 2) mega(Args a) {
    extern __shared__ __attribute__((aligned(16))) unsigned char lds_raw[];
    LAS unsigned char* lds = (LAS unsigned char*)lds_raw;
    const int tid = threadIdx.x, lane = tid & 63, wave = __builtin_amdgcn_readfirstlane(tid >> 6);
    const int G = gridDim.x, gw = blockIdx.x * 8 + wave, ngw = G * 8;
    const int lo = a.ph_lo, hi = a.ph_hi;
    if (tid < 16) ((LAS unsigned*)(lds + LDS_BARW))[tid] = 0u;
    __syncthreads();
    XcdBarrier bar; bar.bar = (unsigned*)(a.ws + OFF_CTL); bar.x = 0; bar.st = nullptr;
    if (a.coop) bar = xcd_barrier_post((unsigned*)(a.ws + OFF_CTL), (volatile LAS unsigned*)(lds + LDS_BARW));
#define IN(k) (lo <= (k) && (k) < hi)
#ifndef PROF_SEC
#define PROF_SEC 0
#endif
#ifndef PROF_WG
#define PROF_WG 0
#endif
    unsigned long long bacc = 0ull;
#define SEAM(k) do { if (IN(k) && IN((k) + 1)) { unsigned long long tb_ = 0ull; if (PROF_SEC == 20 && (k) != 0) tb_ = __builtin_amdgcn_s_memrealtime(); if ((k) == 0) cg::this_grid().sync(); else xcd_barrier(bar); \
        if (PROF_SEC == 20 && (k) != 0) bacc += __builtin_amdgcn_s_memrealtime() - tb_; } } while (0)
    if (IN(0)) { phase_prep(a, lds, gw, ngw, wave, lane); __syncthreads(); }
    SEAM(0);
    if (IN(1)) { { pg8::Gemm gm{(const bf16_t*)(a.ws + OFF_H0), (const bf16_t*)(a.ws + OFF_W1T), MTOK, 14336, DM}; pg8::StaticOrder S; S.init(MTOK, 14336, G, (int)blockIdx.x);
          Epi1 E{a.ws, a.out, a.b_in};
          pg8::gemm_phase<Epi1, pg8::StaticOrder, true, true>(lds, gm, S, E); }
        { pg8::Gemm gm{(const bf16_t*)(a.ws + OFF_H0), (const bf16_t*)(a.ws + OFF_W1T) + (size_t)14336 * DM, MTOK, 512, 1024, DM, (size_t)2048, (size_t)2048}; pg8::StaticOrder S; S.init(MTOK, 512, G, (int)blockIdx.x);
          EpiFg E{(float*)(a.ws + OFF_FG), (float*)(a.ws + OFF_FG2)};
          pg8::gemm_phase<EpiFg, pg8::StaticOrder, true, true>(lds, gm, S, E); } }
    SEAM(1);
    if (IN(2)) phase_kt(a, lds, tid);
    SEAM(2);
    if (IN(3)) { if (blockIdx.x < 128) phase_scan(a, lds, tid, wave, lane); else { phase_prep2(a, lds, (blockIdx.x - 128) * 8 + wave, (G - 128) * 8, wave, lane); __syncthreads(); } }
    SEAM(3);
    if (IN(4)) phase_merge(a, lds, tid, wave, lane);
    SEAM(4);
    if (IN(5)) { pg8::Gemm gm{(const bf16_t*)(a.ws + OFF_U), (const bf16_t*)(a.ws + OFF_WOT), MTOK, DM, DM}; pg8::StaticOrder S; S.init(MTOK, DM, G, (int)blockIdx.x);
        EpiRes<false> E{(bf16_t*)(a.ws + OFF_H1PRE), (const bf16_t*)(a.ws + OFF_H0), nullptr};
        pg8::gemm_phase<EpiRes<false>, pg8::StaticOrder, true, true>(lds, gm, S, E); }
    SEAM(5);
    if (IN(6)) { const bf16_t* src = (const bf16_t*)(a.ws + OFF_H1PRE); bf16_t* H1 = (bf16_t*)(a.ws + OFF_H1);
        ln_stream<true, true>(src, H1, a.ln1_g, a.ln1_b, gw, ngw, lane); }
    SEAM(6);
    if (IN(7)) { phase_pconv(a, gw, ngw, lane);
        pg8::Gemm gm{(const bf16_t*)(a.ws + OFF_H1), (const bf16_t*)(a.out + DO_WGUT), MTOK, NGU, DM}; pg8::StaticOrder S; S.init(MTOK, NGU, G, (int)blockIdx.x);
        Epi5 E{(bf16_t*)(a.ws + OFF_ACT), (bf16_t*)(a.ws + OFF_GPG), a.b_pg};
        pg8::gemm_phase<Epi5, pg8::StaticOrder, true, true>(lds, gm, S, E); }
    SEAM(7);
    if (IN(9)) { pg8::Gemm gm{(const bf16_t*)(a.ws + OFF_ACT), (const bf16_t*)(a.out + DO_WDT), MTOK, DM, KX}; pg8::StaticOrder S; S.init(MTOK, DM, G, (int)blockIdx.x);
        EpiDown E{(bf16_t*)(a.ws + OFF_OUTPRE), (const bf16_t*)(a.ws + OFF_H1), (const bf16_t*)(a.ws + OFF_GPG)};
        pg8::gemm_phase<EpiDown, pg8::StaticOrder, true, true>(lds, gm, S, E); }
    SEAM(9);
    if (IN(10)) { const bf16_t* src = (const bf16_t*)(a.ws + OFF_OUTPRE); float* o = (float*)a.out;
        ln_stream<false, true>(src, o, a.ln2_g, a.ln2_b, gw, ngw, lane);
        if (PROF_SEC == 20) { __syncthreads(); if (blockIdx.x == PROF_WG && wave == 0) { const float d = (float)bacc * 0.01f * 5e-4f;
#pragma unroll 1
                for (int k = 0; k < 16; ++k) if (lane == 0) o[(size_t)(gw + k * ngw) * DM] += (k & 1) ? -d : d; } } }
    if (IN(11)) {
        float* o = (float*)a.out;
        if (a.pad == 0) { const bf16_t* src = (const bf16_t*)(a.ws + (size_t)a.coop * MiB);
            for (size_t i = (size_t)blockIdx.x * 512 + tid; i < (size_t)MTOK * DM; i += (size_t)G * 512) o[i] = __uint_as_float(((unsigned)src[i]) << 16); }
        else { const float* src = (const float*)(a.ws + (size_t)a.coop * MiB);
            for (size_t i = (size_t)blockIdx.x * 512 + tid; i < (size_t)MTOK * DM; i += (size_t)G * 512) o[i] = src[i]; }
    }
#undef IN
#undef SEAM
}

#ifndef N_LAUNCH_MODE
#define N_LAUNCH_MODE 1
#endif
extern "C" void kernel_launch(void* const* d_in, const int* in_sizes, int n_in, void* d_out, int out_size, void* d_ws, size_t ws_size, hipStream_t stream) {
    static int grid = 0;
    if (grid == 0) {
        if (n_in != 23 || out_size != MTOK * DM || ws_size < WS_NEED) { fprintf(stderr, "kernel_launch: unexpected shapes (n_in %d out %d ws %zu)\n", n_in, out_size, ws_size); grid = -1; return; }
        int dev = 0, cus = 0, per_cu = 0;
        hipGetDevice(&dev); hipDeviceGetAttribute(&cus, hipDeviceAttributeMultiprocessorCount, dev);
        if (hipFuncSetAttribute((const void*)mega, hipFuncAttributeMaxDynamicSharedMemorySize, LDS_BYTES) != hipSuccess) { fprintf(stderr, "kernel_launch: hipFuncSetAttribute failed\n"); grid = -1; return; }
        hipOccupancyMaxActiveBlocksPerMultiprocessor(&per_cu, (const void*)mega, 512, LDS_BYTES);
        (void)hipGetLastError();
        if (cus != 256 || per_cu < 1) { fprintf(stderr, "kernel_launch: needs 256 CUs with one resident block each (cus %d per_cu %d)\n", cus, per_cu); grid = -1; return; }
        grid = 256;
    }
    if (grid < 0) return;
    Args a{};
    const float** f = (const float**)&a;
    for (int i = 0; i < 23; ++i) f[i] = (const float*)d_in[i];
    a.out = (unsigned char*)d_out; a.ws = (unsigned char*)d_ws;
#if N_LAUNCH_MODE == 1
    a.ph_lo = 0; a.ph_hi = 11; a.coop = 1;
    if (hipMemsetAsync((char*)d_ws + OFF_CTL, 0, 65536, stream) != hipSuccess) { fprintf(stderr, "kernel_launch: memset failed\n"); return; }
    void* args[] = {&a};
    hipError_t e = hipLaunchCooperativeKernel((const void*)mega, dim3(grid), dim3(512), args, LDS_BYTES, stream);
    if (e != hipSuccess) fprintf(stderr, "cooperative launch failed: %s\n", hipGetErrorString(e));
#else
#ifndef DBG_STOP
#define DBG_STOP 10
#endif
#ifndef DBG_OFF_MIB
#define DBG_OFF_MIB 321
#endif
#ifndef DBG_F32
#define DBG_F32 0
#endif
#ifndef PROG
#define PROG {0, 1, 2, 3, 4, 5, 6, 7, 8, 9, 10}
#endif
    static const int prog[] = PROG;
    for (int pi = 0; pi < (int)(sizeof(prog) / sizeof(prog[0])); ++pi) { const int ph = prog[pi]; if (ph > DBG_STOP) break; a.ph_lo = ph; a.ph_hi = ph + 1; a.coop = 0;
        hipLaunchKernelGGL(mega, dim3(grid), dim3(512), LDS_BYTES, stream, a); }
    if (DBG_STOP < 10) { a.ph_lo = 11; a.ph_hi = 12; a.coop = DBG_OFF_MIB; a.pad = DBG_F32;
        hipLaunchKernelGGL(mega, dim3(grid), dim3(512), LDS_BYTES, stream, a); }
#endif
}
```

```cpp
#include <hip/hip_runtime.h>
#include <hip/hip_cooperative_groups.h>
#include <cstdio>
#include <cstdint>
#include <type_traits>
namespace cg = cooperative_groups;
namespace pg8 {
#define PG8_LAS __attribute__((address_space(3)))
typedef unsigned short bf16_t;
typedef short bf16x8 __attribute__((ext_vector_type(8)));
typedef float f32x4 __attribute__((ext_vector_type(4)));
typedef unsigned u32x4 __attribute__((ext_vector_type(4)));
constexpr int BM = 256, BK = 64, HALF = 128, HTB = HALF * BK * 2  , STAGE_BYTES = 8 * HTB, NXCD = 8, WGM = 8;

__host__ __device__ __forceinline__ int lds_byte(int r, int c) { const int st = (r >> 4) * 2 + (c >> 5), rr = r & 15, cc = c & 31, ob = rr * 64 + cc * 2; return st * 1024 + (ob ^ (((ob >> 9) & 1) << 5)); }
__host__ __device__ __forceinline__ void stage_rc(int b, int& R, int& C) { const int st = b / 1024, sb = b % 1024, swz = sb ^ (((sb >> 9) & 1) << 5); R = (st >> 1) * 16 + swz / 64; C = (st & 1) * 32 + (swz % 64) / 2; }
__host__ __device__ __forceinline__ int perm32(int rho) { const int n = rho >> 4, i = rho & 15; return 8 * (i >> 2) + 4 * n + (i & 3); }

struct Unit { int pm, pn; };
struct Gemm { const bf16_t* A; const bf16_t* Bt; int M, N, K; int ld = 0; size_t a_pn = 0; size_t b_pn = ~(size_t)0; };

struct StaticOrder {
    int nM, nN, nwg, G, c;
    __host__ __device__ void init(int M, int N, int G_, int c_) { nM = M / BM; nN = N / BM; nwg = nM * nN; G = G_; c = c_; }
    __host__ __device__ bool next(int i, Unit& u) const {
        const long L = (long)i * G + c; if (L >= nwg) return false;
        int wgid = (int)L; { const int q = nwg / NXCD, r = nwg % NXCD, xcd = wgid % NXCD, off = wgid / NXCD; wgid = (xcd < r ? xcd * (q + 1) : r * (q + 1) + (xcd - r) * q) + off; }
        const int nig = WGM * nN, gid = wgid / nig, fm = gid * WGM, gsz = (nM - fm) < WGM ? (nM - fm) : WGM;
        u.pm = fm + ((wgid % nig) % gsz); u.pn = (wgid % nig) / gsz; return true;
    }
    __device__ __forceinline__ void a_ready(const Unit&) const {}
    __device__ __forceinline__ void done(const Unit&) const {}
};
__device__ __forceinline__ unsigned cvt_pk_bf16(float lo, float hi) { unsigned r; asm volatile("v_cvt_pk_bf16_f32 %0, %1, %2" : "=v"(r) : "v"(lo), "v"(hi)); return r; }
typedef float f32x2 __attribute__((ext_vector_type(2)));
__device__ __forceinline__ f32x2 gelu_pk(f32x2 v) {
    const f32x2 av = __builtin_elementwise_abs(v), d = av * 0.2316418882f + 1.0f;
    f32x2 t; t.x = __builtin_amdgcn_rcpf(d.x); t.y = __builtin_amdgcn_rcpf(d.y);
    f32x2 q = t * 0.5307027145f + (-0.7265760135f); q = q * t + 0.7107068705f; q = q * t + (-0.142248368f); q = q * t + 0.127414796f; q = q * t;
    const f32x2 s = (v * v) * (-0.72134752044f);
    f32x2 e; e.x = __builtin_amdgcn_exp2f(s.x); e.y = __builtin_amdgcn_exp2f(s.y);
    const f32x2 m = v * (q * e), r = v - m;
    f32x2 o; o.x = v.x < 0.f ? m.x : r.x; o.y = v.y < 0.f ? m.y : r.y; return o;
}

template <class Epi, class Sched, bool ALIGN_EPI = false, bool SP2 = false>
__device__ __forceinline__ void gemm_phase(PG8_LAS unsigned char* lds, const Gemm g, const Sched& S, const Epi& E) {
    const int tid = threadIdx.x, wid = __builtin_amdgcn_readfirstlane(tid >> 6), lane = tid & 63, wr = wid >> 2, wc = wid & 3, fr = lane & 15, fq = lane >> 4;
    const int nt = g.K / BK, K = g.ld ? g.ld : g.K;
    unsigned voffA[2], voffB[2];
#pragma unroll
    for (int i = 0; i < 2; ++i) { int R, C; stage_rc(tid * 16 + i * 8192, R, C); const int Rb = Epi::PERM ? ((R & ~31) + perm32(R & 31)) : R;
        voffA[i] = (unsigned)(R * K + C) * 2u; voffB[i] = (unsigned)(Rb * K + C) * 2u; }
    const size_t kstep = (size_t)(BK * 2);
    const size_t hstep = (size_t)HALF * K * 2;
    const size_t tstep = 2 * hstep;
    const unsigned ldsw = (unsigned)wid * 1024u;
    const int aoff = lds_byte(wr * 64 + fr, fq * 8), boff = lds_byte(wc * 32 + fr, fq * 8);
#define PG8_SA(b, h) (((b) * 2 + (h)) * HTB)
#define PG8_SB(b, h) ((4 + (b) * 2 + (h)) * HTB)
#define PG8_STAGE(bufoff, gbase, voff) do { _Pragma("unroll") for (int _i = 0; _i < 2; ++_i) \
        __builtin_amdgcn_global_load_lds((const unsigned*)((const char*)(gbase) + (voff)[_i]), (PG8_LAS unsigned*)(lds + (bufoff) + ldsw + _i * 8192), 16, 0, 0); } while (0)
#define PG8_LDA(dst, b, h) do { _Pragma("unroll") for (int m = 0; m < 4; ++m) _Pragma("unroll") for (int k = 0; k < 2; ++k) dst[m][k] = *(const PG8_LAS bf16x8*)(lds + PG8_SA(b, h) + aoff + m * 2048 + k * 1024); } while (0)
#define PG8_LDB(dst, b, h) do { _Pragma("unroll") for (int n = 0; n < 2; ++n) _Pragma("unroll") for (int k = 0; k < 2; ++k) dst[n][k] = *(const PG8_LAS bf16x8*)(lds + PG8_SB(b, h) + boff + n * 2048 + k * 1024); } while (0)
#define PG8_MMA(ai, bj, At, Bt) do { __builtin_amdgcn_s_setprio(1); _Pragma("unroll") for (int m = 0; m < 4; ++m) _Pragma("unroll") for (int n = 0; n < 2; ++n) _Pragma("unroll") for (int k = 0; k < 2; ++k) \
        acc[ai][bj][m][n] = __builtin_amdgcn_mfma_f32_16x16x32_bf16(Bt[n][k], At[m][k], acc[ai][bj][m][n], 0, 0, 0); __builtin_amdgcn_s_setprio(0); } while (0)
#define PG8_WAIT_V(n) asm volatile("s_waitcnt vmcnt(" #n ")" ::: "memory")
#define PG8_WAIT_L(n) asm volatile("s_waitcnt lgkmcnt(" #n ")" ::: "memory")
#define PG8_BAR __builtin_amdgcn_s_barrier()
#define PG8_SCHED __builtin_amdgcn_sched_barrier(0)
    Unit cur, nxt; int ui = 0;
    if (!S.next(0, cur)) return;
    f32x4 acc[2][2][4][2];
#pragma unroll
    for (int a = 0; a < 2; ++a)
#pragma unroll
        for (int b = 0; b < 2; ++b)
#pragma unroll
            for (int m = 0; m < 4; ++m)
#pragma unroll
                for (int n = 0; n < 2; ++n) acc[a][b][m][n] = (f32x4){0.f, 0.f, 0.f, 0.f};
    bf16x8 At[4][2], B0[2][2], B1[2][2];
    const size_t bpn = g.b_pn == ~(size_t)0 ? tstep : g.b_pn;
    const char* cA = (const char*)g.A + (size_t)cur.pm * tstep + (size_t)cur.pn * g.a_pn; const char* cB = (const char*)g.Bt + (size_t)cur.pn * bpn;
    S.a_ready(cur);
    if constexpr (SP2) {
        PG8_STAGE(PG8_SB(0, 0), cB, voffB); PG8_STAGE(PG8_SB(0, 1), cB + hstep, voffB); PG8_STAGE(PG8_SA(0, 0), cA, voffA); PG8_STAGE(PG8_SA(0, 1), cA + hstep, voffA);
        if (wr == 1) PG8_BAR;
        PG8_WAIT_V(2); PG8_BAR;
        PG8_STAGE(PG8_SB(1, 0), cB + kstep, voffB); PG8_STAGE(PG8_SA(1, 0), cA + kstep, voffA); PG8_STAGE(PG8_SB(1, 1), cB + hstep + kstep, voffB);
        PG8_WAIT_V(6); PG8_BAR;
    } else {
        PG8_STAGE(PG8_SB(0, 0), cB, voffB); PG8_STAGE(PG8_SA(0, 0), cA, voffA); PG8_STAGE(PG8_SB(0, 1), cB + hstep, voffB); PG8_STAGE(PG8_SA(0, 1), cA + hstep, voffA);
        if (wr == 1) PG8_BAR;
        PG8_WAIT_V(4); PG8_BAR;
        PG8_STAGE(PG8_SB(1, 0), cB + kstep, voffB); PG8_STAGE(PG8_SA(1, 0), cA + kstep, voffA); PG8_STAGE(PG8_SB(1, 1), cB + hstep + kstep, voffB);
        PG8_WAIT_V(6); PG8_BAR;
    }
    for (;;) {
        const bool has_next = S.next(ui + 1, nxt);
        const char* nA = has_next ? (const char*)g.A + (size_t)nxt.pm * tstep + (size_t)nxt.pn * g.a_pn : cA; const char* nB = has_next ? (const char*)g.Bt + (size_t)nxt.pn * bpn : cB;
        for (int t = 0; t < nt; t += 2) {
            const bool last = (t == nt - 2);
            const char* a1 = cA + (size_t)(t + 1) * kstep;
            const char* a2 = last ? nA : cA + (size_t)(t + 2) * kstep; const char* b2 = last ? nB : cB + (size_t)(t + 2) * kstep;
            const char* a3 = a2 + kstep; const char* b3 = b2 + kstep;
            if (last && has_next) S.a_ready(nxt);
            if constexpr (Epi::HOOK_T > 0) { if (t == Epi::HOOK_T) E.hook(acc, cur, wr, wc, fr, fq); }
            if constexpr (SP2) {
            PG8_LDB(B0, 0, 0); PG8_LDB(B1, 0, 1); PG8_SCHED; PG8_LDA(At, 0, 0); PG8_STAGE(PG8_SA(1, 1), a1 + hstep, voffA);
            PG8_WAIT_V(8); PG8_WAIT_L(0); PG8_BAR; PG8_MMA(0, 0, At, B0); PG8_MMA(0, 1, At, B1); PG8_BAR; PG8_SCHED;
            PG8_LDA(At, 0, 1); PG8_STAGE(PG8_SB(0, 0), b2, voffB); PG8_STAGE(PG8_SB(0, 1), b2 + hstep, voffB); PG8_STAGE(PG8_SA(0, 0), a2, voffA);
            PG8_WAIT_V(8); PG8_WAIT_L(0); PG8_BAR; PG8_MMA(1, 0, At, B0); PG8_MMA(1, 1, At, B1); PG8_BAR; PG8_SCHED;
            PG8_LDB(B0, 1, 0); PG8_LDB(B1, 1, 1); PG8_SCHED; PG8_LDA(At, 1, 0); PG8_STAGE(PG8_SA(0, 1), a2 + hstep, voffA);
            PG8_WAIT_V(8); PG8_WAIT_L(0); PG8_BAR; PG8_MMA(0, 0, At, B0); PG8_MMA(0, 1, At, B1); PG8_BAR; PG8_SCHED;
            PG8_LDA(At, 1, 1); PG8_STAGE(PG8_SB(1, 0), b3, voffB); PG8_STAGE(PG8_SB(1, 1), b3 + hstep, voffB); PG8_STAGE(PG8_SA(1, 0), a3, voffA);
            PG8_WAIT_V(8); PG8_WAIT_L(0); PG8_BAR; PG8_MMA(1, 0, At, B0); PG8_MMA(1, 1, At, B1); PG8_BAR; PG8_SCHED;
            } else {
            PG8_LDB(B0, 0, 0); PG8_SCHED; PG8_LDA(At, 0, 0); PG8_STAGE(PG8_SA(1, 1), a1 + hstep, voffA);
            PG8_WAIT_L(8); PG8_BAR; PG8_WAIT_L(0); PG8_MMA(0, 0, At, B0); PG8_BAR; PG8_SCHED;
            PG8_LDB(B1, 0, 1); PG8_STAGE(PG8_SB(0, 0), b2, voffB);
            PG8_BAR; PG8_WAIT_L(0); PG8_MMA(0, 1, At, B1); PG8_BAR;
            PG8_LDA(At, 0, 1); PG8_STAGE(PG8_SA(0, 0), a2, voffA);
            PG8_BAR; PG8_WAIT_L(0); PG8_MMA(1, 0, At, B0); PG8_BAR; PG8_SCHED;
            PG8_STAGE(PG8_SB(0, 1), b2 + hstep, voffB);
            PG8_WAIT_V(6); PG8_BAR; PG8_MMA(1, 1, At, B1); PG8_BAR;
            PG8_LDB(B0, 1, 0); PG8_SCHED; PG8_LDA(At, 1, 0); PG8_STAGE(PG8_SA(0, 1), a2 + hstep, voffA);
            PG8_WAIT_L(8); PG8_BAR; PG8_WAIT_L(0); PG8_MMA(0, 0, At, B0); PG8_BAR; PG8_SCHED;
            PG8_LDB(B1, 1, 1); PG8_STAGE(PG8_SB(1, 0), b3, voffB);
            PG8_BAR; PG8_WAIT_L(0); PG8_MMA(0, 1, At, B1); PG8_BAR;
            PG8_LDA(At, 1, 1); PG8_STAGE(PG8_SA(1, 0), a3, voffA);
            PG8_BAR; PG8_WAIT_L(0); PG8_MMA(1, 0, At, B0); PG8_BAR; PG8_SCHED;
            PG8_STAGE(PG8_SB(1, 1), b3 + hstep, voffB);
            PG8_WAIT_V(6); PG8_BAR; PG8_MMA(1, 1, At, B1); PG8_BAR;
            }
        }
        if constexpr (ALIGN_EPI) { if (wr == 0) PG8_BAR; }
        if constexpr (!Epi::AFTER_DRAIN) { E(acc, cur, wr, wc, fr, fq); S.done(cur); }
        if (!has_next) break;
#pragma unroll
        for (int a = 0; a < 2; ++a)
#pragma unroll
            for (int b = 0; b < 2; ++b)
#pragma unroll
                for (int m = 0; m < 4; ++m)
#pragma unroll
                    for (int n = 0; n < 2; ++n) acc[a][b][m][n] = (f32x4){0.f, 0.f, 0.f, 0.f};
        cur = nxt; cA = nA; cB = nB; ++ui;
        if constexpr (ALIGN_EPI) { if (wr == 1) PG8_BAR; }
    }
    PG8_WAIT_V(0);
    if constexpr (!ALIGN_EPI) { if (wr == 0) PG8_BAR; }
    PG8_BAR;
    if constexpr (Epi::AFTER_DRAIN) { E.fused(acc, cur, wr, wc, fr, fq, lds, wid, lane); S.done(cur); }
#undef PG8_SA
#undef PG8_SB
#undef PG8_STAGE
#undef PG8_LDA
#undef PG8_LDB
#undef PG8_MMA
#undef PG8_WAIT_V
#undef PG8_WAIT_L
#undef PG8_BAR
#undef PG8_SCHED
}
}

#define LAS __attribute__((address_space(3)))
typedef unsigned short bf16_t;
typedef short bf16x8 __attribute__((ext_vector_type(8)));
typedef float f32x4 __attribute__((ext_vector_type(4)));
typedef unsigned u32x4 __attribute__((ext_vector_type(4)));
typedef unsigned u32x2 __attribute__((ext_vector_type(2)));

constexpr int KX = 5888  , MTOK = 32768, DM = 2048, NCHUNK = 512  , DFF = 5632, N1 = 14592, NGU = 13312;
constexpr float ALPHA = 1.189207115002721f, LN_EPS = 1e-5f;
constexpr size_t MiB = 1u << 20;
constexpr size_t OFF_W1T = 0, OFF_WOT = 57 * MiB, OFF_H0 = 65 * MiB, OFF_Q = 193 * MiB, OFF_K = 257 * MiB, OFF_V = 321 * MiB, OFF_OG = 449 * MiB,
                 OFF_U = 577 * MiB, OFF_Z = 705 * MiB, OFF_GA = 833 * MiB, OFF_FG = 961 * MiB, OFF_CTL = 969 * MiB, OFF_FG2 = 976 * MiB  , WS_NEED = 984 * MiB;
constexpr size_t OFF_H1PRE = OFF_V, OFF_H1 = OFF_Z, OFF_ACT = OFF_Q  , OFF_GPG = OFF_GA, OFF_OUTPRE = 0;
constexpr size_t DO_GB = 0, DO_PLEB = 0, DO_DEC = 128 * MiB, DO_WGUT = 130 * MiB, DO_WDT = 182 * MiB, DO_WPUT = 204 * MiB, DO_PB = 205 * MiB;
constexpr int LDS_BYTES = 153600, LDS_BARW = 153536;

struct Args {
    const float *x, *p, *ln0_g, *ln0_b, *w_in, *b_in, *w_f2, *b_f2, *gla_g, *gm_g, *gm_b, *w_s, *b_s, *w_o, *ln1_g, *ln1_b, *w_gu, *w_down, *w_pg, *b_pg, *w_pu, *ln2_g, *ln2_b;
    unsigned char* out; unsigned char* ws; int ph_lo, ph_hi, coop, pad;
};

typedef float f32x2_t __attribute__((ext_vector_type(2))); typedef __bf16 bf16x2_t __attribute__((ext_vector_type(2)));
__device__ __forceinline__ unsigned cvtpk_s(float lo, float hi) { f32x2_t v = {lo, hi}; bf16x2_t b = __builtin_convertvector(v, bf16x2_t); return __builtin_bit_cast(unsigned, b); }
__device__ __forceinline__ float bflo(unsigned w) { return __uint_as_float(w << 16); }
__device__ __forceinline__ float bfhi(unsigned w) { return __uint_as_float(w & 0xffff0000u); }
__device__ __forceinline__ float sigm(float x) { return __builtin_amdgcn_rcpf(1.f + __expf(-x)); }
#define WS_DPP(x, ctrl, rm) __builtin_bit_cast(float, __builtin_amdgcn_update_dpp(0, __builtin_bit_cast(int, (x)), (ctrl), (rm), 0xf, false))
__device__ __forceinline__ float wave_sum(float v) {
    v += WS_DPP(v, 0xb1, 0xf); v += WS_DPP(v, 0x4e, 0xf); v += WS_DPP(v, 0x124, 0xf); v += WS_DPP(v, 0x128, 0xf); v += WS_DPP(v, 0x142, 0xa); v += WS_DPP(v, 0x143, 0xc);
    return __builtin_bit_cast(float, __builtin_amdgcn_readlane(__builtin_bit_cast(int, v), 63));
}
#define LDS_WAIT() asm volatile("s_waitcnt lgkmcnt(0)" ::: "memory")

using pg8::Unit;
using pg8::gelu_pk;
typedef float f32x2 __attribute__((ext_vector_type(2)));

__device__ __forceinline__ void act8(f32x4& v0, f32x4& v1, int mode) {
    if (mode == 0) { v0 = v0 * 0.0625f; v1 = v1 * 0.0625f; }
    else if (mode == 2) {
#pragma unroll
        for (int j = 0; j < 4; ++j) { v0[j] = v0[j] * sigm(v0[j]); v1[j] = v1[j] * sigm(v1[j]); } }
    else if (mode == 3) { f32x2 a = gelu_pk((f32x2){v0[0], v0[1]}), b = gelu_pk((f32x2){v0[2], v0[3]}), c = gelu_pk((f32x2){v1[0], v1[1]}), d = gelu_pk((f32x2){v1[2], v1[3]});
        v0 = (f32x4){a.x, a.y, b.x, b.y}; v1 = (f32x4){c.x, c.y, d.x, d.y}; }
    else if (mode == 4) {
#pragma unroll
        for (int j = 0; j < 4; ++j) { v0[j] = sigm(v0[j]); v1[j] = sigm(v1[j]); } }
}

struct Epi1 {
    static constexpr bool PERM = true, AFTER_DRAIN = false; static constexpr int HOOK_T = 0;
    unsigned char* ws; unsigned char* dout; const float* b_in;
    __device__ __forceinline__ void operator()(const f32x4 (&acc)[2][2][4][2], const Unit& u, int wr, int wc, int fr, int fq) const {
        const int pn = u.pn; const int row0 = u.pm * 256 + wr * 64 + fr;
        if (pn == 56) {
            if (wc < 2) {
                float* FG = (float*)(ws + OFF_FG); const int c0 = wc * 32 + 8 * fq;
                const f32x4 b0 = *(const f32x4*)(b_in + 6144 + c0), b1 = *(const f32x4*)(b_in + 6144 + c0 + 4);
#pragma unroll
                for (int ai = 0; ai < 2; ++ai)
#pragma unroll
                    for (int m = 0; m < 4; ++m) { float* rp = FG + (size_t)(row0 + ai * 128 + m * 16) * 64 + c0;
                        *(f32x4*)rp = acc[ai][0][m][0] + b0; *(f32x4*)(rp + 4) = acc[ai][0][m][1] + b1; }
            }
            return;
        }
        const int cw = wc * 32 + 8 * fq;
        if (pn >= 16 && pn < 48) {
            const bool first = pn < 32; const int t = first ? pn - 16 : pn - 32;
            const float* bA = b_in + (first ? 4096 : 6208) + 128 * t + cw; const float* bB = b_in + (first ? 10304 : 12352) + 128 * t + cw;
            const f32x4 a0 = *(const f32x4*)bA, a1 = *(const f32x4*)(bA + 4), g0 = *(const f32x4*)bB, g1 = *(const f32x4*)(bB + 4);
            bf16_t* rowp0 = (bf16_t*)(ws + (first ? OFF_OG : OFF_U)) + (size_t)row0 * 2048 + 128 * t + cw;
            if (first) pair_body<2>(acc, a0, a1, g0, g1, rowp0); else pair_body<3>(acc, a0, a1, g0, g1, rowp0);
            return;
        }
        int mode, ldc, colt, bsrc; bf16_t* base;
        if (pn < 4) { mode = 0; base = (bf16_t*)(ws + OFF_Q); ldc = 1024; colt = pn * 256; bsrc = pn * 256; }
        else if (pn < 8) { mode = 1; base = (bf16_t*)(ws + OFF_K); ldc = 1024; colt = (pn - 4) * 256; bsrc = pn * 256; }
        else if (pn < 16) { mode = 1; base = (bf16_t*)(ws + OFF_V); ldc = 2048; colt = (pn - 8) * 256; bsrc = pn * 256; }
        else { mode = 3; base = (bf16_t*)(ws + OFF_Z); ldc = 2048; colt = (pn - 48) * 256; bsrc = 8256 + (pn - 48) * 256; }
        f32x4 bv[2][2];
#pragma unroll
        for (int bj = 0; bj < 2; ++bj)
#pragma unroll
            for (int n = 0; n < 2; ++n) bv[bj][n] = *(const f32x4*)(b_in + bsrc + bj * 128 + (mode == 0 ? wc * 32 + 4 * fq + 16 * n : cw + 4 * n));
        bf16_t* rowp0 = base + (size_t)row0 * ldc + colt + cw;
        switch (mode) {
            case 0: body<0>(acc, bv, rowp0, ldc); break;
            case 1: body<1>(acc, bv, rowp0, ldc); break;
            default: body<3>(acc, bv, rowp0, ldc); break;
        }
    }
    template <int MODE> __device__ __forceinline__ void body(const f32x4 (&acc)[2][2][4][2], const f32x4 (&bv)[2][2], bf16_t* rowp0, int ldc) const {
#pragma unroll
        for (int ai = 0; ai < 2; ++ai)
#pragma unroll
            for (int m = 0; m < 4; ++m) { bf16_t* rowp = rowp0 + (size_t)(ai * 128 + m * 16) * ldc;
#pragma unroll
                for (int bj = 0; bj < 2; ++bj) { f32x4 v0 = acc[ai][bj][m][0] + bv[bj][0], v1 = acc[ai][bj][m][1] + bv[bj][1];
                    act8(v0, v1, MODE);
                    u32x4 w; w.x = cvtpk_s(v0[0], v0[1]); w.y = cvtpk_s(v0[2], v0[3]); w.z = cvtpk_s(v1[0], v1[1]); w.w = cvtpk_s(v1[2], v1[3]);
                    *(u32x4*)(rowp + bj * 128) = w; } }
    }
    template <int MODE> __device__ __forceinline__ void pair_body(const f32x4 (&acc)[2][2][4][2], const f32x4 a0, const f32x4 a1, const f32x4 g0, const f32x4 g1, bf16_t* rowp0) const {
#pragma unroll
        for (int ai = 0; ai < 2; ++ai)
#pragma unroll
            for (int m = 0; m < 4; ++m) { f32x4 v0 = acc[ai][0][m][0] + a0, v1 = acc[ai][0][m][1] + a1, s0 = acc[ai][1][m][0] + g0, s1 = acc[ai][1][m][1] + g1;
                act8(v0, v1, MODE); act8(s0, s1, 4);
                v0 = v0 * s0; v1 = v1 * s1;
                u32x4 w; w.x = cvtpk_s(v0[0], v0[1]); w.y = cvtpk_s(v0[2], v0[3]); w.z = cvtpk_s(v1[0], v1[1]); w.w = cvtpk_s(v1[2], v1[3]);
                *(u32x4*)(rowp0 + (size_t)(ai * 128 + m * 16) * 2048) = w; }
    }
};

struct EpiFg {
    static constexpr bool PERM = true, AFTER_DRAIN = false; static constexpr int HOOK_T = 0;
    float* P0; float* P1;
    __device__ __forceinline__ void operator()(const f32x4 (&acc)[2][2][4][2], const Unit& u, int wr, int wc, int fr, int fq) const {
        if (wc >= 2) return;
        float* FG = u.pn ? P1 : P0; const int row0 = u.pm * 256 + wr * 64 + fr, c0 = wc * 32 + 8 * fq;
#pragma unroll
        for (int ai = 0; ai < 2; ++ai)
#pragma unroll
            for (int m = 0; m < 4; ++m) { float* rp = FG + (size_t)(row0 + ai * 128 + m * 16) * 64 + c0; *(f32x4*)rp = acc[ai][0][m][0]; *(f32x4*)(rp + 4) = acc[ai][0][m][1]; }
    }
};

template <bool HAS_P> struct EpiRes {
    static constexpr bool PERM = true, AFTER_DRAIN = false; static constexpr int HOOK_T = 0;
    bf16_t* out; const bf16_t* R; const bf16_t* P;
    __device__ __forceinline__ void operator()(const f32x4 (&acc)[2][2][4][2], const Unit& u, int wr, int wc, int fr, int fq) const {
        const int row0 = u.pm * 256 + wr * 64 + fr, col0 = u.pn * 256 + wc * 32 + 8 * fq;
#pragma unroll
        for (int ai = 0; ai < 2; ++ai)
#pragma unroll
            for (int mh = 0; mh < 2; ++mh) {
                u32x4 rr[2][2], qq[2][2];
#pragma unroll
                for (int m2 = 0; m2 < 2; ++m2)
#pragma unroll
                    for (int bj = 0; bj < 2; ++bj) { const size_t off = (size_t)(row0 + ai * 128 + (2 * mh + m2) * 16) * DM + col0 + bj * 128;
                        rr[m2][bj] = *(const u32x4*)(R + off); if (HAS_P) qq[m2][bj] = *(const u32x4*)(P + off); }
#pragma unroll
                for (int m2 = 0; m2 < 2; ++m2)
#pragma unroll
                    for (int bj = 0; bj < 2; ++bj) { const int m = 2 * mh + m2; const size_t off = (size_t)(row0 + ai * 128 + m * 16) * DM + col0 + bj * 128; const u32x4 r = rr[m2][bj];
                        f32x4 v0 = acc[ai][bj][m][0], v1 = acc[ai][bj][m][1];
                        v0 += (f32x4){bflo(r.x), bfhi(r.x), bflo(r.y), bfhi(r.y)} * ALPHA; v1 += (f32x4){bflo(r.z), bfhi(r.z), bflo(r.w), bfhi(r.w)} * ALPHA;
                        if (HAS_P) { const u32x4 q = qq[m2][bj];
                            v0 += (f32x4){bflo(q.x), bfhi(q.x), bflo(q.y), bfhi(q.y)}; v1 += (f32x4){bflo(q.z), bfhi(q.z), bflo(q.w), bfhi(q.w)}; }
                        u32x4 w; w.x = cvtpk_s(v0[0], v0[1]); w.y = cvtpk_s(v0[2], v0[3]); w.z = cvtpk_s(v1[0], v1[1]); w.w = cvtpk_s(v1[2], v1[3]);
                        *(u32x4*)(out + off) = w; }
                asm volatile("" ::: "memory");
            }
    }
};

struct EpiDown {
    static constexpr bool PERM = true, AFTER_DRAIN = false; static constexpr int HOOK_T = 4;
    bf16_t* out; const bf16_t* R; const bf16_t* G;
    __device__ __forceinline__ void hook(f32x4 (&acc)[2][2][4][2], const Unit& u, int wr, int wc, int fr, int fq) const {
        unsigned zoff; asm volatile("v_mov_b32 %0, 0" : "=v"(zoff));
        const bf16_t* gp = G + (size_t)(u.pm * 256 + wr * 64 + fr) * DM + u.pn * 256 + wc * 32 + 8 * fq + zoff;
#pragma unroll
        for (int ai = 0; ai < 2; ++ai)
#pragma unroll
            for (int mh = 0; mh < 2; ++mh) {
                u32x4 rr[2][2];
#pragma unroll
                for (int m2 = 0; m2 < 2; ++m2)
#pragma unroll
                    for (int bj = 0; bj < 2; ++bj) rr[m2][bj] = *(const u32x4*)(gp + (size_t)(ai * 128 + (2 * mh + m2) * 16) * DM + bj * 128);
#pragma unroll
                for (int m2 = 0; m2 < 2; ++m2)
#pragma unroll
                    for (int bj = 0; bj < 2; ++bj) { const u32x4 r = rr[m2][bj]; const int m = 2 * mh + m2;
                        acc[ai][bj][m][0] *= (f32x4){bflo(r.x), bfhi(r.x), bflo(r.y), bfhi(r.y)}; acc[ai][bj][m][1] *= (f32x4){bflo(r.z), bfhi(r.z), bflo(r.w), bfhi(r.w)}; }
                asm volatile("" ::: "memory");
            }
    }
    __device__ __forceinline__ void operator()(const f32x4 (&acc)[2][2][4][2], const Unit& u, int wr, int wc, int fr, int fq) const {
        const int row0 = u.pm * 256 + wr * 64 + fr, col0 = u.pn * 256 + wc * 32 + 8 * fq;
#pragma unroll
        for (int ai = 0; ai < 2; ++ai)
#pragma unroll
            for (int m = 0; m < 4; ++m)
#pragma unroll
                for (int bj = 0; bj < 2; ++bj) { const size_t off = (size_t)(row0 + ai * 128 + m * 16) * DM + col0 + bj * 128; const u32x4 r = *(const u32x4*)(R + off);
                    f32x4 v0 = acc[ai][bj][m][0], v1 = acc[ai][bj][m][1];
                    v0 += (f32x4){bflo(r.x), bfhi(r.x), bflo(r.y), bfhi(r.y)} * ALPHA; v1 += (f32x4){bflo(r.z), bfhi(r.z), bflo(r.w), bfhi(r.w)} * ALPHA;
                    u32x4 w; w.x = cvtpk_s(v0[0], v0[1]); w.y = cvtpk_s(v0[2], v0[3]); w.z = cvtpk_s(v1[0], v1[1]); w.w = cvtpk_s(v1[2], v1[3]);
                    *(u32x4*)(out + off) = w; }
    }
};

struct Epi5 {
    static constexpr bool PERM = true, AFTER_DRAIN = false; static constexpr int HOOK_T = 0;
    bf16_t* ACT; bf16_t* GPG; const float* b_pg;
    __device__ __forceinline__ void operator()(const f32x4 (&acc)[2][2][4][2], const Unit& u, int wr, int wc, int fr, int fq) const {
        const int pn = u.pn; const int row0 = u.pm * 256 + wr * 64 + fr, cw = wc * 32 + 8 * fq;
        if (pn < 44) {
#pragma unroll
            for (int ai = 0; ai < 2; ++ai)
#pragma unroll
                for (int m = 0; m < 4; ++m) { bf16_t* rowp = ACT + (size_t)(row0 + ai * 128 + m * 16) * KX + 256 + pn * 128 + cw;
                    f32x4 g0 = acc[ai][0][m][0], g1 = acc[ai][0][m][1]; const f32x4 u0 = acc[ai][1][m][0], u1 = acc[ai][1][m][1];
#pragma unroll
                    for (int j = 0; j < 4; ++j) { g0[j] = g0[j] * sigm(g0[j]) * u0[j]; g1[j] = g1[j] * sigm(g1[j]) * u1[j]; }
                    u32x4 w; w.x = cvtpk_s(g0[0], g0[1]); w.y = cvtpk_s(g0[2], g0[3]); w.z = cvtpk_s(g1[0], g1[1]); w.w = cvtpk_s(g1[2], g1[3]);
                    *(u32x4*)rowp = w; }
        } else {
            const int colt = (pn - 44) * 256;
            f32x4 bv[2][2];
#pragma unroll
            for (int bj = 0; bj < 2; ++bj)
#pragma unroll
                for (int n = 0; n < 2; ++n) bv[bj][n] = *(const f32x4*)(b_pg + colt + bj * 128 + cw + 4 * n);
#pragma unroll
            for (int ai = 0; ai < 2; ++ai)
#pragma unroll
                for (int m = 0; m < 4; ++m) { bf16_t* rowp = GPG + (size_t)(row0 + ai * 128 + m * 16) * DM + colt + cw;
#pragma unroll
                    for (int bj = 0; bj < 2; ++bj) { f32x4 v0 = acc[ai][bj][m][0] + bv[bj][0], v1 = acc[ai][bj][m][1] + bv[bj][1];
                        act8(v0, v1, 4);
                        u32x4 w; w.x = cvtpk_s(v0[0], v0[1]); w.y = cvtpk_s(v0[2], v0[3]); w.z = cvtpk_s(v1[0], v1[1]); w.w = cvtpk_s(v1[2], v1[3]);
                        *(u32x4*)(rowp + bj * 128) = w; } }
        }
    }
};

struct EpiPle {
    static constexpr bool PERM = true, AFTER_DRAIN = false; static constexpr int HOOK_T = 0;
    bf16_t* O; const bf16_t* G;
    __device__ __forceinline__ void operator()(const f32x4 (&acc)[2][2][4][2], const Unit& u, int wr, int wc, int fr, int fq) const {
        const int row0 = u.pm * 256 + wr * 64 + fr, col0 = u.pn * 256 + wc * 32 + 8 * fq;
#pragma unroll
        for (int ai = 0; ai < 2; ++ai) {
            u32x4 rr[4][2];
#pragma unroll
            for (int m = 0; m < 4; ++m)
#pragma unroll
                for (int bj = 0; bj < 2; ++bj) rr[m][bj] = *(const u32x4*)(G + (size_t)(row0 + ai * 128 + m * 16) * DM + col0 + bj * 128);
#pragma unroll
            for (int m = 0; m < 4; ++m)
#pragma unroll
                for (int bj = 0; bj < 2; ++bj) { const size_t off = (size_t)(row0 + ai * 128 + m * 16) * DM + col0 + bj * 128; const u32x4 r = rr[m][bj];
                    const f32x4 v0 = acc[ai][bj][m][0] * (f32x4){bflo(r.x), bfhi(r.x), bflo(r.y), bfhi(r.y)}, v1 = acc[ai][bj][m][1] * (f32x4){bflo(r.z), bfhi(r.z), bflo(r.w), bfhi(r.w)};
                    u32x4 w; w.x = cvtpk_s(v0[0], v0[1]); w.y = cvtpk_s(v0[2], v0[3]); w.z = cvtpk_s(v1[0], v1[1]); w.w = cvtpk_s(v1[2], v1[3]);
                    *(u32x4*)(O + off) = w; }
            asm volatile("" ::: "memory");
        }
    }
};

__device__ __forceinline__ int dkmap32(int pos) { const int qq = pos >> 3, jj = pos & 7; return jj < 4 ? 4 * qq + jj : 16 + 4 * qq + (jj - 4); }
__device__ __forceinline__ void tr_item(const float* W, int ldw, int srccol0, int k0, bf16_t* WT, int ldt, int dstrow0, LAS float* scr, int lane, bool zero, int dk0 = 0, bool qperm = false) {
    if (!zero) {
        f32x4 tv[8];
#pragma unroll
        for (int i = 0; i < 8; ++i) tv[i] = *(const f32x4*)(W + (size_t)(k0 + 8 * i + (lane >> 3)) * ldw + srccol0 + 4 * (lane & 7));
#pragma unroll
        for (int i = 0; i < 8; ++i) { LAS float* d = scr + (8 * i + (lane >> 3)) * 33 + 4 * (lane & 7); d[0] = tv[i][0]; d[1] = tv[i][1]; d[2] = tv[i][2]; d[3] = tv[i][3]; }
    }
    LDS_WAIT();
    const int c = lane & 7;
#pragma unroll
    for (int j = 0; j < 4; ++j) { const int n = (lane >> 3) + 8 * j; const LAS float* s = scr + (8 * c) * 33 + (qperm ? dkmap32(n) : n);
        u32x4 o; o.x = cvtpk_s(s[0 * 33], s[1 * 33]); o.y = cvtpk_s(s[2 * 33], s[3 * 33]); o.z = cvtpk_s(s[4 * 33], s[5 * 33]); o.w = cvtpk_s(s[6 * 33], s[7 * 33]);
        if (zero) o = (u32x4){0u, 0u, 0u, 0u};
        *(u32x4*)(WT + (size_t)(dstrow0 + n) * ldt + dk0 + k0 + 8 * c) = o; }
    LDS_WAIT();
}
template <bool OUT_BF16> __device__ __forceinline__ void ln_row(const float* in, void* outp, const float* g, const float* b, int lane) {
    const f32x4* xr = (const f32x4*)in + lane;
    f32x4 v[8]; float s = 0.f;
#pragma unroll
    for (int j = 0; j < 8; ++j) { v[j] = xr[64 * j]; s += (v[j][0] + v[j][1]) + (v[j][2] + v[j][3]); }
    const float mean = wave_sum(s) * (1.f / DM); float s2 = 0.f;
#pragma unroll
    for (int j = 0; j < 8; ++j) { v[j] = v[j] - mean; s2 += (v[j][0] * v[j][0] + v[j][1] * v[j][1]) + (v[j][2] * v[j][2] + v[j][3] * v[j][3]); }
    const float rstd = 1.f / sqrtf(wave_sum(s2) * (1.f / DM) + LN_EPS);
#pragma unroll
    for (int j = 0; j < 8; ++j) { const f32x4 gg = ((const f32x4*)g)[64 * j + lane], bb = ((const f32x4*)b)[64 * j + lane]; const f32x4 o = v[j] * rstd * gg + bb;
        if (OUT_BF16) { u32x2 w; w.x = cvtpk_s(o[0], o[1]); w.y = cvtpk_s(o[2], o[3]); ((u32x2*)outp)[64 * j + lane] = w; }
        else ((f32x4*)outp)[64 * j + lane] = o; }
}
template <bool OUT_BF16, bool IN_BF16 = false> __device__ __forceinline__ void ln_row2(const void* in0, const void* in1, void* out0, void* out1, const float* g, const float* b, int lane) {
    f32x4 v[8], w[8]; float s = 0.f, t = 0.f;
    if (IN_BF16) { const u32x2* x0 = (const u32x2*)in0 + lane; const u32x2* x1 = (const u32x2*)in1 + lane; u32x2 a0[8], a1[8];
#pragma unroll
        for (int j = 0; j < 8; ++j) { a0[j] = x0[64 * j]; a1[j] = x1[64 * j]; }
#pragma unroll
        for (int j = 0; j < 8; ++j) { v[j] = (f32x4){bflo(a0[j].x), bfhi(a0[j].x), bflo(a0[j].y), bfhi(a0[j].y)}; w[j] = (f32x4){bflo(a1[j].x), bfhi(a1[j].x), bflo(a1[j].y), bfhi(a1[j].y)}; }
    } else { const f32x4* x0 = (const f32x4*)in0 + lane; const f32x4* x1 = (const f32x4*)in1 + lane;
#pragma unroll
        for (int j = 0; j < 8; ++j) { v[j] = x0[64 * j]; w[j] = x1[64 * j]; } }
#pragma unroll
    for (int j = 0; j < 8; ++j) { s += (v[j][0] + v[j][1]) + (v[j][2] + v[j][3]); t += (w[j][0] + w[j][1]) + (w[j][2] + w[j][3]); }
#pragma unroll
    for (int o = 1; o < 64; o <<= 1) { s += __shfl_xor(s, o); t += __shfl_xor(t, o); }
    const float m0 = s * (1.f / DM), m1 = t * (1.f / DM); float s2 = 0.f, t2 = 0.f;
#pragma unroll
    for (int j = 0; j < 8; ++j) { v[j] = v[j] - m0; w[j] = w[j] - m1; s2 += (v[j][0] * v[j][0] + v[j][1] * v[j][1]) + (v[j][2] * v[j][2] + v[j][3] * v[j][3]); t2 += (w[j][0] * w[j][0] + w[j][1] * w[j][1]) + (w[j][2] * w[j][2] + w[j][3] * w[j][3]); }
#pragma unroll
    for (int o = 1; o < 64; o <<= 1) { s2 += __shfl_xor(s2, o); t2 += __shfl_xor(t2, o); }
    const float r0 = 1.f / sqrtf(s2 * (1.f / DM) + LN_EPS), r1 = 1.f / sqrtf(t2 * (1.f / DM) + LN_EPS);
#pragma unroll
    for (int j = 0; j < 8; ++j) { const f32x4 gg = ((const f32x4*)g)[64 * j + lane], bb = ((const f32x4*)b)[64 * j + lane]; const f32x4 o0 = v[j] * r0 * gg + bb, o1 = w[j] * r1 * gg + bb;
        if (OUT_BF16) { u32x2 p; p.x = cvtpk_s(o0[0], o0[1]); p.y = cvtpk_s(o0[2], o0[3]); ((u32x2*)out0)[64 * j + lane] = p; p.x = cvtpk_s(o1[0], o1[1]); p.y = cvtpk_s(o1[2], o1[3]); ((u32x2*)out1)[64 * j + lane] = p; }
        else { ((f32x4*)out0)[64 * j + lane] = o0; ((f32x4*)out1)[64 * j + lane] = o1; } }
}

template <bool OUT_BF16, bool IN_BF16> __device__ __forceinline__ void ln_stream(const void* in, void* out, const float* g, const float* b, int gw, int ngw, int lane) {
    typedef typename std::conditional<IN_BF16, u32x2, f32x4>::type raw_t;
    f32x4 gg[8], bb[8];
#pragma unroll
    for (int j = 0; j < 8; ++j) { gg[j] = ((const f32x4*)g)[64 * j + lane]; bb[j] = ((const f32x4*)b)[64 * j + lane]; }
    raw_t cur[2][8], nxt[2][8];
    const int nit = MTOK / (2 * ngw);
#define LN_LOAD(dst, it) do { _Pragma("unroll") for (int r = 0; r < 2; ++r) { const raw_t* rp = (const raw_t*)((const char*)in + (size_t)(gw + (2 * (it) + r) * ngw) * DM * (IN_BF16 ? 2 : 4)) + lane; \
        _Pragma("unroll") for (int j = 0; j < 8; ++j) dst[r][j] = rp[64 * j]; } } while (0)
    LN_LOAD(cur, 0);
    for (int it = 0; it < nit; ++it) {
        if (it + 1 < nit) LN_LOAD(nxt, it + 1);
        f32x4 v[2][8]; float s[2], s2[2];
#pragma unroll
        for (int r = 0; r < 2; ++r) { s[r] = 0.f;
#pragma unroll
            for (int j = 0; j < 8; ++j) { if constexpr (IN_BF16) { const u32x2 w = *(const u32x2*)&cur[r][j]; v[r][j] = (f32x4){bflo(w.x), bfhi(w.x), bflo(w.y), bfhi(w.y)}; } else v[r][j] = *(const f32x4*)&cur[r][j];
                s[r] += (v[r][j][0] + v[r][j][1]) + (v[r][j][2] + v[r][j][3]); } }
        s[0] = wave_sum(s[0]); s[1] = wave_sum(s[1]);
#pragma unroll
        for (int r = 0; r < 2; ++r) { const float mean = s[r] * (1.f / DM); s2[r] = 0.f;
#pragma unroll
            for (int j = 0; j < 8; ++j) { v[r][j] = v[r][j] - mean; s2[r] += (v[r][j][0] * v[r][j][0] + v[r][j][1] * v[r][j][1]) + (v[r][j][2] * v[r][j][2] + v[r][j][3] * v[r][j][3]); } }
        s2[0] = wave_sum(s2[0]); s2[1] = wave_sum(s2[1]);
#pragma unroll
        for (int r = 0; r < 2; ++r) { const float rstd = 1.f / sqrtf(s2[r] * (1.f / DM) + LN_EPS); const size_t row = (size_t)(gw + (2 * it + r) * ngw);
#pragma unroll
            for (int j = 0; j < 8; ++j) { const f32x4 o = v[r][j] * rstd * gg[j] + bb[j];
                if (OUT_BF16) { u32x2 pk; pk.x = cvtpk_s(o[0], o[1]); pk.y = cvtpk_s(o[2], o[3]); ((u32x2*)((bf16_t*)out + row * DM))[64 * j + lane] = pk; }
                else ((f32x4*)((float*)out + row * DM))[64 * j + lane] = o; } }
#pragma unroll
        for (int r = 0; r < 2; ++r)
#pragma unroll
            for (int j = 0; j < 8; ++j) cur[r][j] = nxt[r][j];
    }
#undef LN_LOAD
}

__device__ __forceinline__ void phase_prep(const Args& a, LAS unsigned char* lds, int gw, int ngw, int wave, int lane) {
    LAS float* scr = (LAS float*)(lds + wave * 8448);
    bf16_t* W1T = (bf16_t*)(a.ws + OFF_W1T); bf16_t* WOT = (bf16_t*)(a.ws + OFF_WOT);
    constexpr int I1 = 32 * (N1 / 32), IO = 32 * 64;
    for (int it = gw; it < I1; it += ngw) {
        if (it < I1) { const int kb = it / (N1 / 32), nb = it % (N1 / 32), n0 = nb * 32;
            const bool zero = n0 >= 14400; int src;
            if (n0 < 4096) src = n0;
            else if (n0 < 8192) { const int t = (n0 - 4096) >> 8, wi = n0 & 255; src = wi < 128 ? 4096 + 128 * t + wi : 10304 + 128 * t + (wi - 128); }
            else if (n0 < 12288) { const int t = (n0 - 8192) >> 8, wi = n0 & 255; src = wi < 128 ? 6208 + 128 * t + wi : 12352 + 128 * t + (wi - 128); }
            else if (n0 < 14336) src = 8256 + (n0 - 12288);
            else src = 6144 + (n0 - 14336);
            tr_item(a.w_in, 14400, zero ? 0 : src, kb * 64, W1T, 2048, n0, scr, lane, zero, 0, n0 < 1024); }
        else { const int r = it - I1, kb = r / 64, nb = r % 64; tr_item(a.w_o, 2048, nb * 32, kb * 64, WOT, 2048, nb * 32, scr, lane, false); }
    }
    bf16_t* H0 = (bf16_t*)(a.ws + OFF_H0);
    ln_stream<true, false>(a.x, H0, a.ln0_g, a.ln0_b, gw, ngw, lane);
}
__device__ __forceinline__ void phase_prep2(const Args& a, LAS unsigned char* lds, int gw, int ngw, int wave, int lane) {
    LAS float* scr = (LAS float*)(lds + wave * 8448);
    bf16_t* WGUT = (bf16_t*)(a.out + DO_WGUT); bf16_t* WDT = (bf16_t*)(a.out + DO_WDT);
    constexpr int IG = 32 * (NGU / 32), ID = 88 * 64, IP = 4 * 64;
    { bf16_t* WOT = (bf16_t*)(a.ws + OFF_WOT);
      for (int r = gw; r < 32 * 64; r += ngw) { const int kb = r / 64, nb = r % 64; tr_item(a.w_o, 2048, nb * 32, kb * 64, WOT, 2048, nb * 32, scr, lane, false); } }
    for (int it = gw; it < IG + ID + IP; it += ngw) {
        if (it < IG) { const int kb = it / (NGU / 32), nb = it % (NGU / 32), n0 = nb * 32, t = n0 >> 8, wi = n0 & 255;
            if (t < 44) tr_item(a.w_gu, 2 * DFF, wi < 128 ? t * 128 + wi : DFF + t * 128 + (wi - 128), kb * 64, WGUT, 2048, n0, scr, lane, false);
            else tr_item(a.w_pg, 2048, (t - 44) * 256 + wi, kb * 64, WGUT, 2048, n0, scr, lane, false); }
        else if (it < IG + ID) { const int r = it - IG, kb = r / 64, nb = r % 64; tr_item(a.w_down, 2048, nb * 32, kb * 64, WDT, KX, nb * 32, scr, lane, false, 256); }
        else { const int r = it - IG - ID, kb = r / 64, nb = r % 64; tr_item(a.w_pu, 2048, nb * 32, kb * 64, WDT, KX, nb * 32, scr, lane, false, 0); }
    }
}
__device__ __forceinline__ void phase_pconv(const Args& a, int gw, int ngw, int lane) {
    bf16_t* ACT = (bf16_t*)(a.ws + OFF_ACT);
    for (int i = gw * 64 + lane; i < MTOK * 64; i += ngw * 64) { const int m = i >> 6, c4 = (i & 63) * 4; const f32x4 v = *(const f32x4*)(a.p + (size_t)m * 256 + c4);
        u32x2 w; w.x = cvtpk_s(v[0], v[1]); w.y = cvtpk_s(v[2], v[3]); *(u32x2*)(ACT + (size_t)m * KX + c4) = w; }
}

__device__ __forceinline__ void phase_kt(const Args& a, LAS unsigned char* lds, int tid) {
    LAS float* fgs = (LAS float*)(lds + 131072);
    bf16_t* Kb = (bf16_t*)(a.ws + OFF_K); const float* FG = (const float*)(a.ws + OFF_FG); const float* FG2 = (const float*)(a.ws + OFF_FG2); float* DEC = (float*)(a.out + DO_DEC);
    const int col2 = 2 * tid, h = col2 >> 8, d = col2 & 255;
    float w0[16], w1[16];
#pragma unroll
    for (int r = 0; r < 16; ++r) { const float2 t = *(const float2*)(a.w_f2 + (h * 16 + r) * 256 + d); w0[r] = t.x; w1[r] = t.y; }
    const float2 bb = *(const float2*)(a.b_f2 + h * 256 + d);
    for (int it = blockIdx.x; it < NCHUNK; it += gridDim.x) {
        const size_t row0 = (size_t)it * 64;
        __syncthreads();
#pragma unroll
        for (int i = 0; i < 2; ++i) { const int p = tid + 512 * i; ((LAS f32x4*)fgs)[p] = ((const f32x4*)(FG + row0 * 64))[p] + ((const f32x4*)(FG2 + row0 * 64))[p] + *(const f32x4*)(a.b_in + 6144 + 4 * (p & 15)); }
        __syncthreads();
        float run0 = 0.f, run1 = 0.f;
        unsigned kwc[8], kwn[8];
#pragma unroll
        for (int tt = 0; tt < 8; ++tt) { kwc[tt] = *(const unsigned*)(Kb + (row0 + 56 + tt) * 1024 + col2); kwn[tt] = 0u; }
        for (int tg = 7; tg >= 0; --tg) {
            if (tg > 0) {
#pragma unroll
                for (int tt = 0; tt < 8; ++tt) kwn[tt] = *(const unsigned*)(Kb + (row0 + (tg - 1) * 8 + tt) * 1024 + col2); }
            float v0[8], v1[8];
#pragma unroll
            for (int tt = 7; tt >= 0; --tt) { const int t = tg * 8 + tt;
                const LAS f32x4* fp = (const LAS f32x4*)(fgs + t * 64 + h * 16);
                float f0 = bb.x, f1 = bb.y;
#pragma unroll
                for (int r4 = 0; r4 < 4; ++r4) { const f32x4 fv = fp[r4];
#pragma unroll
                    for (int j = 0; j < 4; ++j) { f0 += fv[j] * w0[r4 * 4 + j]; f1 += fv[j] * w1[r4 * 4 + j]; } }
                const float la0 = (fminf(f0, 0.f) - __logf(1.f + __expf(-fabsf(f0)))) * 0.0625f, la1 = (fminf(f1, 0.f) - __logf(1.f + __expf(-fabsf(f1)))) * 0.0625f;
                const unsigned kw = kwc[tt];
                v0[tt] = bflo(kw) * __expf(run0); v1[tt] = bfhi(kw) * __expf(run1);
                run0 += la0; run1 += la1; }
            u32x4 p0, p1;
            p0.x = cvtpk_s(v0[0], v0[1]); p0.y = cvtpk_s(v0[2], v0[3]); p0.z = cvtpk_s(v0[4], v0[5]); p0.w = cvtpk_s(v0[6], v0[7]);
            p1.x = cvtpk_s(v1[0], v1[1]); p1.y = cvtpk_s(v1[2], v1[3]); p1.z = cvtpk_s(v1[4], v1[5]); p1.w = cvtpk_s(v1[6], v1[7]);
            *(LAS u32x4*)(lds + col2 * 128 + ((tg ^ (col2 & 7)) << 4)) = p0;
            *(LAS u32x4*)(lds + (col2 + 1) * 128 + ((tg ^ ((col2 + 1) & 7)) << 4)) = p1;
#pragma unroll
            for (int tt = 0; tt < 8; ++tt) kwc[tt] = kwn[tt];
        }
        *(float2*)(DEC + (size_t)it * 1024 + col2) = make_float2(__expf(run0), __expf(run1));
        __syncthreads();
#pragma unroll
        for (int i = 0; i < 16; ++i) { const int p = tid + 512 * i, c = p >> 3, s = p & 7;
            *(u32x4*)(Kb + (size_t)it * 65536 + c * 64 + s * 8) = *(const LAS u32x4*)(lds + c * 128 + ((s ^ (c & 7)) << 4)); }
    }
    __syncthreads();
}

__device__ __forceinline__ void phase_scan(const Args& a, LAS unsigned char* lds, int tid, int wave, int lane) {
    const int bx = blockIdx.x, xcd = bx & 7, jj = bx >> 3, bh = xcd * 2 + (jj >> 3), b = bh >> 2, h = bh & 3, dvb = jj & 7, l15 = lane & 15, q = lane >> 4;
    constexpr int KTB = 0, QB = 65536, VB = 131072, DB = 147456;
    const bf16_t* KT = (const bf16_t*)(a.ws + OFF_K) + (size_t)(b * 128) * 65536 + h * 16384;
    const bf16_t* Qg = (const bf16_t*)(a.ws + OFF_Q) + (size_t)(b * 8192) * 1024 + h * 256;
    bf16_t* Vg = (bf16_t*)(a.ws + OFF_V) + (size_t)(b * 8192) * 2048 + h * 512 + dvb * 64;
    const float* DEC = (const float*)(a.out + DO_DEC) + (size_t)(b * 128) * 1024 + h * 256;
#define SBAR() do { asm volatile("s_waitcnt lgkmcnt(0)" ::: "memory"); __builtin_amdgcn_s_barrier(); asm volatile("" ::: "memory"); } while (0)
    if (wave >= 4) {
        const int lw = wave - 4;
        const unsigned kvo = (unsigned)(((lane >> 3) * 64 + (((lane & 7) ^ ((lane >> 3) & 7)) << 3)) * 2);
        unsigned qvo[8];
#pragma unroll
        for (int i = 0; i < 8; ++i) { const int frl = 2 * i + (lane >> 5); qvo[i] = (unsigned)(((lw * 16 + frl) * 1024 + (((lane & 31) ^ (frl & 15)) << 3)) * 2); }
        const unsigned vvo = (unsigned)(((lane >> 3) * 2048 + (lane & 7) * 8) * 2);
#define G1(cc) do { const int c_ = (cc) > 127 ? 127 : (cc); const char* qb_ = (const char*)(Qg + (size_t)c_ * 65536); LAS unsigned char* d_ = lds + QB + ((cc) & 1) * 32768 + lw * 8192; \
            _Pragma("unroll") for (int i = 0; i < 8; ++i) __builtin_amdgcn_global_load_lds((const unsigned*)(qb_ + qvo[i]), (LAS unsigned*)(d_ + i * 1024), 16, 0, 0); } while (0)
#define G2(cc) do { const int c_ = (cc) > 127 ? 127 : (cc); const char* kb_ = (const char*)(KT + (size_t)c_ * 65536) + lw * 8192; LAS unsigned char* d_ = lds + KTB + ((cc) & 1) * 32768 + lw * 8192; \
            _Pragma("unroll") for (int i = 0; i < 8; ++i) __builtin_amdgcn_global_load_lds((const unsigned*)(kb_ + i * 1024 + kvo), (LAS unsigned*)(d_ + i * 1024), 16, 0, 0); \
            const char* vb_ = (const char*)(Vg + (size_t)(c_ * 64 + lw * 16) * 2048); LAS unsigned char* dv_ = lds + VB + ((cc) & 1) * 8192 + lw * 2048; \
            _Pragma("unroll") for (int i = 0; i < 2; ++i) __builtin_amdgcn_global_load_lds((const unsigned*)(vb_ + (size_t)i * 8 * 2048 * 2 + vvo), (LAS unsigned*)(dv_ + i * 1024), 16, 0, 0); \
            __builtin_amdgcn_global_load_lds((const unsigned*)(DEC + (size_t)c_ * 1024 + lw * 64 + lane), (LAS unsigned*)(lds + DB + ((cc) & 1) * 1024 + lw * 256), 4, 0, 0); } while (0)
        G2(0); G1(0); G2(1);
        for (int c = 0; c < 128; ++c) {
            asm volatile("s_waitcnt vmcnt(19)" ::: "memory");
            SBAR();
            G1(c + 1);
            asm volatile("s_waitcnt vmcnt(19)" ::: "memory");
            SBAR();
            G2(c + 2);
        }
        asm volatile("s_waitcnt vmcnt(0)" ::: "memory");
#undef G1
#undef G2
    } else {
        const unsigned ovo = (unsigned)((l15 * 2048 + 16 * wave + 4 * q) * 2);
        __builtin_amdgcn_s_setprio(2);
        f32x4 accS[16];
#pragma unroll
        for (int i = 0; i < 16; ++i) accS[i] = (f32x4){0.f, 0.f, 0.f, 0.f};
        for (int c = 0; c < 128; ++c) {
            LAS unsigned char* KTs = lds + KTB + (c & 1) * 32768; LAS unsigned char* Qs = lds + QB + (c & 1) * 32768;
            const LAS unsigned short* Vs = (const LAS unsigned short*)(lds + VB + (c & 1) * 8192); LAS float* DECs = (LAS float*)(lds + DB + (c & 1) * 1024);
            SBAR();
            bf16x8 vb0, vb1;
            { const LAS unsigned short* vp = Vs + (8 * q) * 64 + 16 * wave + l15; unsigned w0[4], w1[4];
#pragma unroll
              for (int e = 0; e < 4; ++e) { w0[e] = (unsigned)vp[(2 * e) * 64] | ((unsigned)vp[(2 * e + 1) * 64] << 16); w1[e] = (unsigned)vp[(32 + 2 * e) * 64] | ((unsigned)vp[(32 + 2 * e + 1) * 64] << 16); }
              vb0 = __builtin_bit_cast(bf16x8, (u32x4){w0[0], w0[1], w0[2], w0[3]}); vb1 = __builtin_bit_cast(bf16x8, (u32x4){w1[0], w1[1], w1[2], w1[3]}); }
#define SCAN_KTLD(A0, A1, D, bt) do { _Pragma("unroll") for (int t = 0; t < 4; ++t) { const int dk = 16 * (4 * (bt) + t) + l15; \
                A0[t] = *(const LAS bf16x8*)(KTs + dk * 128 + ((q ^ (dk & 7)) << 4)); A1[t] = *(const LAS bf16x8*)(KTs + dk * 128 + (((4 + q) ^ (dk & 7)) << 4)); \
                D[t] = *(const LAS f32x4*)(DECs + 16 * (4 * (bt) + t) + 4 * q); } } while (0)
#define SCAN_KTMM(A0, A1, D, bt) do { _Pragma("unroll") for (int t = 0; t < 4; ++t) accS[4 * (bt) + t] = __builtin_amdgcn_mfma_f32_16x16x32_bf16(A0[t], vb0, accS[4 * (bt) + t] * D[t], 0, 0, 0); \
            _Pragma("unroll") for (int t = 0; t < 4; ++t) accS[4 * (bt) + t] = __builtin_amdgcn_mfma_f32_16x16x32_bf16(A1[t], vb1, accS[4 * (bt) + t], 0, 0, 0); } while (0)
            {
                bf16x8 xa0[4], xa1[4], ya0[4], ya1[4]; f32x4 xd[4], yd[4];
                SCAN_KTLD(xa0, xa1, xd, 0); __builtin_amdgcn_sched_barrier(0);
                SCAN_KTLD(ya0, ya1, yd, 1); __builtin_amdgcn_sched_barrier(0);
                SCAN_KTMM(xa0, xa1, xd, 0); __builtin_amdgcn_sched_barrier(0);
                SCAN_KTLD(xa0, xa1, xd, 2); __builtin_amdgcn_sched_barrier(0);
                SCAN_KTMM(ya0, ya1, yd, 1); __builtin_amdgcn_sched_barrier(0);
                SCAN_KTLD(ya0, ya1, yd, 3); __builtin_amdgcn_sched_barrier(0);
                SCAN_KTMM(xa0, xa1, xd, 2); __builtin_amdgcn_sched_barrier(0);
                SCAN_KTMM(ya0, ya1, yd, 3); __builtin_amdgcn_sched_barrier(0);
            }
            bf16x8 sf[8];
#pragma unroll
            for (int ks = 0; ks < 8; ++ks) { u32x4 w; w.x = cvtpk_s(accS[2 * ks][0], accS[2 * ks][1]); w.y = cvtpk_s(accS[2 * ks][2], accS[2 * ks][3]);
                w.z = cvtpk_s(accS[2 * ks + 1][0], accS[2 * ks + 1][1]); w.w = cvtpk_s(accS[2 * ks + 1][2], accS[2 * ks + 1][3]); sf[ks] = __builtin_bit_cast(bf16x8, w); }
            SBAR();
            f32x4 o[4];
#pragma unroll
            for (int ft = 0; ft < 4; ++ft) o[ft] = (f32x4){0.f, 0.f, 0.f, 0.f};
#define SCAN_QLD(Q, kb) do { _Pragma("unroll") for (int k2 = 0; k2 < 2; ++k2) _Pragma("unroll") for (int ft = 0; ft < 4; ++ft) { const int fr = 16 * ft + l15, pc = 4 * (2 * (kb) + k2) + q; \
                Q[k2 * 4 + ft] = *(const LAS u32x4*)(Qs + fr * 512 + ((pc ^ (fr & 15)) << 4)); } } while (0)
#define SCAN_QMM(Q, kb) do { _Pragma("unroll") for (int k2 = 0; k2 < 2; ++k2) _Pragma("unroll") for (int ft = 0; ft < 4; ++ft) \
                o[ft] = __builtin_amdgcn_mfma_f32_16x16x32_bf16(sf[2 * (kb) + k2], __builtin_bit_cast(bf16x8, Q[k2 * 4 + ft]), o[ft], 0, 0, 0); } while (0)
            {
                u32x4 xq[8], yq[8];
                SCAN_QLD(xq, 0); __builtin_amdgcn_sched_barrier(0);
                SCAN_QLD(yq, 1); __builtin_amdgcn_sched_barrier(0);
                SCAN_QMM(xq, 0); __builtin_amdgcn_sched_barrier(0);
                SCAN_QLD(xq, 2); __builtin_amdgcn_sched_barrier(0);
                SCAN_QMM(yq, 1); __builtin_amdgcn_sched_barrier(0);
                SCAN_QLD(yq, 3); __builtin_amdgcn_sched_barrier(0);
                SCAN_QMM(xq, 2); __builtin_amdgcn_sched_barrier(0);
                SCAN_QMM(yq, 3); __builtin_amdgcn_sched_barrier(0);
            }
#undef SCAN_KTLD
#undef SCAN_KTMM
#undef SCAN_QLD
#undef SCAN_QMM
#pragma unroll
            for (int ft = 0; ft < 4; ++ft) { u32x2 w; w.x = cvtpk_s(o[ft][0], o[ft][1]); w.y = cvtpk_s(o[ft][2], o[ft][3]);
                *(u32x2*)((char*)(Vg + (size_t)(c * 64 + 16 * ft) * 2048) + ovo) = w; }
        }
        __builtin_amdgcn_s_setprio(0);
    }
    SBAR();
#undef SBAR
}

__device__ __forceinline__ void phase_merge(const Args& a, LAS unsigned char* lds, int tid, int wave, int lane) {
    const int g = blockIdx.x & 3, l15 = lane & 15, q = lane >> 4;
    LAS unsigned char* Ws = lds; LAS unsigned char* ZT = lds + 32768; LAS float* SG = (LAS float*)(lds + 65536); LAS float* MU = (LAS float*)(lds + 65536 + 67584); LAS float* RS = MU + 128; LAS float* RO = MU + 256;
    const bf16_t* Zb = (const bf16_t*)(a.ws + OFF_Z); const bf16_t* Ob = (const bf16_t*)(a.ws + OFF_V); const bf16_t* OGb = (const bf16_t*)(a.ws + OFF_OG);
    bf16_t* Ub = (bf16_t*)(a.ws + OFF_U);
    for (int p = tid; p < 4096; p += 512) { const int i = p >> 5, j4 = (p & 31) * 4; f32x4 v = *(const f32x4*)(a.w_s + (size_t)g * 16384 + i * 128 + j4);
        if ((j4 >> 6) > (i >> 6)) v = (f32x4){0.f, 0.f, 0.f, 0.f};
        u32x2 w; w.x = cvtpk_s(v[0], v[1]); w.y = cvtpk_s(v[2], v[3]);
        *(LAS u32x2*)(Ws + i * 256 + (((j4 >> 3) ^ (i & 7)) << 4) + (j4 & 4) * 2) = w; }
    for (int item = blockIdx.x; item < 1024; item += gridDim.x) {
        const int nb = item >> 2; const size_t row0 = (size_t)nb * 128; const int colg = g * 512;
        __syncthreads();
#pragma unroll 4
        for (int rr = 0; rr < 16; ++rr) { const int i = wave * 16 + rr; const size_t off = (row0 + i) * DM + colg + lane * 8;
            const u32x4 zw = *(const u32x4*)(Zb + off), ow = *(const u32x4*)(Ob + off);
            float z[8] = {bflo(zw.x), bfhi(zw.x), bflo(zw.y), bfhi(zw.y), bflo(zw.z), bfhi(zw.z), bflo(zw.w), bfhi(zw.w)};
            const float o[8] = {bflo(ow.x), bfhi(ow.x), bflo(ow.y), bfhi(ow.y), bflo(ow.z), bfhi(ow.z), bflo(ow.w), bfhi(ow.w)};
            float s = 0.f, so = 0.f;
#pragma unroll
            for (int e = 0; e < 8; ++e) { s += z[e]; so += o[e] * o[e]; }
            const float mean = wave_sum(s) * (1.f / 512.f); so = wave_sum(so); float s2 = 0.f;
#pragma unroll
            for (int e = 0; e < 8; ++e) { const float dd = z[e] - mean; s2 += dd * dd; }
            s2 = wave_sum(s2);
            if (lane == 0) { MU[i] = mean; RS[i] = 1.f / sqrtf(s2 * (1.f / 512.f) + LN_EPS); RO[i] = 1.f / sqrtf(so * (1.f / 512.f) + LN_EPS); } }
        __syncthreads();
        for (int cc = 0; cc < 4; ++cc) {
            const int colc = colg + cc * 128;
            u32x4 uw4[4], ow4[4], gw4[4];
#pragma unroll
            for (int k = 0; k < 4; ++k) { const int p = tid + 512 * k, i = p >> 4, c8 = (p & 15) * 8; const size_t off = (row0 + i) * DM + colc + c8;
                uw4[k] = *(const u32x4*)(Ub + off); ow4[k] = *(const u32x4*)(Ob + off); gw4[k] = *(const u32x4*)(OGb + off); }
            { const int c8 = (tid & 15) * 8;
              const f32x4 g0 = *(const f32x4*)(a.gm_g + colc + c8), g1 = *(const f32x4*)(a.gm_g + colc + c8 + 4), b0 = *(const f32x4*)(a.gm_b + colc + c8), b1 = *(const f32x4*)(a.gm_b + colc + c8 + 4);
#pragma unroll
              for (int i = 0; i < 2; ++i) { const int p = tid + 512 * i, j = (p >> 4) * 2;
                const u32x4 zw = *(const u32x4*)(Zb + (row0 + j) * DM + colc + c8), zx = *(const u32x4*)(Zb + (row0 + j + 1) * DM + colc + c8);
                const float z[8] = {bflo(zw.x), bfhi(zw.x), bflo(zw.y), bfhi(zw.y), bflo(zw.z), bfhi(zw.z), bflo(zw.w), bfhi(zw.w)};
                const float y[8] = {bflo(zx.x), bfhi(zx.x), bflo(zx.y), bfhi(zx.y), bflo(zx.z), bfhi(zx.z), bflo(zx.w), bfhi(zx.w)};
                const float mu0 = MU[j], rs0 = RS[j], mu1 = MU[j + 1], rs1 = RS[j + 1];
#pragma unroll
                for (int e = 0; e < 8; ++e) { const float gg = e < 4 ? g0[e & 3] : g1[e & 3], bb = e < 4 ? b0[e & 3] : b1[e & 3];
                    const float zn0 = (z[e] - mu0) * rs0 * gg + bb, zn1 = (y[e] - mu1) * rs1 * gg + bb;
                    const int c = c8 + e;
                    *(LAS unsigned*)(ZT + c * 256 + (((j >> 3) ^ (c & 7)) << 4) + (j & 7) * 2) = cvtpk_s(zn0, zn1); } } }
            __syncthreads();
            {
                const int c = 16 * wave + l15; bf16x8 zf[4];
#pragma unroll
                for (int ks = 0; ks < 4; ++ks) zf[ks] = *(const LAS bf16x8*)(ZT + c * 256 + (((4 * ks + q) ^ (c & 7)) << 4));
#pragma unroll
                for (int it = 0; it < 8; ++it) { const int i = 16 * it + l15; f32x4 acc = (f32x4){0.f, 0.f, 0.f, 0.f};
#pragma unroll
                    for (int ks = 0; ks < 4; ++ks) { if (it < 4 && ks >= 2) continue;
                        const bf16x8 wf = *(const LAS bf16x8*)(Ws + i * 256 + (((4 * ks + q) ^ (i & 7)) << 4));
                        acc = __builtin_amdgcn_mfma_f32_16x16x32_bf16(wf, zf[ks], acc, 0, 0, 0); }
#pragma unroll
                    for (int r = 0; r < 4; ++r) SG[(16 * it + 4 * q + r) * 132 + c] = acc[r]; }
            }
            __syncthreads();
#pragma unroll
            for (int k = 0; k < 4; ++k) { const int p = tid + 512 * k, i = p >> 4, c8 = (p & 15) * 8; const size_t off = (row0 + i) * DM + colc + c8;
                const u32x4 uw = uw4[k], ow = ow4[k], gw = gw4[k];
                const f32x4 s0 = *(const LAS f32x4*)(SG + i * 132 + c8), s1 = *(const LAS f32x4*)(SG + i * 132 + c8 + 4);
                const f32x4 n0 = *(const f32x4*)(a.gla_g + colc + c8), n1 = *(const f32x4*)(a.gla_g + colc + c8 + 4);
                const float bs = a.b_s[g * 128 + i], ro = RO[i];
                const unsigned uu[4] = {uw.x, uw.y, uw.z, uw.w}, oo[4] = {ow.x, ow.y, ow.z, ow.w}, gg[4] = {gw.x, gw.y, gw.z, gw.w};
                float m[8];
#pragma unroll
                for (int e = 0; e < 8; ++e) { const int wi = e >> 1; const bool hi = e & 1;
                    const float uv = hi ? bfhi(uu[wi]) : bflo(uu[wi]), ov = hi ? bfhi(oo[wi]) : bflo(oo[wi]), gv = hi ? bfhi(gg[wi]) : bflo(gg[wi]);
                    const float sg = (e < 4 ? s0[e & 3] : s1[e & 3]) + bs, ng = e < 4 ? n0[e & 3] : n1[e & 3];
                    m[e] = gv * (ov * ro * ng) + uv * sg; }
                u32x4 w; w.x = cvtpk_s(m[0], m[1]); w.y = cvtpk_s(m[2], m[3]); w.z = cvtpk_s(m[4], m[5]); w.w = cvtpk_s(m[6], m[7]);
                *(u32x4*)(Ub + off) = w; }
        }
    }
    __syncthreads();
}

typedef __attribute__((address_space(1))) unsigned gu32;
#define XB_TMO      128
#define XB_XCNT(j)  (256  + 64 * (j))
#define XB_XSUB(j)  (1280 + 64 * (j))
#define XB_XGEN(j)  (2304 + 64 * (j))
#define XB_TOP      3328
#define XB_TOPGEN   3392
#define XCD_BAR_WORDS 3456
#define XB_SPIN_CAP (1u << 18)

__device__ __forceinline__ unsigned xb_ld(unsigned* p)              { return __hip_atomic_load(p, __ATOMIC_RELAXED, __HIP_MEMORY_SCOPE_AGENT); }
__device__ __forceinline__ unsigned xb_add(unsigned* p, unsigned v) { return __hip_atomic_fetch_add(p, v, __ATOMIC_RELAXED, __HIP_MEMORY_SCOPE_AGENT); }
__device__ __forceinline__ unsigned xb_xcc_id() { return (unsigned)__builtin_amdgcn_s_getreg((3 << 11) | 20) & 0xFu; }
#define XB_SPIN(cond, bar) do { unsigned _sp = 0; while (cond) { __builtin_amdgcn_s_sleep(1); \
    if ((++_sp & 255u) == 0u) { if (xb_ld(&(bar)[XB_TMO])) break; if (_sp > XB_SPIN_CAP) { atomicAdd(&(bar)[XB_TMO], 1u); break; } } } } while (0)

struct XcdBarrier {
    unsigned* bar; unsigned x;
    volatile LAS unsigned* st;
};

__device__ __forceinline__ XcdBarrier xcd_barrier_post(unsigned* bar, volatile LAS unsigned* st) {
    XcdBarrier b; b.bar = bar; b.x = xb_xcc_id(); b.st = st;
    if (threadIdx.x == 0) (void)xb_add(&bar[XB_XCNT(b.x)], 1u);
    return b;
}
__device__ __forceinline__ void xcd_barrier_complete(unsigned* bar, unsigned x, unsigned& nloc, unsigned& nx) {
    const unsigned G = gridDim.x * gridDim.y * gridDim.z;
    unsigned sum, cnt, mine, sp = 0u;
    for (;;) {
        sum = 0u; cnt = 0u; mine = 0u;
#pragma unroll
        for (unsigned j = 0; j < 16; ++j) { const unsigned c = xb_ld(&bar[XB_XCNT(j)]); sum += c; cnt += (c > 0u) ? 1u : 0u; mine = (j == x) ? c : mine; }
        if (sum == G) break;
        __builtin_amdgcn_s_sleep(1);
        if ((++sp & 255u) == 0u) { if (xb_ld(&bar[XB_TMO])) break; if (sp > XB_SPIN_CAP) { atomicAdd(&bar[XB_TMO], 1u); break; } }
    }
    nloc = mine > 0u ? mine : 1u; nx = cnt > 0u ? cnt : 1u;
}

__device__ __forceinline__ void xcd_barrier(const XcdBarrier& b) {
    asm volatile("s_waitcnt vmcnt(0)" ::: "memory");
    __syncthreads();
    if (threadIdx.x == 0) {
        unsigned* bar = b.bar;
        __builtin_amdgcn_s_waitcnt(0);
        unsigned nloc = b.st[0], nx = b.st[1];
        if (nloc == 0u) { xcd_barrier_complete(bar, b.x, nloc, nx); b.st[0] = nloc; b.st[1] = nx; }
        const unsigned old = xb_add(&bar[XB_XSUB(b.x)], 1u);
        const unsigned gen = old / nloc;
        if (old + 1u == (gen + 1u) * nloc) {
            __builtin_amdgcn_fence(__ATOMIC_RELEASE, "agent");
            asm volatile("s_waitcnt vmcnt(0)" ::: "memory");
            const unsigned og = xb_add(&bar[XB_TOP], 1u);
            const unsigned tg = og / nx;
            if (og + 1u == (tg + 1u) * nx) xb_add(&bar[XB_TOPGEN], 1u);
            else XB_SPIN(xb_ld(&bar[XB_TOPGEN]) == tg, bar);
            __builtin_amdgcn_fence(__ATOMIC_ACQUIRE, "agent");
            xb_add(&bar[XB_XGEN(b.x)], 1u);
            asm volatile("s_waitcnt vmcnt(0)" ::: "memory");
        } else {
            XB_SPIN(xb_ld(&bar[XB_XGEN(b.x)]) == gen, bar);
            __builtin_amdgcn_fence(__ATOMIC_ACQUIRE, "agent");
            asm volatile("s_waitcnt vmcnt(0)" ::: "memory");
        }
    }
    __syncthreads();
}


__global__ void __launch_bounds__(512, 2) mega(Args a) {
    extern __shared__ __attribute__((aligned(16))) unsigned char lds_raw[];
    LAS unsigned char* lds = (LAS unsigned char*)lds_raw;
    const int tid = threadIdx.x, lane = tid & 63, wave = __builtin_amdgcn_readfirstlane(tid >> 6);
    const int G = gridDim.x, gw = blockIdx.x * 8 + wave, ngw = G * 8;
    const int lo = a.ph_lo, hi = a.ph_hi;
    if (tid < 16) ((LAS unsigned*)(lds + LDS_BARW))[tid] = 0u;
    __syncthreads();
    XcdBarrier bar; bar.bar = (unsigned*)(a.ws + OFF_CTL); bar.x = 0; bar.st = nullptr;
    if (a.coop) bar = xcd_barrier_post((unsigned*)(a.ws + OFF_CTL), (volatile LAS unsigned*)(lds + LDS_BARW));
#define IN(k) (lo <= (k) && (k) < hi)
#ifndef PROF_SEC
#define PROF_SEC 0
#endif
#ifndef PROF_WG
#define PROF_WG 0
#endif
    unsigned long long bacc = 0ull;
#define SEAM(k) do { if (IN(k) && IN((k) + 1)) { unsigned long long tb_ = 0ull; if (PROF_SEC == 20 && (k) != 0) tb_ = __builtin_amdgcn_s_memrealtime(); if ((k) == 0) cg::this_grid().sync(); else xcd_barrier(bar); \
        if (PROF_SEC == 20 && (k) != 0) bacc += __builtin_amdgcn_s_memrealtime() - tb_; } } while (0)
    if (IN(0)) { phase_prep(a, lds, gw, ngw, wave, lane); __syncthreads(); }
    SEAM(0);
    if (IN(1)) { { pg8::Gemm gm{(const bf16_t*)(a.ws + OFF_H0), (const bf16_t*)(a.ws + OFF_W1T), MTOK, 14336, DM}; pg8::StaticOrder S; S.init(MTOK, 14336, G, (int)blockIdx.x);
          Epi1 E{a.ws, a.out, a.b_in};
          pg8::gemm_phase<Epi1, pg8::StaticOrder, true, true>(lds, gm, S, E); }
        { pg8::Gemm gm{(const bf16_t*)(a.ws + OFF_H0), (const bf16_t*)(a.ws + OFF_W1T) + (size_t)14336 * DM, MTOK, 512, 1024, DM, (size_t)2048, (size_t)2048}; pg8::StaticOrder S; S.init(MTOK, 512, G, (int)blockIdx.x);
          EpiFg E{(float*)(a.ws + OFF_FG), (float*)(a.ws + OFF_FG2)};
          pg8::gemm_phase<EpiFg, pg8::StaticOrder, true, true>(lds, gm, S, E); } }
    SEAM(1);
    if (IN(2)) phase_kt(a, lds, tid);
    SEAM(2);
    if (IN(3)) { if (blockIdx.x < 128) phase_scan(a, lds, tid, wave, lane); else { phase_prep2(a, lds, (blockIdx.x - 128) * 8 + wave, (G - 128) * 8, wave, lane); __syncthreads(); } }
    SEAM(3);
    if (IN(4)) phase_merge(a, lds, tid, wave, lane);
    SEAM(4);
    if (IN(5)) { pg8::Gemm gm{(const bf16_t*)(a.ws + OFF_U), (const bf16_t*)(a.ws + OFF_WOT), MTOK, DM, DM}; pg8::StaticOrder S; S.init(MTOK, DM, G, (int)blockIdx.x);
        EpiRes<false> E{(bf16_t*)(a.ws + OFF_H1PRE), (const bf16_t*)(a.ws + OFF_H0), nullptr};
        pg8::gemm_phase<EpiRes<false>, pg8::StaticOrder, true, true>(lds, gm, S, E); }
    SEAM(5);
    if (IN(6)) { const bf16_t* src = (const bf16_t*)(a.ws + OFF_H1PRE); bf16_t* H1 = (bf16_t*)(a.ws + OFF_H1);
        ln_stream<true, true>(src, H1, a.ln1_g, a.ln1_b, gw, ngw, lane); }
    SEAM(6);
    if (IN(7)) { phase_pconv(a, gw, ngw, lane);
        pg8::Gemm gm{(const bf16_t*)(a.ws + OFF_H1), (const bf16_t*)(a.out + DO_WGUT), MTOK, NGU, DM}; pg8::StaticOrder S; S.init(MTOK, NGU, G, (int)blockIdx.x);
        Epi5 E{(bf16_t*)(a.ws + OFF_ACT), (bf16_t*)(a.ws + OFF_GPG), a.b_pg};
        pg8::gemm_phase<Epi5, pg8::StaticOrder, true, true>(lds, gm, S, E); }
    SEAM(7);
    if (IN(9)) { pg8::Gemm gm{(const bf16_t*)(a.ws + OFF_ACT), (const bf16_t*)(a.out + DO_WDT), MTOK, DM, KX}; pg8::StaticOrder S; S.init(MTOK, DM, G, (int)blockIdx.x);
        EpiDown E{(bf16_t*)(a.ws + OFF_OUTPRE), (const bf16_t*)(a.ws + OFF_H1), (const bf16_t*)(a.ws + OFF_GPG)};
        pg8::gemm_phase<EpiDown, pg8::StaticOrder, true, true>(lds, gm, S, E); }
    SEAM(9);
    if (IN(10)) { const bf16_t* src = (const bf16_t*)(a.ws + OFF_OUTPRE); float* o = (float*)a.out;
        ln_stream<false, true>(src, o, a.ln2_g, a.ln2_b, gw, ngw, lane);
        if (PROF_SEC == 20) { __syncthreads(); if (blockIdx.x == PROF_WG && wave == 0) { const float d = (float)bacc * 0.01f * 5e-4f;
#pragma unroll 1
                for (int k = 0; k < 16; ++k) if (lane == 0) o[(size_t)(gw + k * ngw) * DM] += (k & 1) ? -d : d; } } }
    if (IN(11)) {
        float* o = (float*)a.out;
        if (a.pad == 0) { const bf16_t* src = (const bf16_t*)(a.ws + (size_t)a.coop * MiB);
            for (size_t i = (size_t)blockIdx.x * 512 + tid; i < (size_t)MTOK * DM; i += (size_t)G * 512) o[i] = __uint_as_float(((unsigned)src[i]) << 16); }
        else { const float* src = (const float*)(a.ws + (size_t)a.coop * MiB);
            for (size_t i = (size_t)blockIdx.x * 512 + tid; i < (size_t)MTOK * DM; i += (size_t)G * 512) o[i] = src[i]; }
    }
#undef IN
#undef SEAM
}

#ifndef N_LAUNCH_MODE
#define N_LAUNCH_MODE 1
#endif
extern "C" void kernel_launch(void* const* d_in, const int* in_sizes, int n_in, void* d_out, int out_size, void* d_ws, size_t ws_size, hipStream_t stream) {
    static int grid = 0;
    if (grid == 0) {
        if (n_in != 23 || out_size != MTOK * DM || ws_size < WS_NEED) { fprintf(stderr, "kernel_launch: unexpected shapes (n_in %d out %d ws %zu)\n", n_in, out_size, ws_size); grid = -1; return; }
        int dev = 0, cus = 0, per_cu = 0;
        hipGetDevice(&dev); hipDeviceGetAttribute(&cus, hipDeviceAttributeMultiprocessorCount, dev);
        if (hipFuncSetAttribute((const void*)mega, hipFuncAttributeMaxDynamicSharedMemorySize, LDS_BYTES) != hipSuccess) { fprintf(stderr, "kernel_launch: hipFuncSetAttribute failed\n"); grid = -1; return; }
        hipOccupancyMaxActiveBlocksPerMultiprocessor(&per_cu, (const void*)mega, 512, LDS_BYTES);
        (void)hipGetLastError();
        if (cus != 256 || per_cu < 1) { fprintf(stderr, "kernel_launch: needs 256 CUs with one resident block each (cus %d per_cu %d)\n", cus, per_cu); grid = -1; return; }
        grid = 256;
    }
    if (grid < 0) return;
    Args a{};
    const float** f = (const float**)&a;
    for (int i = 0; i < 23; ++i) f[i] = (const float*)d_in[i];
    a.out = (unsigned char*)d_out; a.ws = (unsigned char*)d_ws;
#if N_LAUNCH_MODE == 1
    a.ph_lo = 0; a.ph_hi = 11; a.coop = 1;
    if (hipMemsetAsync((char*)d_ws + OFF_CTL, 0, 65536, stream) != hipSuccess) { fprintf(stderr, "kernel_launch: memset failed\n"); return; }
    void* args[] = {&a};
    hipError_t e = hipLaunchCooperativeKernel((const void*)mega, dim3(grid), dim3(512), args, LDS_BYTES, stream);
    if (e != hipSuccess) fprintf(stderr, "cooperative launch failed: %s\n", hipGetErrorString(e));
#else
#ifndef DBG_STOP
#define DBG_STOP 10
#endif
#ifndef DBG_OFF_MIB
#define DBG_OFF_MIB 321
#endif
#ifndef DBG_F32
#define DBG_F32 0
#endif
#ifndef PROG
#define PROG {0, 1, 2, 3, 4, 5, 6, 7, 8, 9, 10}
#endif
    static const int prog[] = PROG;
    for (int pi = 0; pi < (int)(sizeof(prog) / sizeof(prog[0])); ++pi) { const int ph = prog[pi]; if (ph > DBG_STOP) break; a.ph_lo = ph; a.ph_hi = ph + 1; a.coop = 0;
        hipLaunchKernelGGL(mega, dim3(grid), dim3(512), LDS_BYTES, stream, a); }
    if (DBG_STOP < 10) { a.ph_lo = 11; a.ph_hi = 12; a.coop = DBG_OFF_MIB; a.pad = DBG_F32;
        hipLaunchKernelGGL(mega, dim3(grid), dim3(512), LDS_BYTES, stream, a); }
#endif
}
```

```cpp
#include <hip/hip_runtime.h>
#include <hip/hip_cooperative_groups.h>
#include <cstdio>
#include <cstdint>
#include <type_traits>
namespace cg = cooperative_groups;
namespace pg8 {
#define PG8_LAS __attribute__((address_space(3)))
typedef unsigned short bf16_t;
typedef short bf16x8 __attribute__((ext_vector_type(8)));
typedef float f32x4 __attribute__((ext_vector_type(4)));
typedef unsigned u32x4 __attribute__((ext_vector_type(4)));
constexpr int BM = 256, BK = 64, HALF = 128, HTB = HALF * BK * 2  , STAGE_BYTES = 8 * HTB, NXCD = 8, WGM = 8;

__host__ __device__ __forceinline__ int lds_byte(int r, int c) { const int st = (r >> 4) * 2 + (c >> 5), rr = r & 15, cc = c & 31, ob = rr * 64 + cc * 2; return st * 1024 + (ob ^ (((ob >> 9) & 1) << 5)); }
__host__ __device__ __forceinline__ void stage_rc(int b, int& R, int& C) { const int st = b / 1024, sb = b % 1024, swz = sb ^ (((sb >> 9) & 1) << 5); R = (st >> 1) * 16 + swz / 64; C = (st & 1) * 32 + (swz % 64) / 2; }
__host__ __device__ __forceinline__ int perm32(int rho) { const int n = rho >> 4, i = rho & 15; return 8 * (i >> 2) + 4 * n + (i & 3); }

struct Unit { int pm, pn; };
struct Gemm { const bf16_t* A; const bf16_t* Bt; int M, N, K; int ld = 0; size_t a_pn = 0; size_t b_pn = ~(size_t)0; };

struct StaticOrder {
    int nM, nN, nwg, G, c;
    __host__ __device__ void init(int M, int N, int G_, int c_) { nM = M / BM; nN = N / BM; nwg = nM * nN; G = G_; c = c_; }
    __host__ __device__ bool next(int i, Unit& u) const {
        const long L = (long)i * G + c; if (L >= nwg) return false;
        int wgid = (int)L; { const int q = nwg / NXCD, r = nwg % NXCD, xcd = wgid % NXCD, off = wgid / NXCD; wgid = (xcd < r ? xcd * (q + 1) : r * (q + 1) + (xcd - r) * q) + off; }
        const int nig = WGM * nN, gid = wgid / nig, fm = gid * WGM, gsz = (nM - fm) < WGM ? (nM - fm) : WGM;
        u.pm = fm + ((wgid % nig) % gsz); u.pn = (wgid % nig) / gsz; return true;
    }
    __device__ __forceinline__ void a_ready(const Unit&) const {}
    __device__ __forceinline__ void done(const Unit&) const {}
};
__device__ __forceinline__ unsigned cvt_pk_bf16(float lo, float hi) { unsigned r; asm volatile("v_cvt_pk_bf16_f32 %0, %1, %2" : "=v"(r) : "v"(lo), "v"(hi)); return r; }
typedef float f32x2 __attribute__((ext_vector_type(2)));
__device__ __forceinline__ f32x2 gelu_pk(f32x2 v) {
    const f32x2 av = __builtin_elementwise_abs(v), d = av * 0.2316418882f + 1.0f;
    f32x2 t; t.x = __builtin_amdgcn_rcpf(d.x); t.y = __builtin_amdgcn_rcpf(d.y);
    f32x2 q = t * 0.5307027145f + (-0.7265760135f); q = q * t + 0.7107068705f; q = q * t + (-0.142248368f); q = q * t + 0.127414796f; q = q * t;
    const f32x2 s = (v * v) * (-0.72134752044f);
    f32x2 e; e.x = __builtin_amdgcn_exp2f(s.x); e.y = __builtin_amdgcn_exp2f(s.y);
    const f32x2 m = v * (q * e), r = v - m;
    f32x2 o; o.x = v.x < 0.f ? m.x : r.x; o.y = v.y < 0.f ? m.y : r.y; return o;
}

template <class Epi, class Sched, bool ALIGN_EPI = false, bool SP2 = false>
__device__ __forceinline__ void gemm_phase(PG8_LAS unsigned char* lds, const Gemm g, const Sched& S, const Epi& E) {
    const int tid = threadIdx.x, wid = __builtin_amdgcn_readfirstlane(tid >> 6), lane = tid & 63, wr = wid >> 2, wc = wid & 3, fr = lane & 15, fq = lane >> 4;
    const int nt = g.K / BK, K = g.ld ? g.ld : g.K;
    unsigned voffA[2], voffB[2];
#pragma unroll
    for (int i = 0; i < 2; ++i) { int R, C; stage_rc(tid * 16 + i * 8192, R, C); const int Rb = Epi::PERM ? ((R & ~31) + perm32(R & 31)) : R;
        voffA[i] = (unsigned)(R * K + C) * 2u; voffB[i] = (unsigned)(Rb * K + C) * 2u; }
    const size_t kstep = (size_t)(BK * 2);
    const size_t hstep = (size_t)HALF * K * 2;
    const size_t tstep = 2 * hstep;
    const unsigned ldsw = (unsigned)wid * 1024u;
    const int aoff = lds_byte(wr * 64 + fr, fq * 8), boff = lds_byte(wc * 32 + fr, fq * 8);
#define PG8_SA(b, h) (((b) * 2 + (h)) * HTB)
#define PG8_SB(b, h) ((4 + (b) * 2 + (h)) * HTB)
#define PG8_STAGE(bufoff, gbase, voff) do { _Pragma("unroll") for (int _i = 0; _i < 2; ++_i) \
        __builtin_amdgcn_global_load_lds((const unsigned*)((const char*)(gbase) + (voff)[_i]), (PG8_LAS unsigned*)(lds + (bufoff) + ldsw + _i * 8192), 16, 0, 0); } while (0)
#define PG8_LDA(dst, b, h) do { _Pragma("unroll") for (int m = 0; m < 4; ++m) _Pragma("unroll") for (int k = 0; k < 2; ++k) dst[m][k] = *(const PG8_LAS bf16x8*)(lds + PG8_SA(b, h) + aoff + m * 2048 + k * 1024); } while (0)
#define PG8_LDB(dst, b, h) do { _Pragma("unroll") for (int n = 0; n < 2; ++n) _Pragma("unroll") for (int k = 0; k < 2; ++k) dst[n][k] = *(const PG8_LAS bf16x8*)(lds + PG8_SB(b, h) + boff + n * 2048 + k * 1024); } while (0)
#define PG8_MMA(ai, bj, At, Bt) do { __builtin_amdgcn_s_setprio(1); _Pragma("unroll") for (int m = 0; m < 4; ++m) _Pragma("unroll") for (int n = 0; n < 2; ++n) _Pragma("unroll") for (int k = 0; k < 2; ++k) \
        acc[ai][bj][m][n] = __builtin_amdgcn_mfma_f32_16x16x32_bf16(Bt[n][k], At[m][k], acc[ai][bj][m][n], 0, 0, 0); __builtin_amdgcn_s_setprio(0); } while (0)
#define PG8_WAIT_V(n) asm volatile("s_waitcnt vmcnt(" #n ")" ::: "memory")
#define PG8_WAIT_L(n) asm volatile("s_waitcnt lgkmcnt(" #n ")" ::: "memory")
#define PG8_BAR __builtin_amdgcn_s_barrier()
#define PG8_SCHED __builtin_amdgcn_sched_barrier(0)
    Unit cur, nxt; int ui = 0;
    if (!S.next(0, cur)) return;
    f32x4 acc[2][2][4][2];
#pragma unroll
    for (int a = 0; a < 2; ++a)
#pragma unroll
        for (int b = 0; b < 2; ++b)
#pragma unroll
            for (int m = 0; m < 4; ++m)
#pragma unroll
                for (int n = 0; n < 2; ++n) acc[a][b][m][n] = (f32x4){0.f, 0.f, 0.f, 0.f};
    bf16x8 At[4][2], B0[2][2], B1[2][2];
    const size_t bpn = g.b_pn == ~(size_t)0 ? tstep : g.b_pn;
    const char* cA = (const char*)g.A + (size_t)cur.pm * tstep + (size_t)cur.pn * g.a_pn; const char* cB = (const char*)g.Bt + (size_t)cur.pn * bpn;
    S.a_ready(cur);
    if constexpr (SP2) {
        PG8_STAGE(PG8_SB(0, 0), cB, voffB); PG8_STAGE(PG8_SB(0, 1), cB + hstep, voffB); PG8_STAGE(PG8_SA(0, 0), cA, voffA); PG8_STAGE(PG8_SA(0, 1), cA + hstep, voffA);
        if (wr == 1) PG8_BAR;
        PG8_WAIT_V(2); PG8_BAR;
        PG8_STAGE(PG8_SB(1, 0), cB + kstep, voffB); PG8_STAGE(PG8_SA(1, 0), cA + kstep, voffA); PG8_STAGE(PG8_SB(1, 1), cB + hstep + kstep, voffB);
        PG8_WAIT_V(6); PG8_BAR;
    } else {
        PG8_STAGE(PG8_SB(0, 0), cB, voffB); PG8_STAGE(PG8_SA(0, 0), cA, voffA); PG8_STAGE(PG8_SB(0, 1), cB + hstep, voffB); PG8_STAGE(PG8_SA(0, 1), cA + hstep, voffA);
        if (wr == 1) PG8_BAR;
        PG8_WAIT_V(4); PG8_BAR;
        PG8_STAGE(PG8_SB(1, 0), cB + kstep, voffB); PG8_STAGE(PG8_SA(1, 0), cA + kstep, voffA); PG8_STAGE(PG8_SB(1, 1), cB + hstep + kstep, voffB);
        PG8_WAIT_V(6); PG8_BAR;
    }
    for (;;) {
        const bool has_next = S.next(ui + 1, nxt);
        const char* nA = has_next ? (const char*)g.A + (size_t)nxt.pm * tstep + (size_t)nxt.pn * g.a_pn : cA; const char* nB = has_next ? (const char*)g.Bt + (size_t)nxt.pn * bpn : cB;
        for (int t = 0; t < nt; t += 2) {
            const bool last = (t == nt - 2);
            const char* a1 = cA + (size_t)(t + 1) * kstep;
            const char* a2 = last ? nA : cA + (size_t)(t + 2) * kstep; const char* b2 = last ? nB : cB + (size_t)(t + 2) * kstep;
            const char* a3 = a2 + kstep; const char* b3 = b2 + kstep;
            if (last && has_next) S.a_ready(nxt);
            if constexpr (Epi::HOOK_T > 0) { if (t == Epi::HOOK_T) E.hook(acc, cur, wr, wc, fr, fq); }
            if constexpr (SP2) {
            PG8_LDB(B0, 0, 0); PG8_LDB(B1, 0, 1); PG8_SCHED; PG8_LDA(At, 0, 0); PG8_STAGE(PG8_SA(1, 1), a1 + hstep, voffA);
            PG8_WAIT_V(8); PG8_WAIT_L(0); PG8_BAR; PG8_MMA(0, 0, At, B0); PG8_MMA(0, 1, At, B1); PG8_BAR; PG8_SCHED;
            PG8_LDA(At, 0, 1); PG8_STAGE(PG8_SB(0, 0), b2, voffB); PG8_STAGE(PG8_SB(0, 1), b2 + hstep, voffB); PG8_STAGE(PG8_SA(0, 0), a2, voffA);
            PG8_WAIT_V(8); PG8_WAIT_L(0); PG8_BAR; PG8_MMA(1, 0, At, B0); PG8_MMA(1, 1, At, B1); PG8_BAR; PG8_SCHED;
            PG8_LDB(B0, 1, 0); PG8_LDB(B1, 1, 1); PG8_SCHED; PG8_LDA(At, 1, 0); PG8_STAGE(PG8_SA(0, 1), a2 + hstep, voffA);
            PG8_WAIT_V(8); PG8_WAIT_L(0); PG8_BAR; PG8_MMA(0, 0, At, B0); PG8_MMA(0, 1, At, B1); PG8_BAR; PG8_SCHED;
            PG8_LDA(At, 1, 1); PG8_STAGE(PG8_SB(1, 0), b3, voffB); PG8_STAGE(PG8_SB(1, 1), b3 + hstep, voffB); PG8_STAGE(PG8_SA(1, 0), a3, voffA);
            PG8_WAIT_V(8); PG8_WAIT_L(0); PG8_BAR; PG8_MMA(1, 0, At, B0); PG8_MMA(1, 1, At, B1); PG8_BAR; PG8_SCHED;
            } else {
            PG8_LDB(B0, 0, 0); PG8_SCHED; PG8_LDA(At, 0, 0); PG8_STAGE(PG8_SA(1, 1), a1 + hstep, voffA);
            PG8_WAIT_L(8); PG8_BAR; PG8_WAIT_L(0); PG8_MMA(0, 0, At, B0); PG8_BAR; PG8_SCHED;
            PG8_LDB(B1, 0, 1); PG8_STAGE(PG8_SB(0, 0), b2, voffB);
            PG8_BAR; PG8_WAIT_L(0); PG8_MMA(0, 1, At, B1); PG8_BAR;
            PG8_LDA(At, 0, 1); PG8_STAGE(PG8_SA(0, 0), a2, voffA);
            PG8_BAR; PG8_WAIT_L(0); PG8_MMA(1, 0, At, B0); PG8_BAR; PG8_SCHED;
            PG8_STAGE(PG8_SB(0, 1), b2 + hstep, voffB);
            PG8_WAIT_V(6); PG8_BAR; PG8_MMA(1, 1, At, B1); PG8_BAR;
            PG8_LDB(B0, 1, 0); PG8_SCHED; PG8_LDA(At, 1, 0); PG8_STAGE(PG8_SA(0, 1), a2 + hstep, voffA);
            PG8_WAIT_L(8); PG8_BAR; PG8_WAIT_L(0); PG8_MMA(0, 0, At, B0); PG8_BAR; PG8_SCHED;
            PG8_LDB(B1, 1, 1); PG8_STAGE(PG8_SB(1, 0), b3, voffB);
            PG8_BAR; PG8_WAIT_L(0); PG8_MMA(0, 1, At, B1); PG8_BAR;
            PG8_LDA(At, 1, 1); PG8_STAGE(PG8_SA(1, 0), a3, voffA);
            PG8_BAR; PG8_WAIT_L(0); PG8_MMA(1, 0, At, B0); PG8_BAR; PG8_SCHED;
            PG8_STAGE(PG8_SB(1, 1), b3 + hstep, voffB);
            PG8_WAIT_V(6); PG8_BAR; PG8_MMA(1, 1, At, B1); PG8_BAR;
            }
        }
        if constexpr (ALIGN_EPI) { if (wr == 0) PG8_BAR; }
        if constexpr (!Epi::AFTER_DRAIN) { E(acc, cur, wr, wc, fr, fq); S.done(cur); }
        if (!has_next) break;
#pragma unroll
        for (int a = 0; a < 2; ++a)
#pragma unroll
            for (int b = 0; b < 2; ++b)
#pragma unroll
                for (int m = 0; m < 4; ++m)
#pragma unroll
                    for (int n = 0; n < 2; ++n) acc[a][b][m][n] = (f32x4){0.f, 0.f, 0.f, 0.f};
        cur = nxt; cA = nA; cB = nB; ++ui;
        if constexpr (ALIGN_EPI) { if (wr == 1) PG8_BAR; }
    }
    PG8_WAIT_V(0);
    if constexpr (!ALIGN_EPI) { if (wr == 0) PG8_BAR; }
    PG8_BAR;
    if constexpr (Epi::AFTER_DRAIN) { E.fused(acc, cur, wr, wc, fr, fq, lds, wid, lane); S.done(cur); }
#undef PG8_SA
#undef PG8_SB
#undef PG8_STAGE
#undef PG8_LDA
#undef PG8_LDB
#undef PG8_MMA
#undef PG8_WAIT_V
#undef PG8_WAIT_L
#undef PG8_BAR
#undef PG8_SCHED
}
}

#define LAS __attribute__((address_space(3)))
typedef unsigned short bf16_t;
typedef short bf16x8 __attribute__((ext_vector_type(8)));
typedef float f32x4 __attribute__((ext_vector_type(4)));
typedef unsigned u32x4 __attribute__((ext_vector_type(4)));
typedef unsigned u32x2 __attribute__((ext_vector_type(2)));

constexpr int KX = 5888  , MTOK = 32768, DM = 2048, NCHUNK = 512  , DFF = 5632, N1 = 14592, NGU = 13312;
constexpr float ALPHA = 1.189207115002721f, LN_EPS = 1e-5f;
constexpr size_t MiB = 1u << 20;
constexpr size_t OFF_W1T = 0, OFF_WOT = 57 * MiB, OFF_H0 = 65 * MiB, OFF_Q = 193 * MiB, OFF_K = 257 * MiB, OFF_V = 321 * MiB, OFF_OG = 449 * MiB,
                 OFF_U = 577 * MiB, OFF_Z = 705 * MiB, OFF_GA = 833 * MiB, OFF_FG = 961 * MiB, OFF_CTL = 969 * MiB, OFF_FG2 = 976 * MiB  , WS_NEED = 984 * MiB;
constexpr size_t OFF_H1PRE = OFF_V, OFF_H1 = OFF_Z, OFF_ACT = OFF_Q  , OFF_GPG = OFF_GA, OFF_OUTPRE = 0;
constexpr size_t DO_GB = 0, DO_PLEB = 0, DO_DEC = 128 * MiB, DO_WGUT = 130 * MiB, DO_WDT = 182 * MiB, DO_WPUT = 204 * MiB, DO_PB = 205 * MiB;
constexpr int LDS_BYTES = 153600, LDS_BARW = 153536;

struct Args {
    const float *x, *p, *ln0_g, *ln0_b, *w_in, *b_in, *w_f2, *b_f2, *gla_g, *gm_g, *gm_b, *w_s, *b_s, *w_o, *ln1_g, *ln1_b, *w_gu, *w_down, *w_pg, *b_pg, *w_pu, *ln2_g, *ln2_b;
    unsigned char* out; unsigned char* ws; int ph_lo, ph_hi, coop, pad;
};

typedef float f32x2_t __attribute__((ext_vector_type(2))); typedef __bf16 bf16x2_t __attribute__((ext_vector_type(2)));
__device__ __forceinline__ unsigned cvtpk_s(float lo, float hi) { f32x2_t v = {lo, hi}; bf16x2_t b = __builtin_convertvector(v, bf16x2_t); return __builtin_bit_cast(unsigned, b); }
__device__ __forceinline__ float bflo(unsigned w) { return __uint_as_float(w << 16); }
__device__ __forceinline__ float bfhi(unsigned w) { return __uint_as_float(w & 0xffff0000u); }
__device__ __forceinline__ float sigm(float x) { return __builtin_amdgcn_rcpf(1.f + __expf(-x)); }
#define WS_DPP(x, ctrl, rm) __builtin_bit_cast(float, __builtin_amdgcn_update_dpp(0, __builtin_bit_cast(int, (x)), (ctrl), (rm), 0xf, false))
__device__ __forceinline__ float wave_sum(float v) {
    v += WS_DPP(v, 0xb1, 0xf); v += WS_DPP(v, 0x4e, 0xf); v += WS_DPP(v, 0x124, 0xf); v += WS_DPP(v, 0x128, 0xf); v += WS_DPP(v, 0x142, 0xa); v += WS_DPP(v, 0x143, 0xc);
    return __builtin_bit_cast(float, __builtin_amdgcn_readlane(__builtin_bit_cast(int, v), 63));
}
#define LDS_WAIT() asm volatile("s_waitcnt lgkmcnt(0)" ::: "memory")

using pg8::Unit;
using pg8::gelu_pk;
typedef float f32x2 __attribute__((ext_vector_type(2)));

__device__ __forceinline__ void act8(f32x4& v0, f32x4& v1, int mode) {
    if (mode == 0) { v0 = v0 * 0.0625f; v1 = v1 * 0.0625f; }
    else if (mode == 2) {
#pragma unroll
        for (int j = 0; j < 4; ++j) { v0[j] = v0[j] * sigm(v0[j]); v1[j] = v1[j] * sigm(v1[j]); } }
    else if (mode == 3) { f32x2 a = gelu_pk((f32x2){v0[0], v0[1]}), b = gelu_pk((f32x2){v0[2], v0[3]}), c = gelu_pk((f32x2){v1[0], v1[1]}), d = gelu_pk((f32x2){v1[2], v1[3]});
        v0 = (f32x4){a.x, a.y, b.x, b.y}; v1 = (f32x4){c.x, c.y, d.x, d.y}; }
    else if (mode == 4) {
#pragma unroll
        for (int j = 0; j < 4; ++j) { v0[j] = sigm(v0[j]); v1[j] = sigm(v1[j]); } }
}

struct Epi1 {
    static constexpr bool PERM = true, AFTER_DRAIN = false; static constexpr int HOOK_T = 0;
    unsigned char* ws; unsigned char* dout; const float* b_in;
    __device__ __forceinline__ void operator()(const f32x4 (&acc)[2][2][4][2], const Unit& u, int wr, int wc, int fr, int fq) const {
        const int pn = u.pn; const int row0 = u.pm * 256 + wr * 64 + fr;
        if (pn == 56) {
            if (wc < 2) {
                float* FG = (float*)(ws + OFF_FG); const int c0 = wc * 32 + 8 * fq;
                const f32x4 b0 = *(const f32x4*)(b_in + 6144 + c0), b1 = *(const f32x4*)(b_in + 6144 + c0 + 4);
#pragma unroll
                for (int ai = 0; ai < 2; ++ai)
#pragma unroll
                    for (int m = 0; m < 4; ++m) { float* rp = FG + (size_t)(row0 + ai * 128 + m * 16) * 64 + c0;
                        *(f32x4*)rp = acc[ai][0][m][0] + b0; *(f32x4*)(rp + 4) = acc[ai][0][m][1] + b1; }
            }
            return;
        }
        const int cw = wc * 32 + 8 * fq;
        if (pn >= 16 && pn < 48) {
            const bool first = pn < 32; const int t = first ? pn - 16 : pn - 32;
            const float* bA = b_in + (first ? 4096 : 6208) + 128 * t + cw; const float* bB = b_in + (first ? 10304 : 12352) + 128 * t + cw;
            const f32x4 a0 = *(const f32x4*)bA, a1 = *(const f32x4*)(bA + 4), g0 = *(const f32x4*)bB, g1 = *(const f32x4*)(bB + 4);
            bf16_t* rowp0 = (bf16_t*)(ws + (first ? OFF_OG : OFF_U)) + (size_t)row0 * 2048 + 128 * t + cw;
            if (first) pair_body<2>(acc, a0, a1, g0, g1, rowp0); else pair_body<3>(acc, a0, a1, g0, g1, rowp0);
            return;
        }
        int mode, ldc, colt, bsrc; bf16_t* base;
        if (pn < 4) { mode = 0; base = (bf16_t*)(ws + OFF_Q); ldc = 1024; colt = pn * 256; bsrc = pn * 256; }
        else if (pn < 8) { mode = 1; base = (bf16_t*)(ws + OFF_K); ldc = 1024; colt = (pn - 4) * 256; bsrc = pn * 256; }
        else if (pn < 16) { mode = 1; base = (bf16_t*)(ws + OFF_V); ldc = 2048; colt = (pn - 8) * 256; bsrc = pn * 256; }
        else { mode = 3; base = (bf16_t*)(ws + OFF_Z); ldc = 2048; colt = (pn - 48) * 256; bsrc = 8256 + (pn - 48) * 256; }
        f32x4 bv[2][2];
#pragma unroll
        for (int bj = 0; bj < 2; ++bj)
#pragma unroll
            for (int n = 0; n < 2; ++n) bv[bj][n] = *(const f32x4*)(b_in + bsrc + bj * 128 + (mode == 0 ? wc * 32 + 4 * fq + 16 * n : cw + 4 * n));
        bf16_t* rowp0 = base + (size_t)row0 * ldc + colt + cw;
        switch (mode) {
            case 0: body<0>(acc, bv, rowp0, ldc); break;
            case 1: body<1>(acc, bv, rowp0, ldc); break;
            default: body<3>(acc, bv, rowp0, ldc); break;
        }
    }
    template <int MODE> __device__ __forceinline__ void body(const f32x4 (&acc)[2][2][4][2], const f32x4 (&bv)[2][2], bf16_t* rowp0, int ldc) const {
#pragma unroll
        for (int ai = 0; ai < 2; ++ai)
#pragma unroll
            for (int m = 0; m < 4; ++m) { bf16_t* rowp = rowp0 + (size_t)(ai * 128 + m * 16) * ldc;
#pragma unroll
                for (int bj = 0; bj < 2; ++bj) { f32x4 v0 = acc[ai][bj][m][0] + bv[bj][0], v1 = acc[ai][bj][m][1] + bv[bj][1];
                    act8(v0, v1, MODE);
                    u32x4 w; w.x = cvtpk_s(v0[0], v0[1]); w.y = cvtpk_s(v0[2], v0[3]); w.z = cvtpk_s(v1[0], v1[1]); w.w = cvtpk_s(v1[2], v1[3]);
                    *(u32x4*)(rowp + bj * 128) = w; } }
    }
    template <int MODE> __device__ __forceinline__ void pair_body(const f32x4 (&acc)[2][2][4][2], const f32x4 a0, const f32x4 a1, const f32x4 g0, const f32x4 g1, bf16_t* rowp0) const {
#pragma unroll
        for (int ai = 0; ai < 2; ++ai)
#pragma unroll
            for (int m = 0; m < 4; ++m) { f32x4 v0 = acc[ai][0][m][0] + a0, v1 = acc[ai][0][m][1] + a1, s0 = acc[ai][1][m][0] + g0, s1 = acc[ai][1][m][1] + g1;
                act8(v0, v1, MODE); act8(s0, s1, 4);
                v0 = v0 * s0; v1 = v1 * s1;
                u32x4 w; w.x = cvtpk_s(v0[0], v0[1]); w.y = cvtpk_s(v0[2], v0[3]); w.z = cvtpk_s(v1[0], v1[1]); w.w = cvtpk_s(v1[2], v1[3]);
                *(u32x4*)(rowp0 + (size_t)(ai * 128 + m * 16) * 2048) = w; }
    }
};

struct EpiFg {
    static constexpr bool PERM = true, AFTER_DRAIN = false; static constexpr int HOOK_T = 0;
    float* P0; float* P1;
    __device__ __forceinline__ void operator()(const f32x4 (&acc)[2][2][4][2], const Unit& u, int wr, int wc, int fr, int fq) const {
        if (wc >= 2) return;
        float* FG = u.pn ? P1 : P0; const int row0 = u.pm * 256 + wr * 64 + fr, c0 = wc * 32 + 8 * fq;
#pragma unroll
        for (int ai = 0; ai < 2; ++ai)
#pragma unroll
            for (int m = 0; m < 4; ++m) { float* rp = FG + (size_t)(row0 + ai * 128 + m * 16) * 64 + c0; *(f32x4*)rp = acc[ai][0][m][0]; *(f32x4*)(rp + 4) = acc[ai][0][m][1]; }
    }
};

template <bool HAS_P> struct EpiRes {
    static constexpr bool PERM = true, AFTER_DRAIN = false; static constexpr int HOOK_T = 0;
    bf16_t* out; const bf16_t* R; const bf16_t* P;
    __device__ __forceinline__ void operator()(const f32x4 (&acc)[2][2][4][2], const Unit& u, int wr, int wc, int fr, int fq) const {
        const int row0 = u.pm * 256 + wr * 64 + fr, col0 = u.pn * 256 + wc * 32 + 8 * fq;
#pragma unroll
        for (int ai = 0; ai < 2; ++ai)
#pragma unroll
            for (int mh = 0; mh < 2; ++mh) {
                u32x4 rr[2][2], qq[2][2];
#pragma unroll
                for (int m2 = 0; m2 < 2; ++m2)
#pragma unroll
                    for (int bj = 0; bj < 2; ++bj) { const size_t off = (size_t)(row0 + ai * 128 + (2 * mh + m2) * 16) * DM + col0 + bj * 128;
                        rr[m2][bj] = *(const u32x4*)(R + off); if (HAS_P) qq[m2][bj] = *(const u32x4*)(P + off); }
#pragma unroll
                for (int m2 = 0; m2 < 2; ++m2)
#pragma unroll
                    for (int bj = 0; bj < 2; ++bj) { const int m = 2 * mh + m2; const size_t off = (size_t)(row0 + ai * 128 + m * 16) * DM + col0 + bj * 128; const u32x4 r = rr[m2][bj];
                        f32x4 v0 = acc[ai][bj][m][0], v1 = acc[ai][bj][m][1];
                        v0 += (f32x4){bflo(r.x), bfhi(r.x), bflo(r.y), bfhi(r.y)} * ALPHA; v1 += (f32x4){bflo(r.z), bfhi(r.z), bflo(r.w), bfhi(r.w)} * ALPHA;
                        if (HAS_P) { const u32x4 q = qq[m2][bj];
                            v0 += (f32x4){bflo(q.x), bfhi(q.x), bflo(q.y), bfhi(q.y)}; v1 += (f32x4){bflo(q.z), bfhi(q.z), bflo(q.w), bfhi(q.w)}; }
                        u32x4 w; w.x = cvtpk_s(v0[0], v0[1]); w.y = cvtpk_s(v0[2], v0[3]); w.z = cvtpk_s(v1[0], v1[1]); w.w = cvtpk_s(v1[2], v1[3]);
                        *(u32x4*)(out + off) = w; }
                asm volatile("" ::: "memory");
            }
    }
};

struct EpiDown {
    static constexpr bool PERM = true, AFTER_DRAIN = false; static constexpr int HOOK_T = 4;
    bf16_t* out; const bf16_t* R; const bf16_t* G;
    __device__ __forceinline__ void hook(f32x4 (&acc)[2][2][4][2], const Unit& u, int wr, int wc, int fr, int fq) const {
        unsigned zoff; asm volatile("v_mov_b32 %0, 0" : "=v"(zoff));
        const bf16_t* gp = G + (size_t)(u.pm * 256 + wr * 64 + fr) * DM + u.pn * 256 + wc * 32 + 8 * fq + zoff;
#pragma unroll
        for (int ai = 0; ai < 2; ++ai)
#pragma unroll
            for (int mh = 0; mh < 2; ++mh) {
                u32x4 rr[2][2];
#pragma unroll
                for (int m2 = 0; m2 < 2; ++m2)
#pragma unroll
                    for (int bj = 0; bj < 2; ++bj) rr[m2][bj] = *(const u32x4*)(gp + (size_t)(ai * 128 + (2 * mh + m2) * 16) * DM + bj * 128);
#pragma unroll
                for (int m2 = 0; m2 < 2; ++m2)
#pragma unroll
                    for (int bj = 0; bj < 2; ++bj) { const u32x4 r = rr[m2][bj]; const int m = 2 * mh + m2;
                        acc[ai][bj][m][0] *= (f32x4){bflo(r.x), bfhi(r.x), bflo(r.y), bfhi(r.y)}; acc[ai][bj][m][1] *= (f32x4){bflo(r.z), bfhi(r.z), bflo(r.w), bfhi(r.w)}; }
                asm volatile("" ::: "memory");
            }
    }
    __device__ __forceinline__ void operator()(const f32x4 (&acc)[2][2][4][2], const Unit& u, int wr, int wc, int fr, int fq) const {
        const int row0 = u.pm * 256 + wr * 64 + fr, col0 = u.pn * 256 + wc * 32 + 8 * fq;
#pragma unroll
        for (int ai = 0; ai < 2; ++ai)
#pragma unroll
            for (int m = 0; m < 4; ++m)
#pragma unroll
                for (int bj = 0; bj < 2; ++bj) { const size_t off = (size_t)(row0 + ai * 128 + m * 16) * DM + col0 + bj * 128; const u32x4 r = *(const u32x4*)(R + off);
                    f32x4 v0 = acc[ai][bj][m][0], v1 = acc[ai][bj][m][1];
                    v0 += (f32x4){bflo(r.x), bfhi(r.x), bflo(r.y), bfhi(r.y)} * ALPHA; v1 += (f32x4){bflo(r.z), bfhi(r.z), bflo(r.w), bfhi(r.w)} * ALPHA;
                    u32x4 w; w.x = cvtpk_s(v0[0], v0[1]); w.y = cvtpk_s(v0[2], v0[3]); w.z = cvtpk_s(v1[0], v1[1]); w.w = cvtpk_s(v1[2], v1[3]);
                    *(u32x4*)(out + off) = w; }
    }
};

struct Epi5 {
    static constexpr bool PERM = true, AFTER_DRAIN = false; static constexpr int HOOK_T = 0;
    bf16_t* ACT; bf16_t* GPG; const float* b_pg;
    __device__ __forceinline__ void operator()(const f32x4 (&acc)[2][2][4][2], const Unit& u, int wr, int wc, int fr, int fq) const {
        const int pn = u.pn; const int row0 = u.pm * 256 + wr * 64 + fr, cw = wc * 32 + 8 * fq;
        if (pn < 44) {
#pragma unroll
            for (int ai = 0; ai < 2; ++ai)
#pragma unroll
                for (int m = 0; m < 4; ++m) { bf16_t* rowp = ACT + (size_t)(row0 + ai * 128 + m * 16) * KX + 256 + pn * 128 + cw;
                    f32x4 g0 = acc[ai][0][m][0], g1 = acc[ai][0][m][1]; const f32x4 u0 = acc[ai][1][m][0], u1 = acc[ai][1][m][1];
#pragma unroll
                    for (int j = 0; j < 4; ++j) { g0[j] = g0[j] * sigm(g0[j]) * u0[j]; g1[j] = g1[j] * sigm(g1[j]) * u1[j]; }
                    u32x4 w; w.x = cvtpk_s(g0[0], g0[1]); w.y = cvtpk_s(g0[2], g0[3]); w.z = cvtpk_s(g1[0], g1[1]); w.w = cvtpk_s(g1[2], g1[3]);
                    *(u32x4*)rowp = w; }
        } else {
            const int colt = (pn - 44) * 256;
            f32x4 bv[2][2];
#pragma unroll
            for (int bj = 0; bj < 2; ++bj)
#pragma unroll
                for (int n = 0; n < 2; ++n) bv[bj][n] = *(const f32x4*)(b_pg + colt + bj * 128 + cw + 4 * n);
#pragma unroll
            for (int ai = 0; ai < 2; ++ai)
#pragma unroll
                for (int m = 0; m < 4; ++m) { bf16_t* rowp = GPG + (size_t)(row0 + ai * 128 + m * 16) * DM + colt + cw;
#pragma unroll
                    for (int bj = 0; bj < 2; ++bj) { f32x4 v0 = acc[ai][bj][m][0] + bv[bj][0], v1 = acc[ai][bj][m][1] + bv[bj][1];
                        act8(v0, v1, 4);
                        u32x4 w; w.x = cvtpk_s(v0[0], v0[1]); w.y = cvtpk_s(v0[2], v0[3]); w.z = cvtpk_s(v1[0], v1[1]); w.w = cvtpk_s(v1[2], v1[3]);
                        *(u32x4*)(rowp + bj * 128) = w; } }
        }
    }
};

struct EpiPle {
    static constexpr bool PERM = true, AFTER_DRAIN = false; static constexpr int HOOK_T = 0;
    bf16_t* O; const bf16_t* G;
    __device__ __forceinline__ void operator()(const f32x4 (&acc)[2][2][4][2], const Unit& u, int wr, int wc, int fr, int fq) const {
        const int row0 = u.pm * 256 + wr * 64 + fr, col0 = u.pn * 256 + wc * 32 + 8 * fq;
#pragma unroll
        for (int ai = 0; ai < 2; ++ai) {
            u32x4 rr[4][2];
#pragma unroll
            for (int m = 0; m < 4; ++m)
#pragma unroll
                for (int bj = 0; bj < 2; ++bj) rr[m][bj] = *(const u32x4*)(G + (size_t)(row0 + ai * 128 + m * 16) * DM + col0 + bj * 128);
#pragma unroll
            for (int m = 0; m < 4; ++m)
#pragma unroll
                for (int bj = 0; bj < 2; ++bj) { const size_t off = (size_t)(row0 + ai * 128 + m * 16) * DM + col0 + bj * 128; const u32x4 r = rr[m][bj];
                    const f32x4 v0 = acc[ai][bj][m][0] * (f32x4){bflo(r.x), bfhi(r.x), bflo(r.y), bfhi(r.y)}, v1 = acc[ai][bj][m][1] * (f32x4){bflo(r.z), bfhi(r.z), bflo(r.w), bfhi(r.w)};
                    u32x4 w; w.x = cvtpk_s(v0[0], v0[1]); w.y = cvtpk_s(v0[2], v0[3]); w.z = cvtpk_s(v1[0], v1[1]); w.w = cvtpk_s(v1[2], v1[3]);
                    *(u32x4*)(O + off) = w; }
            asm volatile("" ::: "memory");
        }
    }
};

__device__ __forceinline__ int dkmap32(int pos) { const int qq = pos >> 3, jj = pos & 7; return jj < 4 ? 4 * qq + jj : 16 + 4 * qq + (jj - 4); }
__device__ __forceinline__ void tr_item(const float* W, int ldw, int srccol0, int k0, bf16_t* WT, int ldt, int dstrow0, LAS float* scr, int lane, bool zero, int dk0 = 0, bool qperm = false) {
    if (!zero) {
        f32x4 tv[8];
#pragma unroll
        for (int i = 0; i < 8; ++i) tv[i] = *(const f32x4*)(W + (size_t)(k0 + 8 * i + (lane >> 3)) * ldw + srccol0 + 4 * (lane & 7));
#pragma unroll
        for (int i = 0; i < 8; ++i) { LAS float* d = scr + (8 * i + (lane >> 3)) * 33 + 4 * (lane & 7); d[0] = tv[i][0]; d[1] = tv[i][1]; d[2] = tv[i][2]; d[3] = tv[i][3]; }
    }
    LDS_WAIT();
    const int c = lane & 7;
#pragma unroll
    for (int j = 0; j < 4; ++j) { const int n = (lane >> 3) + 8 * j; const LAS float* s = scr + (8 * c) * 33 + (qperm ? dkmap32(n) : n);
        u32x4 o; o.x = cvtpk_s(s[0 * 33], s[1 * 33]); o.y = cvtpk_s(s[2 * 33], s[3 * 33]); o.z = cvtpk_s(s[4 * 33], s[5 * 33]); o.w = cvtpk_s(s[6 * 33], s[7 * 33]);
        if (zero) o = (u32x4){0u, 0u, 0u, 0u};
        *(u32x4*)(WT + (size_t)(dstrow0 + n) * ldt + dk0 + k0 + 8 * c) = o; }
    LDS_WAIT();
}
template <bool OUT_BF16> __device__ __forceinline__ void ln_row(const float* in, void* outp, const float* g, const float* b, int lane) {
    const f32x4* xr = (const f32x4*)in + lane;
    f32x4 v[8]; float s = 0.f;
#pragma unroll
    for (int j = 0; j < 8; ++j) { v[j] = xr[64 * j]; s += (v[j][0] + v[j][1]) + (v[j][2] + v[j][3]); }
    const float mean = wave_sum(s) * (1.f / DM); float s2 = 0.f;
#pragma unroll
    for (int j = 0; j < 8; ++j) { v[j] = v[j] - mean; s2 += (v[j][0] * v[j][0] + v[j][1] * v[j][1]) + (v[j][2] * v[j][2] + v[j][3] * v[j][3]); }
    const float rstd = 1.f / sqrtf(wave_sum(s2) * (1.f / DM) + LN_EPS);
#pragma unroll
    for (int j = 0; j < 8; ++j) { const f32x4 gg = ((const f32x4*)g)[64 * j + lane], bb = ((const f32x4*)b)[64 * j + lane]; const f32x4 o = v[j] * rstd * gg + bb;
        if (OUT_BF16) { u32x2 w; w.x = cvtpk_s(o[0], o[1]); w.y = cvtpk_s(o[2], o[3]); ((u32x2*)outp)[64 * j + lane] = w; }
        else ((f32x4*)outp)[64 * j + lane] = o; }
}
template <bool OUT_BF16, bool IN_BF16 = false> __device__ __forceinline__ void ln_row2(const void* in0, const void* in1, void* out0, void* out1, const float* g, const float* b, int lane) {
    f32x4 v[8], w[8]; float s = 0.f, t = 0.f;
    if (IN_BF16) { const u32x2* x0 = (const u32x2*)in0 + lane; const u32x2* x1 = (const u32x2*)in1 + lane; u32x2 a0[8], a1[8];
#pragma unroll
        for (int j = 0; j < 8; ++j) { a0[j] = x0[64 * j]; a1[j] = x1[64 * j]; }
#pragma unroll
        for (int j = 0; j < 8; ++j) { v[j] = (f32x4){bflo(a0[j].x), bfhi(a0[j].x), bflo(a0[j].y), bfhi(a0[j].y)}; w[j] = (f32x4){bflo(a1[j].x), bfhi(a1[j].x), bflo(a1[j].y), bfhi(a1[j].y)}; }
    } else { const f32x4* x0 = (const f32x4*)in0 + lane; const f32x4* x1 = (const f32x4*)in1 + lane;
#pragma unroll
        for (int j = 0; j < 8; ++j) { v[j] = x0[64 * j]; w[j] = x1[64 * j]; } }
#pragma unroll
    for (int j = 0; j < 8; ++j) { s += (v[j][0] + v[j][1]) + (v[j][2] + v[j][3]); t += (w[j][0] + w[j][1]) + (w[j][2] + w[j][3]); }
#pragma unroll
    for (int o = 1; o < 64; o <<= 1) { s += __shfl_xor(s, o); t += __shfl_xor(t, o); }
    const float m0 = s * (1.f / DM), m1 = t * (1.f / DM); float s2 = 0.f, t2 = 0.f;
#pragma unroll
    for (int j = 0; j < 8; ++j) { v[j] = v[j] - m0; w[j] = w[j] - m1; s2 += (v[j][0] * v[j][0] + v[j][1] * v[j][1]) + (v[j][2] * v[j][2] + v[j][3] * v[j][3]); t2 += (w[j][0] * w[j][0] + w[j][1] * w[j][1]) + (w[j][2] * w[j][2] + w[j][3] * w[j][3]); }
#pragma unroll
    for (int o = 1; o < 64; o <<= 1) { s2 += __shfl_xor(s2, o); t2 += __shfl_xor(t2, o); }
    const float r0 = 1.f / sqrtf(s2 * (1.f / DM) + LN_EPS), r1 = 1.f / sqrtf(t2 * (1.f / DM) + LN_EPS);
#pragma unroll
    for (int j = 0; j < 8; ++j) { const f32x4 gg = ((const f32x4*)g)[64 * j + lane], bb = ((const f32x4*)b)[64 * j + lane]; const f32x4 o0 = v[j] * r0 * gg + bb, o1 = w[j] * r1 * gg + bb;
        if (OUT_BF16) { u32x2 p; p.x = cvtpk_s(o0[0], o0[1]); p.y = cvtpk_s(o0[2], o0[3]); ((u32x2*)out0)[64 * j + lane] = p; p.x = cvtpk_s(o1[0], o1[1]); p.y = cvtpk_s(o1[2], o1[3]); ((u32x2*)out1)[64 * j + lane] = p; }
        else { ((f32x4*)out0)[64 * j + lane] = o0; ((f32x4*)out1)[64 * j + lane] = o1; } }
}

template <bool OUT_BF16, bool IN_BF16> __device__ __forceinline__ void ln_stream(const void* in, void* out, const float* g, const float* b, int gw, int ngw, int lane) {
    typedef typename std::conditional<IN_BF16, u32x2, f32x4>::type raw_t;
    f32x4 gg[8], bb[8];
#pragma unroll
    for (int j = 0; j < 8; ++j) { gg[j] = ((const f32x4*)g)[64 * j + lane]; bb[j] = ((const f32x4*)b)[64 * j + lane]; }
    raw_t cur[2][8], nxt[2][8];
    const int nit = MTOK / (2 * ngw);
#define LN_LOAD(dst, it) do { _Pragma("unroll") for (int r = 0; r < 2; ++r) { const raw_t* rp = (const raw_t*)((const char*)in + (size_t)(gw + (2 * (it) + r) * ngw) * DM * (IN_BF16 ? 2 : 4)) + lane; \
        _Pragma("unroll") for (int j = 0; j < 8; ++j) dst[r][j] = rp[64 * j]; } } while (0)
    LN_LOAD(cur, 0);
    for (int it = 0; it < nit; ++it) {
        if (it + 1 < nit) LN_LOAD(nxt, it + 1);
        f32x4 v[2][8]; float s[2], s2[2];
#pragma unroll
        for (int r = 0; r < 2; ++r) { s[r] = 0.f;
#pragma unroll
            for (int j = 0; j < 8; ++j) { if constexpr (IN_BF16) { const u32x2 w = *(const u32x2*)&cur[r][j]; v[r][j] = (f32x4){bflo(w.x), bfhi(w.x), bflo(w.y), bfhi(w.y)}; } else v[r][j] = *(const f32x4*)&cur[r][j];
                s[r] += (v[r][j][0] + v[r][j][1]) + (v[r][j][2] + v[r][j][3]); } }
        s[0] = wave_sum(s[0]); s[1] = wave_sum(s[1]);
#pragma unroll
        for (int r = 0; r < 2; ++r) { const float mean = s[r] * (1.f / DM); s2[r] = 0.f;
#pragma unroll
            for (int j = 0; j < 8; ++j) { v[r][j] = v[r][j] - mean; s2[r] += (v[r][j][0] * v[r][j][0] + v[r][j][1] * v[r][j][1]) + (v[r][j][2] * v[r][j][2] + v[r][j][3] * v[r][j][3]); } }
        s2[0] = wave_sum(s2[0]); s2[1] = wave_sum(s2[1]);
#pragma unroll
        for (int r = 0; r < 2; ++r) { const float rstd = 1.f / sqrtf(s2[r] * (1.f / DM) + LN_EPS); const size_t row = (size_t)(gw + (2 * it + r) * ngw);
#pragma unroll
            for (int j = 0; j < 8; ++j) { const f32x4 o = v[r][j] * rstd * gg[j] + bb[j];
                if (OUT_BF16) { u32x2 pk; pk.x = cvtpk_s(o[0], o[1]); pk.y = cvtpk_s(o[2], o[3]); ((u32x2*)((bf16_t*)out + row * DM))[64 * j + lane] = pk; }
                else ((f32x4*)((float*)out + row * DM))[64 * j + lane] = o; } }
#pragma unroll
        for (int r = 0; r < 2; ++r)
#pragma unroll
            for (int j = 0; j < 8; ++j) cur[r][j] = nxt[r][j];
    }
#undef LN_LOAD
}

__device__ __forceinline__ void phase_prep(const Args& a, LAS unsigned char* lds, int gw, int ngw, int wave, int lane) {
    LAS float* scr = (LAS float*)(lds + wave * 8448);
    bf16_t* W1T = (bf16_t*)(a.ws + OFF_W1T); bf16_t* WOT = (bf16_t*)(a.ws + OFF_WOT);
    constexpr int I1 = 32 * (N1 / 32), IO = 32 * 64;
    for (int it = gw; it < I1; it += ngw) {
        if (it < I1) { const int kb = it / (N1 / 32), nb = it % (N1 / 32), n0 = nb * 32;
            const bool zero = n0 >= 14400; int src;
            if (n0 < 4096) src = n0;
            else if (n0 < 8192) { const int t = (n0 - 4096) >> 8, wi = n0 & 255; src = wi < 128 ? 4096 + 128 * t + wi : 10304 + 128 * t + (wi - 128); }
            else if (n0 < 12288) { const int t = (n0 - 8192) >> 8, wi = n0 & 255; src = wi < 128 ? 6208 + 128 * t + wi : 12352 + 128 * t + (wi - 128); }
            else if (n0 < 14336) src = 8256 + (n0 - 12288);
            else src = 6144 + (n0 - 14336);
            tr_item(a.w_in, 14400, zero ? 0 : src, kb * 64, W1T, 2048, n0, scr, lane, zero, 0, n0 < 1024); }
        else { const int r = it - I1, kb = r / 64, nb = r % 64; tr_item(a.w_o, 2048, nb * 32, kb * 64, WOT, 2048, nb * 32, scr, lane, false); }
    }
    bf16_t* H0 = (bf16_t*)(a.ws + OFF_H0);
    ln_stream<true, false>(a.x, H0, a.ln0_g, a.ln0_b, gw, ngw, lane);
}
__device__ __forceinline__ void phase_prep2(const Args& a, LAS unsigned char* lds, int gw, int ngw, int wave, int lane) {
    LAS float* scr = (LAS float*)(lds + wave * 8448);
    bf16_t* WGUT = (bf16_t*)(a.out + DO_WGUT); bf16_t* WDT = (bf16_t*)(a.out + DO_WDT);
    constexpr int IG = 32 * (NGU / 32), ID = 88 * 64, IP = 4 * 64;
    { bf16_t* WOT = (bf16_t*)(a.ws + OFF_WOT);
      for (int r = gw; r < 32 * 64; r += ngw) { const int kb = r / 64, nb = r % 64; tr_item(a.w_o, 2048, nb * 32, kb * 64, WOT, 2048, nb * 32, scr, lane, false); } }
    for (int it = gw; it < IG + ID + IP; it += ngw) {
        if (it < IG) { const int kb = it / (NGU / 32), nb = it % (NGU / 32), n0 = nb * 32, t = n0 >> 8, wi = n0 & 255;
            if (t < 44) tr_item(a.w_gu, 2 * DFF, wi < 128 ? t * 128 + wi : DFF + t * 128 + (wi - 128), kb * 64, WGUT, 2048, n0, scr, lane, false);
            else tr_item(a.w_pg, 2048, (t - 44) * 256 + wi, kb * 64, WGUT, 2048, n0, scr, lane, false); }
        else if (it < IG + ID) { const int r = it - IG, kb = r / 64, nb = r % 64; tr_item(a.w_down, 2048, nb * 32, kb * 64, WDT, KX, nb * 32, scr, lane, false, 256); }
        else { const int r = it - IG - ID, kb = r / 64, nb = r % 64; tr_item(a.w_pu, 2048, nb * 32, kb * 64, WDT, KX, nb * 32, scr, lane, false, 0); }
    }
}
__device__ __forceinline__ void phase_pconv(const Args& a, int gw, int ngw, int lane) {
    bf16_t* ACT = (bf16_t*)(a.ws + OFF_ACT);
    for (int i = gw * 64 + lane; i < MTOK * 64; i += ngw * 64) { const int m = i >> 6, c4 = (i & 63) * 4; const f32x4 v = *(const f32x4*)(a.p + (size_t)m * 256 + c4);
        u32x2 w; w.x = cvtpk_s(v[0], v[1]); w.y = cvtpk_s(v[2], v[3]); *(u32x2*)(ACT + (size_t)m * KX + c4) = w; }
}

__device__ __forceinline__ void phase_kt(const Args& a, LAS unsigned char* lds, int tid) {
    LAS float* fgs = (LAS float*)(lds + 131072);
    bf16_t* Kb = (bf16_t*)(a.ws + OFF_K); const float* FG = (const float*)(a.ws + OFF_FG); const float* FG2 = (const float*)(a.ws + OFF_FG2); float* DEC = (float*)(a.out + DO_DEC);
    const int col2 = 2 * tid, h = col2 >> 8, d = col2 & 255;
    float w0[16], w1[16];
#pragma unroll
    for (int r = 0; r < 16; ++r) { const float2 t = *(const float2*)(a.w_f2 + (h * 16 + r) * 256 + d); w0[r] = t.x; w1[r] = t.y; }
    const float2 bb = *(const float2*)(a.b_f2 + h * 256 + d);
    for (int it = blockIdx.x; it < NCHUNK; it += gridDim.x) {
        const size_t row0 = (size_t)it * 64;
        __syncthreads();
#pragma unroll
        for (int i = 0; i < 2; ++i) { const int p = tid + 512 * i; ((LAS f32x4*)fgs)[p] = ((const f32x4*)(FG + row0 * 64))[p] + ((const f32x4*)(FG2 + row0 * 64))[p] + *(const f32x4*)(a.b_in + 6144 + 4 * (p & 15)); }
        __syncthreads();
        float run0 = 0.f, run1 = 0.f;
        unsigned kwc[8], kwn[8];
#pragma unroll
        for (int tt = 0; tt < 8; ++tt) { kwc[tt] = *(const unsigned*)(Kb + (row0 + 56 + tt) * 1024 + col2); kwn[tt] = 0u; }
        for (int tg = 7; tg >= 0; --tg) {
            if (tg > 0) {
#pragma unroll
                for (int tt = 0; tt < 8; ++tt) kwn[tt] = *(const unsigned*)(Kb + (row0 + (tg - 1) * 8 + tt) * 1024 + col2); }
            float v0[8], v1[8];
#pragma unroll
            for (int tt = 7; tt >= 0; --tt) { const int t = tg * 8 + tt;
                const LAS f32x4* fp = (const LAS f32x4*)(fgs + t * 64 + h * 16);
                float f0 = bb.x, f1 = bb.y;
#pragma unroll
                for (int r4 = 0; r4 < 4; ++r4) { const f32x4 fv = fp[r4];
#pragma unroll
                    for (int j = 0; j < 4; ++j) { f0 += fv[j] * w0[r4 * 4 + j]; f1 += fv[j] * w1[r4 * 4 + j]; } }
                const float la0 = (fminf(f0, 0.f) - __logf(1.f + __expf(-fabsf(f0)))) * 0.0625f, la1 = (fminf(f1, 0.f) - __logf(1.f + __expf(-fabsf(f1)))) * 0.0625f;
                const unsigned kw = kwc[tt];
                v0[tt] = bflo(kw) * __expf(run0); v1[tt] = bfhi(kw) * __expf(run1);
                run0 += la0; run1 += la1; }
            u32x4 p0, p1;
            p0.x = cvtpk_s(v0[0], v0[1]); p0.y = cvtpk_s(v0[2], v0[3]); p0.z = cvtpk_s(v0[4], v0[5]); p0.w = cvtpk_s(v0[6], v0[7]);
            p1.x = cvtpk_s(v1[0], v1[1]); p1.y = cvtpk_s(v1[2], v1[3]); p1.z = cvtpk_s(v1[4], v1[5]); p1.w = cvtpk_s(v1[6], v1[7]);
            *(LAS u32x4*)(lds + col2 * 128 + ((tg ^ (col2 & 7)) << 4)) = p0;
            *(LAS u32x4*)(lds + (col2 + 1) * 128 + ((tg ^ ((col2 + 1) & 7)) << 4)) = p1;
#pragma unroll
            for (int tt = 0; tt < 8; ++tt) kwc[tt] = kwn[tt];
        }
        *(float2*)(DEC + (size_t)it * 1024 + col2) = make_float2(__expf(run0), __expf(run1));
        __syncthreads();
#pragma unroll
        for (int i = 0; i < 16; ++i) { const int p = tid + 512 * i, c = p >> 3, s = p & 7;
            *(u32x4*)(Kb + (size_t)it * 65536 + c * 64 + s * 8) = *(const LAS u32x4*)(lds + c * 128 + ((s ^ (c & 7)) << 4)); }
    }
    __syncthreads();
}

__device__ __forceinline__ void phase_scan(const Args& a, LAS unsigned char* lds, int tid, int wave, int lane) {
    const int bx = blockIdx.x, xcd = bx & 7, jj = bx >> 3, bh = xcd * 2 + (jj >> 3), b = bh >> 2, h = bh & 3, dvb = jj & 7, l15 = lane & 15, q = lane >> 4;
    constexpr int KTB = 0, QB = 65536, VB = 131072, DB = 147456;
    const bf16_t* KT = (const bf16_t*)(a.ws + OFF_K) + (size_t)(b * 128) * 65536 + h * 16384;
    const bf16_t* Qg = (const bf16_t*)(a.ws + OFF_Q) + (size_t)(b * 8192) * 1024 + h * 256;
    bf16_t* Vg = (bf16_t*)(a.ws + OFF_V) + (size_t)(b * 8192) * 2048 + h * 512 + dvb * 64;
    const float* DEC = (const float*)(a.out + DO_DEC) + (size_t)(b * 128) * 1024 + h * 256;
#define SBAR() do { asm volatile("s_waitcnt lgkmcnt(0)" ::: "memory"); __builtin_amdgcn_s_barrier(); asm volatile("" ::: "memory"); } while (0)
    if (wave >= 4) {
        const int lw = wave - 4;
        const unsigned kvo = (unsigned)(((lane >> 3) * 64 + (((lane & 7) ^ ((lane >> 3) & 7)) << 3)) * 2);
        unsigned qvo[8];
#pragma unroll
        for (int i = 0; i < 8; ++i) { const int frl = 2 * i + (lane >> 5); qvo[i] = (unsigned)(((lw * 16 + frl) * 1024 + (((lane & 31) ^ (frl & 15)) << 3)) * 2); }
        const unsigned vvo = (unsigned)(((lane >> 3) * 2048 + (lane & 7) * 8) * 2);
#define G1(cc) do { const int c_ = (cc) > 127 ? 127 : (cc); const char* qb_ = (const char*)(Qg + (size_t)c_ * 65536); LAS unsigned char* d_ = lds + QB + ((cc) & 1) * 32768 + lw * 8192; \
            _Pragma("unroll") for (int i = 0; i < 8; ++i) __builtin_amdgcn_global_load_lds((const unsigned*)(qb_ + qvo[i]), (LAS unsigned*)(d_ + i * 1024), 16, 0, 0); } while (0)
#define G2(cc) do { const int c_ = (cc) > 127 ? 127 : (cc); const char* kb_ = (const char*)(KT + (size_t)c_ * 65536) + lw * 8192; LAS unsigned char* d_ = lds + KTB + ((cc) & 1) * 32768 + lw * 8192; \
            _Pragma("unroll") for (int i = 0; i < 8; ++i) __builtin_amdgcn_global_load_lds((const unsigned*)(kb_ + i * 1024 + kvo), (LAS unsigned*)(d_ + i * 1024), 16, 0, 0); \
            const char* vb_ = (const char*)(Vg + (size_t)(c_ * 64 + lw * 16) * 2048); LAS unsigned char* dv_ = lds + VB + ((cc) & 1) * 8192 + lw * 2048; \
            _Pragma("unroll") for (int i = 0; i < 2; ++i) __builtin_amdgcn_global_load_lds((const unsigned*)(vb_ + (size_t)i * 8 * 2048 * 2 + vvo), (LAS unsigned*)(dv_ + i * 1024), 16, 0, 0); \
            __builtin_amdgcn_global_load_lds((const unsigned*)(DEC + (size_t)c_ * 1024 + lw * 64 + lane), (LAS unsigned*)(lds + DB + ((cc) & 1) * 1024 + lw * 256), 4, 0, 0); } while (0)
        G2(0); G1(0); G2(1);
        for (int c = 0; c < 128; ++c) {
            asm volatile("s_waitcnt vmcnt(19)" ::: "memory");
            SBAR();
            G1(c + 1);
            asm volatile("s_waitcnt vmcnt(19)" ::: "memory");
            SBAR();
            G2(c + 2);
        }
        asm volatile("s_waitcnt vmcnt(0)" ::: "memory");
#undef G1
#undef G2
    } else {
        const unsigned ovo = (unsigned)((l15 * 2048 + 16 * wave + 4 * q) * 2);
        __builtin_amdgcn_s_setprio(2);
        f32x4 accS[16];
#pragma unroll
        for (int i = 0; i < 16; ++i) accS[i] = (f32x4){0.f, 0.f, 0.f, 0.f};
        for (int c = 0; c < 128; ++c) {
            LAS unsigned char* KTs = lds + KTB + (c & 1) * 32768; LAS unsigned char* Qs = lds + QB + (c & 1) * 32768;
            const LAS unsigned short* Vs = (const LAS unsigned short*)(lds + VB + (c & 1) * 8192); LAS float* DECs = (LAS float*)(lds + DB + (c & 1) * 1024);
            SBAR();
            bf16x8 vb0, vb1;
            { const LAS unsigned short* vp = Vs + (8 * q) * 64 + 16 * wave + l15; unsigned w0[4], w1[4];
#pragma unroll
              for (int e = 0; e < 4; ++e) { w0[e] = (unsigned)vp[(2 * e) * 64] | ((unsigned)vp[(2 * e + 1) * 64] << 16); w1[e] = (unsigned)vp[(32 + 2 * e) * 64] | ((unsigned)vp[(32 + 2 * e + 1) * 64] << 16); }
              vb0 = __builtin_bit_cast(bf16x8, (u32x4){w0[0], w0[1], w0[2], w0[3]}); vb1 = __builtin_bit_cast(bf16x8, (u32x4){w1[0], w1[1], w1[2], w1[3]}); }
#define SCAN_KTLD(A0, A1, D, bt) do { _Pragma("unroll") for (int t = 0; t < 4; ++t) { const int dk = 16 * (4 * (bt) + t) + l15; \
                A0[t] = *(const LAS bf16x8*)(KTs + dk * 128 + ((q ^ (dk & 7)) << 4)); A1[t] = *(const LAS bf16x8*)(KTs + dk * 128 + (((4 + q) ^ (dk & 7)) << 4)); \
                D[t] = *(const LAS f32x4*)(DECs + 16 * (4 * (bt) + t) + 4 * q); } } while (0)
#define SCAN_KTMM(A0, A1, D, bt) do { _Pragma("unroll") for (int t = 0; t < 4; ++t) accS[4 * (bt) + t] = __builtin_amdgcn_mfma_f32_16x16x32_bf16(A0[t], vb0, accS[4 * (bt) + t] * D[t], 0, 0, 0); \
            _Pragma("unroll") for (int t = 0; t < 4; ++t) accS[4 * (bt) + t] = __builtin_amdgcn_mfma_f32_16x16x32_bf16(A1[t], vb1, accS[4 * (bt) + t], 0, 0, 0); } while (0)
            {
                bf16x8 xa0[4], xa1[4], ya0[4], ya1[4]; f32x4 xd[4], yd[4];
                SCAN_KTLD(xa0, xa1, xd, 0); __builtin_amdgcn_sched_barrier(0);
                SCAN_KTLD(ya0, ya1, yd, 1); __builtin_amdgcn_sched_barrier(0);
                SCAN_KTMM(xa0, xa1, xd, 0); __builtin_amdgcn_sched_barrier(0);
                SCAN_KTLD(xa0, xa1, xd, 2); __builtin_amdgcn_sched_barrier(0);
                SCAN_KTMM(ya0, ya1, yd, 1); __builtin_amdgcn_sched_barrier(0);
                SCAN_KTLD(ya0, ya1, yd, 3); __builtin_amdgcn_sched_barrier(0);
                SCAN_KTMM(xa0, xa1, xd, 2); __builtin_amdgcn_sched_barrier(0);
                SCAN_KTMM(ya0, ya1, yd, 3); __builtin_amdgcn_sched_barrier(0);
            }
            bf16x8 sf[8];
#pragma unroll
            for (int ks = 0; ks < 8; ++ks) { u32x4 w; w.x = cvtpk_s(accS[2 * ks][0], accS[2 * ks][1]); w.y = cvtpk_s(accS[2 * ks][2], accS[2 * ks][3]);
                w.z = cvtpk_s(accS[2 * ks + 1][0], accS[2 * ks + 1][1]); w.w = cvtpk_s(accS[2 * ks + 1][2], accS[2 * ks + 1][3]); sf[ks] = __builtin_bit_cast(bf16x8, w); }
            SBAR();
            f32x4 o[4];
#pragma unroll
            for (int ft = 0; ft < 4; ++ft) o[ft] = (f32x4){0.f, 0.f, 0.f, 0.f};
#define SCAN_QLD(Q, kb) do { _Pragma("unroll") for (int k2 = 0; k2 < 2; ++k2) _Pragma("unroll") for (int ft = 0; ft < 4; ++ft) { const int fr = 16 * ft + l15, pc = 4 * (2 * (kb) + k2) + q; \
                Q[k2 * 4 + ft] = *(const LAS u32x4*)(Qs + fr * 512 + ((pc ^ (fr & 15)) << 4)); } } while (0)
#define SCAN_QMM(Q, kb) do { _Pragma("unroll") for (int k2 = 0; k2 < 2; ++k2) _Pragma("unroll") for (int ft = 0; ft < 4; ++ft) \
                o[ft] = __builtin_amdgcn_mfma_f32_16x16x32_bf16(sf[2 * (kb) + k2], __builtin_bit_cast(bf16x8, Q[k2 * 4 + ft]), o[ft], 0, 0, 0); } while (0)
            {
                u32x4 xq[8], yq[8];
                SCAN_QLD(xq, 0); __builtin_amdgcn_sched_barrier(0);
                SCAN_QLD(yq, 1); __builtin_amdgcn_sched_barrier(0);
                SCAN_QMM(xq, 0); __builtin_amdgcn_sched_barrier(0);
                SCAN_QLD(xq, 2); __builtin_amdgcn_sched_barrier(0);
                SCAN_QMM(yq, 1); __builtin_amdgcn_sched_barrier(0);
                SCAN_QLD(yq, 3); __builtin_amdgcn_sched_barrier(0);
                SCAN_QMM(xq, 2); __builtin_amdgcn_sched_barrier(0);
                SCAN_QMM(yq, 3); __builtin_amdgcn_sched_barrier(0);
            }
#undef SCAN_KTLD
#undef SCAN_KTMM
#undef SCAN_QLD
#undef SCAN_QMM
#pragma unroll
            for (int ft = 0; ft < 4; ++ft) { u32x2 w; w.x = cvtpk_s(o[ft][0], o[ft][1]); w.y = cvtpk_s(o[ft][2], o[ft][3]);
                *(u32x2*)((char*)(Vg + (size_t)(c * 64 + 16 * ft) * 2048) + ovo) = w; }
        }
        __builtin_amdgcn_s_setprio(0);
    }
    SBAR();
#undef SBAR
}

__device__ __forceinline__ void phase_merge(const Args& a, LAS unsigned char* lds, int tid, int wave, int lane) {
    const int g = blockIdx.x & 3, l15 = lane & 15, q = lane >> 4;
    LAS unsigned char* Ws = lds; LAS unsigned char* ZT = lds + 32768; LAS float* SG = (LAS float*)(lds + 65536); LAS float* MU = (LAS float*)(lds + 65536 + 67584); LAS float* RS = MU + 128; LAS float* RO = MU + 256;
    const bf16_t* Zb = (const bf16_t*)(a.ws + OFF_Z); const bf16_t* Ob = (const bf16_t*)(a.ws + OFF_V); const bf16_t* OGb = (const bf16_t*)(a.ws + OFF_OG);
    bf16_t* Ub = (bf16_t*)(a.ws + OFF_U);
    for (int p = tid; p < 4096; p += 512) { const int i = p >> 5, j4 = (p & 31) * 4; f32x4 v = *(const f32x4*)(a.w_s + (size_t)g * 16384 + i * 128 + j4);
        if ((j4 >> 6) > (i >> 6)) v = (f32x4){0.f, 0.f, 0.f, 0.f};
        u32x2 w; w.x = cvtpk_s(v[0], v[1]); w.y = cvtpk_s(v[2], v[3]);
        *(LAS u32x2*)(Ws + i * 256 + (((j4 >> 3) ^ (i & 7)) << 4) + (j4 & 4) * 2) = w; }
    for (int item = blockIdx.x; item < 1024; item += gridDim.x) {
        const int nb = item >> 2; const size_t row0 = (size_t)nb * 128; const int colg = g * 512;
        __syncthreads();
#pragma unroll 4
        for (int rr = 0; rr < 16; ++rr) { const int i = wave * 16 + rr; const size_t off = (row0 + i) * DM + colg + lane * 8;
            const u32x4 zw = *(const u32x4*)(Zb + off), ow = *(const u32x4*)(Ob + off);
            float z[8] = {bflo(zw.x), bfhi(zw.x), bflo(zw.y), bfhi(zw.y), bflo(zw.z), bfhi(zw.z), bflo(zw.w), bfhi(zw.w)};
            const float o[8] = {bflo(ow.x), bfhi(ow.x), bflo(ow.y), bfhi(ow.y), bflo(ow.z), bfhi(ow.z), bflo(ow.w), bfhi(ow.w)};
            float s = 0.f, so = 0.f;
#pragma unroll
            for (int e = 0; e < 8; ++e) { s += z[e]; so += o[e] * o[e]; }
            const float mean = wave_sum(s) * (1.f / 512.f); so = wave_sum(so); float s2 = 0.f;
#pragma unroll
            for (int e = 0; e < 8; ++e) { const float dd = z[e] - mean; s2 += dd * dd; }
            s2 = wave_sum(s2);
            if (lane == 0) { MU[i] = mean; RS[i] = 1.f / sqrtf(s2 * (1.f / 512.f) + LN_EPS); RO[i] = 1.f / sqrtf(so * (1.f / 512.f) + LN_EPS); } }
        __syncthreads();
        for (int cc = 0; cc < 4; ++cc) {
            const int colc = colg + cc * 128;
            u32x4 uw4[4], ow4[4], gw4[4];
#pragma unroll
            for (int k = 0; k < 4; ++k) { const int p = tid + 512 * k, i = p >> 4, c8 = (p & 15) * 8; const size_t off = (row0 + i) * DM + colc + c8;
                uw4[k] = *(const u32x4*)(Ub + off); ow4[k] = *(const u32x4*)(Ob + off); gw4[k] = *(const u32x4*)(OGb + off); }
            { const int c8 = (tid & 15) * 8;
              const f32x4 g0 = *(const f32x4*)(a.gm_g + colc + c8), g1 = *(const f32x4*)(a.gm_g + colc + c8 + 4), b0 = *(const f32x4*)(a.gm_b + colc + c8), b1 = *(const f32x4*)(a.gm_b + colc + c8 + 4);
#pragma unroll
              for (int i = 0; i < 2; ++i) { const int p = tid + 512 * i, j = (p >> 4) * 2;
                const u32x4 zw = *(const u32x4*)(Zb + (row0 + j) * DM + colc + c8), zx = *(const u32x4*)(Zb + (row0 + j + 1) * DM + colc + c8);
                const float z[8] = {bflo(zw.x), bfhi(zw.x), bflo(zw.y), bfhi(zw.y), bflo(zw.z), bfhi(zw.z), bflo(zw.w), bfhi(zw.w)};
                const float y[8] = {bflo(zx.x), bfhi(zx.x), bflo(zx.y), bfhi(zx.y), bflo(zx.z), bfhi(zx.z), bflo(zx.w), bfhi(zx.w)};
                const float mu0 = MU[j], rs0 = RS[j], mu1 = MU[j + 1], rs1 = RS[j + 1];
#pragma unroll
                for (int e = 0; e < 8; ++e) { const float gg = e < 4 ? g0[e & 3] : g1[e & 3], bb = e < 4 ? b0[e & 3] : b1[e & 3];
                    const float zn0 = (z[e] - mu0) * rs0 * gg + bb, zn1 = (y[e] - mu1) * rs1 * gg + bb;
                    const int c = c8 + e;
                    *(LAS unsigned*)(ZT + c * 256 + (((j >> 3) ^ ((c ^ (c >> 3)) & 7)) << 4) + (j & 7) * 2) = cvtpk_s(zn0, zn1); } } }
            __syncthreads();
            {
                const int c = 16 * wave + l15; bf16x8 zf[4];
#pragma unroll
                for (int ks = 0; ks < 4; ++ks) zf[ks] = *(const LAS bf16x8*)(ZT + c * 256 + (((4 * ks + q) ^ ((c ^ (c >> 3)) & 7)) << 4));
#pragma unroll
                for (int it = 0; it < 8; ++it) { const int i = 16 * it + l15; f32x4 acc = (f32x4){0.f, 0.f, 0.f, 0.f};
#pragma unroll
                    for (int ks = 0; ks < 4; ++ks) { if (it < 4 && ks >= 2) continue;
                        const bf16x8 wf = *(const LAS bf16x8*)(Ws + i * 256 + (((4 * ks + q) ^ (i & 7)) << 4));
                        acc = __builtin_amdgcn_mfma_f32_16x16x32_bf16(wf, zf[ks], acc, 0, 0, 0); }
#pragma unroll
                    for (int r = 0; r < 4; ++r) SG[(16 * it + 4 * q + r) * 132 + c] = acc[r]; }
            }
            __syncthreads();
#pragma unroll
            for (int k = 0; k < 4; ++k) { const int p = tid + 512 * k, i = p >> 4, c8 = (p & 15) * 8; const size_t off = (row0 + i) * DM + colc + c8;
                const u32x4 uw = uw4[k], ow = ow4[k], gw = gw4[k];
                const f32x4 s0 = *(const LAS f32x4*)(SG + i * 132 + c8), s1 = *(const LAS f32x4*)(SG + i * 132 + c8 + 4);
                const f32x4 n0 = *(const f32x4*)(a.gla_g + colc + c8), n1 = *(const f32x4*)(a.gla_g + colc + c8 + 4);
                const float bs = a.b_s[g * 128 + i], ro = RO[i];
                const unsigned uu[4] = {uw.x, uw.y, uw.z, uw.w}, oo[4] = {ow.x, ow.y, ow.z, ow.w}, gg[4] = {gw.x, gw.y, gw.z, gw.w};
                float m[8];
#pragma unroll
                for (int e = 0; e < 8; ++e) { const int wi = e >> 1; const bool hi = e & 1;
                    const float uv = hi ? bfhi(uu[wi]) : bflo(uu[wi]), ov = hi ? bfhi(oo[wi]) : bflo(oo[wi]), gv = hi ? bfhi(gg[wi]) : bflo(gg[wi]);
                    const float sg = (e < 4 ? s0[e & 3] : s1[e & 3]) + bs, ng = e < 4 ? n0[e & 3] : n1[e & 3];
                    m[e] = gv * (ov * ro * ng) + uv * sg; }
                u32x4 w; w.x = cvtpk_s(m[0], m[1]); w.y = cvtpk_s(m[2], m[3]); w.z = cvtpk_s(m[4], m[5]); w.w = cvtpk_s(m[6], m[7]);
                *(u32x4*)(Ub + off) = w; }
        }
    }
    __syncthreads();
}

typedef __attribute__((address_space(1))) unsigned gu32;
#define XB_TMO      128
#define XB_XCNT(j)  (256  + 64 * (j))
#define XB_XSUB(j)  (1280 + 64 * (j))
#define XB_XGEN(j)  (2304 + 64 * (j))
#define XB_TOP      3328
#define XB_TOPGEN   3392
#define XCD_BAR_WORDS 3456
#define XB_SPIN_CAP (1u << 18)

__device__ __forceinline__ unsigned xb_ld(unsigned* p)              { return __hip_atomic_load(p, __ATOMIC_RELAXED, __HIP_MEMORY_SCOPE_AGENT); }
__device__ __forceinline__ unsigned xb_add(unsigned* p, unsigned v) { return __hip_atomic_fetch_add(p, v, __ATOMIC_RELAXED, __HIP_MEMORY_SCOPE_AGENT); }
__device__ __forceinline__ unsigned xb_xcc_id() { return (unsigned)__builtin_amdgcn_s_getreg((3 << 11) | 20) & 0xFu; }
#define XB_SPIN(cond, bar) do { unsigned _sp = 0; while (cond) { __builtin_amdgcn_s_sleep(1); \
    if ((++_sp & 255u) == 0u) { if (xb_ld(&(bar)[XB_TMO])) break; if (_sp > XB_SPIN_CAP) { atomicAdd(&(bar)[XB_TMO], 1u); break; } } } } while (0)

struct XcdBarrier {
    unsigned* bar; unsigned x;
    volatile LAS unsigned* st;
};

__device__ __forceinline__ XcdBarrier xcd_barrier_post(unsigned* bar, volatile LAS unsigned* st) {
    XcdBarrier b; b.bar = bar; b.x = xb_xcc_id(); b.st = st;
    if (threadIdx.x == 0) (void)xb_add(&bar[XB_XCNT(b.x)], 1u);
    return b;
}
__device__ __forceinline__ void xcd_barrier_complete(unsigned* bar, unsigned x, unsigned& nloc, unsigned& nx) {
    const unsigned G = gridDim.x * gridDim.y * gridDim.z;
    unsigned sum, cnt, mine, sp = 0u;
    for (;;) {
        sum = 0u; cnt = 0u; mine = 0u;
#pragma unroll
        for (unsigned j = 0; j < 16; ++j) { const unsigned c = xb_ld(&bar[XB_XCNT(j)]); sum += c; cnt += (c > 0u) ? 1u : 0u; mine = (j == x) ? c : mine; }
        if (sum == G) break;
        __builtin_amdgcn_s_sleep(1);
        if ((++sp & 255u) == 0u) { if (xb_ld(&bar[XB_TMO])) break; if (sp > XB_SPIN_CAP) { atomicAdd(&bar[XB_TMO], 1u); break; } }
    }
    nloc = mine > 0u ? mine : 1u; nx = cnt > 0u ? cnt : 1u;
}

__device__ __forceinline__ void xcd_barrier(const XcdBarrier& b) {
    asm volatile("s_waitcnt vmcnt(0)" ::: "memory");
    __syncthreads();
    if (threadIdx.x == 0) {
        unsigned* bar = b.bar;
        __builtin_amdgcn_s_waitcnt(0);
        unsigned nloc = b.st[0], nx = b.st[1];
        if (nloc == 0u) { xcd_barrier_complete(bar, b.x, nloc, nx); b.st[0] = nloc; b.st[1] = nx; }
        const unsigned old = xb_add(&bar[XB_XSUB(b.x)], 1u);
        const unsigned gen = old / nloc;
        if (old + 1u == (gen + 1u) * nloc) {
            __builtin_amdgcn_fence(__ATOMIC_RELEASE, "agent");
            asm volatile("s_waitcnt vmcnt(0)" ::: "memory");
            const unsigned og = xb_add(&bar[XB_TOP], 1u);
            const unsigned tg = og / nx;
            if (og + 1u == (tg + 1u) * nx) xb_add(&bar[XB_TOPGEN], 1u);
            else XB_SPIN(xb_ld(&bar[XB_TOPGEN]) == tg, bar);
            __builtin_amdgcn_fence(__ATOMIC_ACQUIRE, "agent");
            xb_add(&bar[XB_XGEN(b.x)], 1u);
            asm volatile("s_waitcnt vmcnt(0)" ::: "memory");
        } else {
            XB_SPIN(xb_ld(&bar[XB_XGEN(b.x)]) == gen, bar);
            __builtin_amdgcn_fence(__ATOMIC_ACQUIRE, "agent");
            asm volatile("s_waitcnt vmcnt(0)" ::: "memory");
        }
    }
    __syncthreads();
}


__global__ void __launch_bounds__(512, 2) mega(Args a) {
    extern __shared__ __attribute__((aligned(16))) unsigned char lds_raw[];
    LAS unsigned char* lds = (LAS unsigned char*)lds_raw;
    const int tid = threadIdx.x, lane = tid & 63, wave = __builtin_amdgcn_readfirstlane(tid >> 6);
    const int G = gridDim.x, gw = blockIdx.x * 8 + wave, ngw = G * 8;
    const int lo = a.ph_lo, hi = a.ph_hi;
    if (tid < 16) ((LAS unsigned*)(lds + LDS_BARW))[tid] = 0u;
    __syncthreads();
    XcdBarrier bar; bar.bar = (unsigned*)(a.ws + OFF_CTL); bar.x = 0; bar.st = nullptr;
    if (a.coop) bar = xcd_barrier_post((unsigned*)(a.ws + OFF_CTL), (volatile LAS unsigned*)(lds + LDS_BARW));
#define IN(k) (lo <= (k) && (k) < hi)
#ifndef PROF_SEC
#define PROF_SEC 0
#endif
#ifndef PROF_WG
#define PROF_WG 0
#endif
    unsigned long long bacc = 0ull;
#define SEAM(k) do { if (IN(k) && IN((k) + 1)) { unsigned long long tb_ = 0ull; if (PROF_SEC == 20 && (k) != 0) tb_ = __builtin_amdgcn_s_memrealtime(); if ((k) == 0) cg::this_grid().sync(); else xcd_barrier(bar); \
        if (PROF_SEC == 20 && (k) != 0) bacc += __builtin_amdgcn_s_memrealtime() - tb_; } } while (0)
    if (IN(0)) { phase_prep(a, lds, gw, ngw, wave, lane); __syncthreads(); }
    SEAM(0);
    if (IN(1)) { { pg8::Gemm gm{(const bf16_t*)(a.ws + OFF_H0), (const bf16_t*)(a.ws + OFF_W1T), MTOK, 14336, DM}; pg8::StaticOrder S; S.init(MTOK, 14336, G, (int)blockIdx.x);
          Epi1 E{a.ws, a.out, a.b_in};
          pg8::gemm_phase<Epi1, pg8::StaticOrder, true, true>(lds, gm, S, E); }
        { pg8::Gemm gm{(const bf16_t*)(a.ws + OFF_H0), (const bf16_t*)(a.ws + OFF_W1T) + (size_t)14336 * DM, MTOK, 512, 1024, DM, (size_t)2048, (size_t)2048}; pg8::StaticOrder S; S.init(MTOK, 512, G, (int)blockIdx.x);
          EpiFg E{(float*)(a.ws + OFF_FG), (float*)(a.ws + OFF_FG2)};
          pg8::gemm_phase<EpiFg, pg8::StaticOrder, true, true>(lds, gm, S, E); } }
    SEAM(1);
    if (IN(2)) phase_kt(a, lds, tid);
    SEAM(2);
    if (IN(3)) { if (blockIdx.x < 128) phase_scan(a, lds, tid, wave, lane); else { phase_prep2(a, lds, (blockIdx.x - 128) * 8 + wave, (G - 128) * 8, wave, lane); __syncthreads(); } }
    SEAM(3);
    if (IN(4)) phase_merge(a, lds, tid, wave, lane);
    SEAM(4);
    if (IN(5)) { pg8::Gemm gm{(const bf16_t*)(a.ws + OFF_U), (const bf16_t*)(a.ws + OFF_WOT), MTOK, DM, DM}; pg8::StaticOrder S; S.init(MTOK, DM, G, (int)blockIdx.x);
        EpiRes<false> E{(bf16_t*)(a.ws + OFF_H1PRE), (const bf16_t*)(a.ws + OFF_H0), nullptr};
        pg8::gemm_phase<EpiRes<false>, pg8::StaticOrder, true, true>(lds, gm, S, E); }
    SEAM(5);
    if (IN(6)) { const bf16_t* src = (const bf16_t*)(a.ws + OFF_H1PRE); bf16_t* H1 = (bf16_t*)(a.ws + OFF_H1);
        ln_stream<true, true>(src, H1, a.ln1_g, a.ln1_b, gw, ngw, lane); }
    SEAM(6);
    if (IN(7)) { phase_pconv(a, gw, ngw, lane);
        pg8::Gemm gm{(const bf16_t*)(a.ws + OFF_H1), (const bf16_t*)(a.out + DO_WGUT), MTOK, NGU, DM}; pg8::StaticOrder S; S.init(MTOK, NGU, G, (int)blockIdx.x);
        Epi5 E{(bf16_t*)(a.ws + OFF_ACT), (bf16_t*)(a.ws + OFF_GPG), a.b_pg};
        pg8::gemm_phase<Epi5, pg8::StaticOrder, true, true>(lds, gm, S, E); }
    SEAM(7);
    if (IN(9)) { pg8::Gemm gm{(const bf16_t*)(a.ws + OFF_ACT), (const bf16_t*)(a.out + DO_WDT), MTOK, DM, KX}; pg8::StaticOrder S; S.init(MTOK, DM, G, (int)blockIdx.x);
        EpiDown E{(bf16_t*)(a.ws + OFF_OUTPRE), (const bf16_t*)(a.ws + OFF_H1), (const bf16_t*)(a.ws + OFF_GPG)};
        pg8::gemm_phase<EpiDown, pg8::StaticOrder, true, true>(lds, gm, S, E); }
    SEAM(9);
    if (IN(10)) { const bf16_t* src = (const bf16_t*)(a.ws + OFF_OUTPRE); float* o = (float*)a.out;
        ln_stream<false, true>(src, o, a.ln2_g, a.ln2_b, gw, ngw, lane);
        if (PROF_SEC == 20) { __syncthreads(); if (blockIdx.x == PROF_WG && wave == 0) { const float d = (float)bacc * 0.01f * 5e-4f;
#pragma unroll 1
                for (int k = 0; k < 16; ++k) if (lane == 0) o[(size_t)(gw + k * ngw) * DM] += (k & 1) ? -d : d; } } }
    if (IN(11)) {
        float* o = (float*)a.out;
        if (a.pad == 0) { const bf16_t* src = (const bf16_t*)(a.ws + (size_t)a.coop * MiB);
            for (size_t i = (size_t)blockIdx.x * 512 + tid; i < (size_t)MTOK * DM; i += (size_t)G * 512) o[i] = __uint_as_float(((unsigned)src[i]) << 16); }
        else { const float* src = (const float*)(a.ws + (size_t)a.coop * MiB);
            for (size_t i = (size_t)blockIdx.x * 512 + tid; i < (size_t)MTOK * DM; i += (size_t)G * 512) o[i] = src[i]; }
    }
#undef IN
#undef SEAM
}

#ifndef N_LAUNCH_MODE
#define N_LAUNCH_MODE 1
#endif
extern "C" void kernel_launch(void* const* d_in, const int* in_sizes, int n_in, void* d_out, int out_size, void* d_ws, size_t ws_size, hipStream_t stream) {
    static int grid = 0;
    if (grid == 0) {
        if (n_in != 23 || out_size != MTOK * DM || ws_size < WS_NEED) { fprintf(stderr, "kernel_launch: unexpected shapes (n_in %d out %d ws %zu)\n", n_in, out_size, ws_size); grid = -1; return; }
        int dev = 0, cus = 0, per_cu = 0;
        hipGetDevice(&dev); hipDeviceGetAttribute(&cus, hipDeviceAttributeMultiprocessorCount, dev);
        if (hipFuncSetAttribute((const void*)mega, hipFuncAttributeMaxDynamicSharedMemorySize, LDS_BYTES) != hipSuccess) { fprintf(stderr, "kernel_launch: hipFuncSetAttribute failed\n"); grid = -1; return; }
        hipOccupancyMaxActiveBlocksPerMultiprocessor(&per_cu, (const void*)mega, 512, LDS_BYTES);
        (void)hipGetLastError();
        if (cus != 256 || per_cu < 1) { fprintf(stderr, "kernel_launch: needs 256 CUs with one resident block each (cus %d per_cu %d)\n", cus, per_cu); grid = -1; return; }
        grid = 256;
    }
    if (grid < 0) return;
    Args a{};
    const float** f = (const float**)&a;
    for (int i = 0; i < 23; ++i) f[i] = (const float*)d_in[i];
    a.out = (unsigned char*)d_out; a.ws = (unsigned char*)d_ws;
#if N_LAUNCH_MODE == 1
    a.ph_lo = 0; a.ph_hi = 11; a.coop = 1;
    if (hipMemsetAsync((char*)d_ws + OFF_CTL, 0, 65536, stream) != hipSuccess) { fprintf(stderr, "kernel_launch: memset failed\n"); return; }
    void* args[] = {&a};
    hipError_t e = hipLaunchCooperativeKernel((const void*)mega, dim3(grid), dim3(512), args, LDS_BYTES, stream);
    if (e != hipSuccess) fprintf(stderr, "cooperative launch failed: %s\n", hipGetErrorString(e));
#else
#ifndef DBG_STOP
#define DBG_STOP 10
#endif
#ifndef DBG_OFF_MIB
#define DBG_OFF_MIB 321
#endif
#ifndef DBG_F32
#define DBG_F32 0
#endif
#ifndef PROG
#define PROG {0, 1, 2, 3, 4, 5, 6, 7, 8, 9, 10}
#endif
    static const int prog[] = PROG;
    for (int pi = 0; pi < (int)(sizeof(prog) / sizeof(prog[0])); ++pi) { const int ph = prog[pi]; if (ph > DBG_STOP) break; a.ph_lo = ph; a.ph_hi = ph + 1; a.coop = 0;
        hipLaunchKernelGGL(mega, dim3(grid), dim3(512), LDS_BYTES, stream, a); }
    if (DBG_STOP < 10) { a.ph_lo = 11; a.ph_hi = 12; a.coop = DBG_OFF_MIB; a.pad = DBG_F32;
        hipLaunchKernelGGL(mega, dim3(grid), dim3(512), LDS_BYTES, stream, a); }
#endif
}
```

```cpp
#include <hip/hip_runtime.h>
#include <hip/hip_cooperative_groups.h>
#include <cstdio>
#include <cstdint>
#include <type_traits>
namespace cg = cooperative_groups;
namespace pg8 {
#define PG8_LAS __attribute__((address_space(3)))
typedef unsigned short bf16_t;
typedef short bf16x8 __attribute__((ext_vector_type(8)));
typedef float f32x4 __attribute__((ext_vector_type(4)));
typedef unsigned u32x4 __attribute__((ext_vector_type(4)));
constexpr int BM = 256, BK = 64, HALF = 128, HTB = HALF * BK * 2  , STAGE_BYTES = 8 * HTB, NXCD = 8, WGM = 8;

__host__ __device__ __forceinline__ int lds_byte(int r, int c) { const int st = (r >> 4) * 2 + (c >> 5), rr = r & 15, cc = c & 31, ob = rr * 64 + cc * 2; return st * 1024 + (ob ^ (((ob >> 9) & 1) << 5)); }
__host__ __device__ __forceinline__ void stage_rc(int b, int& R, int& C) { const int st = b / 1024, sb = b % 1024, swz = sb ^ (((sb >> 9) & 1) << 5); R = (st >> 1) * 16 + swz / 64; C = (st & 1) * 32 + (swz % 64) / 2; }
__host__ __device__ __forceinline__ int perm32(int rho) { const int n = rho >> 4, i = rho & 15; return 8 * (i >> 2) + 4 * n + (i & 3); }

struct Unit { int pm, pn; };
struct Gemm { const bf16_t* A; const bf16_t* Bt; int M, N, K; int ld = 0; size_t a_pn = 0; size_t b_pn = ~(size_t)0; };

struct StaticOrder {
    int nM, nN, nwg, G, c;
    __host__ __device__ void init(int M, int N, int G_, int c_) { nM = M / BM; nN = N / BM; nwg = nM * nN; G = G_; c = c_; }
    __host__ __device__ bool next(int i, Unit& u) const {
        const long L = (long)i * G + c; if (L >= nwg) return false;
        int wgid = (int)L; { const int q = nwg / NXCD, r = nwg % NXCD, xcd = wgid % NXCD, off = wgid / NXCD; wgid = (xcd < r ? xcd * (q + 1) : r * (q + 1) + (xcd - r) * q) + off; }
        const int nig = WGM * nN, gid = wgid / nig, fm = gid * WGM, gsz = (nM - fm) < WGM ? (nM - fm) : WGM;
        u.pm = fm + ((wgid % nig) % gsz); u.pn = (wgid % nig) / gsz; return true;
    }
    __device__ __forceinline__ void a_ready(const Unit&) const {}
    __device__ __forceinline__ void done(const Unit&) const {}
};
__device__ __forceinline__ unsigned cvt_pk_bf16(float lo, float hi) { unsigned r; asm volatile("v_cvt_pk_bf16_f32 %0, %1, %2" : "=v"(r) : "v"(lo), "v"(hi)); return r; }
typedef float f32x2 __attribute__((ext_vector_type(2)));
__device__ __forceinline__ f32x2 gelu_pk(f32x2 v) {
    const f32x2 av = __builtin_elementwise_abs(v), d = av * 0.2316418882f + 1.0f;
    f32x2 t; t.x = __builtin_amdgcn_rcpf(d.x); t.y = __builtin_amdgcn_rcpf(d.y);
    f32x2 q = t * 0.5307027145f + (-0.7265760135f); q = q * t + 0.7107068705f; q = q * t + (-0.142248368f); q = q * t + 0.127414796f; q = q * t;
    const f32x2 s = (v * v) * (-0.72134752044f);
    f32x2 e; e.x = __builtin_amdgcn_exp2f(s.x); e.y = __builtin_amdgcn_exp2f(s.y);
    const f32x2 m = v * (q * e), r = v - m;
    f32x2 o; o.x = v.x < 0.f ? m.x : r.x; o.y = v.y < 0.f ? m.y : r.y; return o;
}

template <class Epi, class Sched, bool ALIGN_EPI = false, bool SP2 = false>
__device__ __forceinline__ void gemm_phase(PG8_LAS unsigned char* lds, const Gemm g, const Sched& S, const Epi& E) {
    const int tid = threadIdx.x, wid = __builtin_amdgcn_readfirstlane(tid >> 6), lane = tid & 63, wr = wid >> 2, wc = wid & 3, fr = lane & 15, fq = lane >> 4;
    const int nt = g.K / BK, K = g.ld ? g.ld : g.K;
    unsigned voffA[2], voffB[2];
#pragma unroll
    for (int i = 0; i < 2; ++i) { int R, C; stage_rc(tid * 16 + i * 8192, R, C); const int Rb = Epi::PERM ? ((R & ~31) + perm32(R & 31)) : R;
        voffA[i] = (unsigned)(R * K + C) * 2u; voffB[i] = (unsigned)(Rb * K + C) * 2u; }
    const size_t kstep = (size_t)(BK * 2);
    const size_t hstep = (size_t)HALF * K * 2;
    const size_t tstep = 2 * hstep;
    const unsigned ldsw = (unsigned)wid * 1024u;
    const int aoff = lds_byte(wr * 64 + fr, fq * 8), boff = lds_byte(wc * 32 + fr, fq * 8);
#define PG8_SA(b, h) (((b) * 2 + (h)) * HTB)
#define PG8_SB(b, h) ((4 + (b) * 2 + (h)) * HTB)
#define PG8_STAGE(bufoff, gbase, voff) do { _Pragma("unroll") for (int _i = 0; _i < 2; ++_i) \
        __builtin_amdgcn_global_load_lds((const unsigned*)((const char*)(gbase) + (voff)[_i]), (PG8_LAS unsigned*)(lds + (bufoff) + ldsw + _i * 8192), 16, 0, 0); } while (0)
#define PG8_LDA(dst, b, h) do { _Pragma("unroll") for (int m = 0; m < 4; ++m) _Pragma("unroll") for (int k = 0; k < 2; ++k) dst[m][k] = *(const PG8_LAS bf16x8*)(lds + PG8_SA(b, h) + aoff + m * 2048 + k * 1024); } while (0)
#define PG8_LDB(dst, b, h) do { _Pragma("unroll") for (int n = 0; n < 2; ++n) _Pragma("unroll") for (int k = 0; k < 2; ++k) dst[n][k] = *(const PG8_LAS bf16x8*)(lds + PG8_SB(b, h) + boff + n * 2048 + k * 1024); } while (0)
#define PG8_MMA(ai, bj, At, Bt) do { __builtin_amdgcn_s_setprio(1); _Pragma("unroll") for (int m = 0; m < 4; ++m) _Pragma("unroll") for (int n = 0; n < 2; ++n) _Pragma("unroll") for (int k = 0; k < 2; ++k) \
        acc[ai][bj][m][n] = __builtin_amdgcn_mfma_f32_16x16x32_bf16(Bt[n][k], At[m][k], acc[ai][bj][m][n], 0, 0, 0); __builtin_amdgcn_s_setprio(0); } while (0)
#define PG8_WAIT_V(n) asm volatile("s_waitcnt vmcnt(" #n ")" ::: "memory")
#define PG8_WAIT_L(n) asm volatile("s_waitcnt lgkmcnt(" #n ")" ::: "memory")
#define PG8_BAR __builtin_amdgcn_s_barrier()
#define PG8_SCHED __builtin_amdgcn_sched_barrier(0)
    Unit cur, nxt; int ui = 0;
    if (!S.next(0, cur)) return;
    f32x4 acc[2][2][4][2];
#pragma unroll
    for (int a = 0; a < 2; ++a)
#pragma unroll
        for (int b = 0; b < 2; ++b)
#pragma unroll
            for (int m = 0; m < 4; ++m)
#pragma unroll
                for (int n = 0; n < 2; ++n) acc[a][b][m][n] = (f32x4){0.f, 0.f, 0.f, 0.f};
    bf16x8 At[4][2], B0[2][2], B1[2][2];
    const size_t bpn = g.b_pn == ~(size_t)0 ? tstep : g.b_pn;
    const char* cA = (const char*)g.A + (size_t)cur.pm * tstep + (size_t)cur.pn * g.a_pn; const char* cB = (const char*)g.Bt + (size_t)cur.pn * bpn;
    S.a_ready(cur);
    if constexpr (SP2) {
        PG8_STAGE(PG8_SB(0, 0), cB, voffB); PG8_STAGE(PG8_SB(0, 1), cB + hstep, voffB); PG8_STAGE(PG8_SA(0, 0), cA, voffA); PG8_STAGE(PG8_SA(0, 1), cA + hstep, voffA);
        if (wr == 1) PG8_BAR;
        PG8_WAIT_V(2); PG8_BAR;
        PG8_STAGE(PG8_SB(1, 0), cB + kstep, voffB); PG8_STAGE(PG8_SA(1, 0), cA + kstep, voffA); PG8_STAGE(PG8_SB(1, 1), cB + hstep + kstep, voffB);
        PG8_WAIT_V(6); PG8_BAR;
    } else {
        PG8_STAGE(PG8_SB(0, 0), cB, voffB); PG8_STAGE(PG8_SA(0, 0), cA, voffA); PG8_STAGE(PG8_SB(0, 1), cB + hstep, voffB); PG8_STAGE(PG8_SA(0, 1), cA + hstep, voffA);
        if (wr == 1) PG8_BAR;
        PG8_WAIT_V(4); PG8_BAR;
        PG8_STAGE(PG8_SB(1, 0), cB + kstep, voffB); PG8_STAGE(PG8_SA(1, 0), cA + kstep, voffA); PG8_STAGE(PG8_SB(1, 1), cB + hstep + kstep, voffB);
        PG8_WAIT_V(6); PG8_BAR;
    }
    for (;;) {
        const bool has_next = S.next(ui + 1, nxt);
        const char* nA = has_next ? (const char*)g.A + (size_t)nxt.pm * tstep + (size_t)nxt.pn * g.a_pn : cA; const char* nB = has_next ? (const char*)g.Bt + (size_t)nxt.pn * bpn : cB;
        for (int t = 0; t < nt; t += 2) {
            const bool last = (t == nt - 2);
            const char* a1 = cA + (size_t)(t + 1) * kstep;
            const char* a2 = last ? nA : cA + (size_t)(t + 2) * kstep; const char* b2 = last ? nB : cB + (size_t)(t + 2) * kstep;
            const char* a3 = a2 + kstep; const char* b3 = b2 + kstep;
            if (last && has_next) S.a_ready(nxt);
            if constexpr (Epi::HOOK_T > 0) { if (t == Epi::HOOK_T) E.hook(acc, cur, wr, wc, fr, fq); }
            if constexpr (SP2) {
            PG8_LDB(B0, 0, 0); PG8_LDB(B1, 0, 1); PG8_SCHED; PG8_LDA(At, 0, 0); PG8_STAGE(PG8_SA(1, 1), a1 + hstep, voffA);
            PG8_WAIT_V(8); PG8_WAIT_L(0); PG8_BAR; PG8_MMA(0, 0, At, B0); PG8_MMA(0, 1, At, B1); PG8_BAR; PG8_SCHED;
            PG8_LDA(At, 0, 1); PG8_STAGE(PG8_SB(0, 0), b2, voffB); PG8_STAGE(PG8_SB(0, 1), b2 + hstep, voffB); PG8_STAGE(PG8_SA(0, 0), a2, voffA);
            PG8_WAIT_V(8); PG8_WAIT_L(0); PG8_BAR; PG8_MMA(1, 0, At, B0); PG8_MMA(1, 1, At, B1); PG8_BAR; PG8_SCHED;
            PG8_LDB(B0, 1, 0); PG8_LDB(B1, 1, 1); PG8_SCHED; PG8_LDA(At, 1, 0); PG8_STAGE(PG8_SA(0, 1), a2 + hstep, voffA);
            PG8_WAIT_V(8); PG8_WAIT_L(0); PG8_BAR; PG8_MMA(0, 0, At, B0); PG8_MMA(0, 1, At, B1); PG8_BAR; PG8_SCHED;
            PG8_LDA(At, 1, 1); PG8_STAGE(PG8_SB(1, 0), b3, voffB); PG8_STAGE(PG8_SB(1, 1), b3 + hstep, voffB); PG8_STAGE(PG8_SA(1, 0), a3, voffA);
            PG8_WAIT_V(8); PG8_WAIT_L(0); PG8_BAR; PG8_MMA(1, 0, At, B0); PG8_MMA(1, 1, At, B1); PG8_BAR; PG8_SCHED;
            } else {
            PG8_LDB(B0, 0, 0); PG8_SCHED; PG8_LDA(At, 0, 0); PG8_STAGE(PG8_SA(1, 1), a1 + hstep, voffA);
            PG8_WAIT_L(8); PG8_BAR; PG8_WAIT_L(0); PG8_MMA(0, 0, At, B0); PG8_BAR; PG8_SCHED;
            PG8_LDB(B1, 0, 1); PG8_STAGE(PG8_SB(0, 0), b2, voffB);
            PG8_BAR; PG8_WAIT_L(0); PG8_MMA(0, 1, At, B1); PG8_BAR;
            PG8_LDA(At, 0, 1); PG8_STAGE(PG8_SA(0, 0), a2, voffA);
            PG8_BAR; PG8_WAIT_L(0); PG8_MMA(1, 0, At, B0); PG8_BAR; PG8_SCHED;
            PG8_STAGE(PG8_SB(0, 1), b2 + hstep, voffB);
            PG8_WAIT_V(6); PG8_BAR; PG8_MMA(1, 1, At, B1); PG8_BAR;
            PG8_LDB(B0, 1, 0); PG8_SCHED; PG8_LDA(At, 1, 0); PG8_STAGE(PG8_SA(0, 1), a2 + hstep, voffA);
            PG8_WAIT_L(8); PG8_BAR; PG8_WAIT_L(0); PG8_MMA(0, 0, At, B0); PG8_BAR; PG8_SCHED;
            PG8_LDB(B1, 1, 1); PG8_STAGE(PG8_SB(1, 0), b3, voffB);
            PG8_BAR; PG8_WAIT_L(0); PG8_MMA(0, 1, At, B1); PG8_BAR;
            PG8_LDA(At, 1, 1); PG8_STAGE(PG8_SA(1, 0), a3, voffA);
            PG8_BAR; PG8_WAIT_L(0); PG8_MMA(1, 0, At, B0); PG8_BAR; PG8_SCHED;
            PG8_STAGE(PG8_SB(1, 1), b3 + hstep, voffB);
            PG8_WAIT_V(6); PG8_BAR; PG8_MMA(1, 1, At, B1); PG8_BAR;
            }
        }
        if constexpr (ALIGN_EPI) { if (wr == 0) PG8_BAR; }
        if constexpr (!Epi::AFTER_DRAIN) { E(acc, cur, wr, wc, fr, fq); S.done(cur); }
        if (!has_next) break;
#pragma unroll
        for (int a = 0; a < 2; ++a)
#pragma unroll
            for (int b = 0; b < 2; ++b)
#pragma unroll
                for (int m = 0; m < 4; ++m)
#pragma unroll
                    for (int n = 0; n < 2; ++n) acc[a][b][m][n] = (f32x4){0.f, 0.f, 0.f, 0.f};
        cur = nxt; cA = nA; cB = nB; ++ui;
        if constexpr (ALIGN_EPI) { if (wr == 1) PG8_BAR; }
    }
    PG8_WAIT_V(0);
    if constexpr (!ALIGN_EPI) { if (wr == 0) PG8_BAR; }
    PG8_BAR;
    if constexpr (Epi::AFTER_DRAIN) { E.fused(acc, cur, wr, wc, fr, fq, lds, wid, lane); S.done(cur); }
#undef PG8_SA
#undef PG8_SB
#undef PG8_STAGE
#undef PG8_LDA
#undef PG8_LDB
#undef PG8_MMA
#undef PG8_WAIT_V
#undef PG8_WAIT_L
#undef PG8_BAR
#undef PG8_SCHED
}
}

#define LAS __attribute__((address_space(3)))
typedef unsigned short bf16_t;
typedef short bf16x8 __attribute__((ext_vector_type(8)));
typedef float f32x4 __attribute__((ext_vector_type(4)));
typedef unsigned u32x4 __attribute__((ext_vector_type(4)));
typedef unsigned u32x2 __attribute__((ext_vector_type(2)));

constexpr int KX = 5888  , MTOK = 32768, DM = 2048, NCHUNK = 512  , DFF = 5632, N1 = 14592, NGU = 13312;
constexpr float ALPHA = 1.189207115002721f, LN_EPS = 1e-5f;
constexpr size_t MiB = 1u << 20;
constexpr size_t OFF_W1T = 0, OFF_WOT = 57 * MiB, OFF_H0 = 65 * MiB, OFF_Q = 193 * MiB, OFF_K = 257 * MiB, OFF_V = 321 * MiB, OFF_OG = 449 * MiB,
                 OFF_U = 577 * MiB, OFF_Z = 705 * MiB, OFF_GA = 833 * MiB, OFF_FG = 961 * MiB, OFF_CTL = 969 * MiB, OFF_FG2 = 976 * MiB  , WS_NEED = 984 * MiB;
constexpr size_t OFF_H1PRE = OFF_V, OFF_H1 = OFF_Z, OFF_ACT = OFF_Q  , OFF_GPG = OFF_GA, OFF_OUTPRE = 0;
constexpr size_t DO_GB = 0, DO_PLEB = 0, DO_DEC = 128 * MiB, DO_WGUT = 130 * MiB, DO_WDT = 182 * MiB, DO_WPUT = 204 * MiB, DO_PB = 205 * MiB;
constexpr int LDS_BYTES = 153600, LDS_BARW = 153536;

struct Args {
    const float *x, *p, *ln0_g, *ln0_b, *w_in, *b_in, *w_f2, *b_f2, *gla_g, *gm_g, *gm_b, *w_s, *b_s, *w_o, *ln1_g, *ln1_b, *w_gu, *w_down, *w_pg, *b_pg, *w_pu, *ln2_g, *ln2_b;
    unsigned char* out; unsigned char* ws; int ph_lo, ph_hi, coop, pad;
};

typedef float f32x2_t __attribute__((ext_vector_type(2))); typedef __bf16 bf16x2_t __attribute__((ext_vector_type(2)));
__device__ __forceinline__ unsigned cvtpk_s(float lo, float hi) { f32x2_t v = {lo, hi}; bf16x2_t b = __builtin_convertvector(v, bf16x2_t); return __builtin_bit_cast(unsigned, b); }
__device__ __forceinline__ float bflo(unsigned w) { return __uint_as_float(w << 16); }
__device__ __forceinline__ float bfhi(unsigned w) { return __uint_as_float(w & 0xffff0000u); }
__device__ __forceinline__ float sigm(float x) { return __builtin_amdgcn_rcpf(1.f + __expf(-x)); }
#define WS_DPP(x, ctrl, rm) __builtin_bit_cast(float, __builtin_amdgcn_update_dpp(0, __builtin_bit_cast(int, (x)), (ctrl), (rm), 0xf, false))
__device__ __forceinline__ float wave_sum(float v) {
    v += WS_DPP(v, 0xb1, 0xf); v += WS_DPP(v, 0x4e, 0xf); v += WS_DPP(v, 0x124, 0xf); v += WS_DPP(v, 0x128, 0xf); v += WS_DPP(v, 0x142, 0xa); v += WS_DPP(v, 0x143, 0xc);
    return __builtin_bit_cast(float, __builtin_amdgcn_readlane(__builtin_bit_cast(int, v), 63));
}
#define LDS_WAIT() asm volatile("s_waitcnt lgkmcnt(0)" ::: "memory")

using pg8::Unit;
using pg8::gelu_pk;
typedef float f32x2 __attribute__((ext_vector_type(2)));

__device__ __forceinline__ void act8(f32x4& v0, f32x4& v1, int mode) {
    if (mode == 0) { v0 = v0 * 0.0625f; v1 = v1 * 0.0625f; }
    else if (mode == 2) {
#pragma unroll
        for (int j = 0; j < 4; ++j) { v0[j] = v0[j] * sigm(v0[j]); v1[j] = v1[j] * sigm(v1[j]); } }
    else if (mode == 3) { f32x2 a = gelu_pk((f32x2){v0[0], v0[1]}), b = gelu_pk((f32x2){v0[2], v0[3]}), c = gelu_pk((f32x2){v1[0], v1[1]}), d = gelu_pk((f32x2){v1[2], v1[3]});
        v0 = (f32x4){a.x, a.y, b.x, b.y}; v1 = (f32x4){c.x, c.y, d.x, d.y}; }
    else if (mode == 4) {
#pragma unroll
        for (int j = 0; j < 4; ++j) { v0[j] = sigm(v0[j]); v1[j] = sigm(v1[j]); } }
}

struct Epi1 {
    static constexpr bool PERM = true, AFTER_DRAIN = false; static constexpr int HOOK_T = 0;
    unsigned char* ws; unsigned char* dout; const float* b_in;
    __device__ __forceinline__ void operator()(const f32x4 (&acc)[2][2][4][2], const Unit& u, int wr, int wc, int fr, int fq) const {
        const int pn = u.pn; const int row0 = u.pm * 256 + wr * 64 + fr;
        if (pn == 56) {
            if (wc < 2) {
                float* FG = (float*)(ws + OFF_FG); const int c0 = wc * 32 + 8 * fq;
                const f32x4 b0 = *(const f32x4*)(b_in + 6144 + c0), b1 = *(const f32x4*)(b_in + 6144 + c0 + 4);
#pragma unroll
                for (int ai = 0; ai < 2; ++ai)
#pragma unroll
                    for (int m = 0; m < 4; ++m) { float* rp = FG + (size_t)(row0 + ai * 128 + m * 16) * 64 + c0;
                        *(f32x4*)rp = acc[ai][0][m][0] + b0; *(f32x4*)(rp + 4) = acc[ai][0][m][1] + b1; }
            }
            return;
        }
        const int cw = wc * 32 + 8 * fq;
        if (pn >= 16 && pn < 48) {
            const bool first = pn < 32; const int t = first ? pn - 16 : pn - 32;
            const float* bA = b_in + (first ? 4096 : 6208) + 128 * t + cw; const float* bB = b_in + (first ? 10304 : 12352) + 128 * t + cw;
            const f32x4 a0 = *(const f32x4*)bA, a1 = *(const f32x4*)(bA + 4), g0 = *(const f32x4*)bB, g1 = *(const f32x4*)(bB + 4);
            bf16_t* rowp0 = (bf16_t*)(ws + (first ? OFF_OG : OFF_U)) + (size_t)row0 * 2048 + 128 * t + cw;
            if (first) pair_body<2>(acc, a0, a1, g0, g1, rowp0); else pair_body<3>(acc, a0, a1, g0, g1, rowp0);
            return;
        }
        int mode, ldc, colt, bsrc; bf16_t* base;
        if (pn < 4) { mode = 0; base = (bf16_t*)(ws + OFF_Q); ldc = 1024; colt = pn * 256; bsrc = pn * 256; }
        else if (pn < 8) { mode = 1; base = (bf16_t*)(ws + OFF_K); ldc = 1024; colt = (pn - 4) * 256; bsrc = pn * 256; }
        else if (pn < 16) { mode = 1; base = (bf16_t*)(ws + OFF_V); ldc = 2048; colt = (pn - 8) * 256; bsrc = pn * 256; }
        else { mode = 3; base = (bf16_t*)(ws + OFF_Z); ldc = 2048; colt = (pn - 48) * 256; bsrc = 8256 + (pn - 48) * 256; }
        f32x4 bv[2][2];
#pragma unroll
        for (int bj = 0; bj < 2; ++bj)
#pragma unroll
            for (int n = 0; n < 2; ++n) bv[bj][n] = *(const f32x4*)(b_in + bsrc + bj * 128 + (mode == 0 ? wc * 32 + 4 * fq + 16 * n : cw + 4 * n));
        bf16_t* rowp0 = base + (size_t)row0 * ldc + colt + cw;
        switch (mode) {
            case 0: body<0>(acc, bv, rowp0, ldc); break;
            case 1: body<1>(acc, bv, rowp0, ldc); break;
            default: body<3>(acc, bv, rowp0, ldc); break;
        }
    }
    template <int MODE> __device__ __forceinline__ void body(const f32x4 (&acc)[2][2][4][2], const f32x4 (&bv)[2][2], bf16_t* rowp0, int ldc) const {
#pragma unroll
        for (int ai = 0; ai < 2; ++ai)
#pragma unroll
            for (int m = 0; m < 4; ++m) { bf16_t* rowp = rowp0 + (size_t)(ai * 128 + m * 16) * ldc;
#pragma unroll
                for (int bj = 0; bj < 2; ++bj) { f32x4 v0 = acc[ai][bj][m][0] + bv[bj][0], v1 = acc[ai][bj][m][1] + bv[bj][1];
                    act8(v0, v1, MODE);
                    u32x4 w; w.x = cvtpk_s(v0[0], v0[1]); w.y = cvtpk_s(v0[2], v0[3]); w.z = cvtpk_s(v1[0], v1[1]); w.w = cvtpk_s(v1[2], v1[3]);
                    *(u32x4*)(rowp + bj * 128) = w; } }
    }
    template <int MODE> __device__ __forceinline__ void pair_body(const f32x4 (&acc)[2][2][4][2], const f32x4 a0, const f32x4 a1, const f32x4 g0, const f32x4 g1, bf16_t* rowp0) const {
#pragma unroll
        for (int ai = 0; ai < 2; ++ai)
#pragma unroll
            for (int m = 0; m < 4; ++m) { f32x4 v0 = acc[ai][0][m][0] + a0, v1 = acc[ai][0][m][1] + a1, s0 = acc[ai][1][m][0] + g0, s1 = acc[ai][1][m][1] + g1;
                act8(v0, v1, MODE); act8(s0, s1, 4);
                v0 = v0 * s0; v1 = v1 * s1;
                u32x4 w; w.x = cvtpk_s(v0[0], v0[1]); w.y = cvtpk_s(v0[2], v0[3]); w.z = cvtpk_s(v1[0], v1[1]); w.w = cvtpk_s(v1[2], v1[3]);
                *(u32x4*)(rowp0 + (size_t)(ai * 128 + m * 16) * 2048) = w; }
    }
};

struct EpiFg {
    static constexpr bool PERM = true, AFTER_DRAIN = false; static constexpr int HOOK_T = 0;
    float* P0; float* P1;
    __device__ __forceinline__ void operator()(const f32x4 (&acc)[2][2][4][2], const Unit& u, int wr, int wc, int fr, int fq) const {
        if (wc >= 2) return;
        float* FG = u.pn ? P1 : P0; const int row0 = u.pm * 256 + wr * 64 + fr, c0 = wc * 32 + 8 * fq;
#pragma unroll
        for (int ai = 0; ai < 2; ++ai)
#pragma unroll
            for (int m = 0; m < 4; ++m) { float* rp = FG + (size_t)(row0 + ai * 128 + m * 16) * 64 + c0; *(f32x4*)rp = acc[ai][0][m][0]; *(f32x4*)(rp + 4) = acc[ai][0][m][1]; }
    }
};

template <bool HAS_P> struct EpiRes {
    static constexpr bool PERM = true, AFTER_DRAIN = false; static constexpr int HOOK_T = 0;
    bf16_t* out; const bf16_t* R; const bf16_t* P;
    __device__ __forceinline__ void operator()(const f32x4 (&acc)[2][2][4][2], const Unit& u, int wr, int wc, int fr, int fq) const {
        const int row0 = u.pm * 256 + wr * 64 + fr, col0 = u.pn * 256 + wc * 32 + 8 * fq;
#pragma unroll
        for (int ai = 0; ai < 2; ++ai)
#pragma unroll
            for (int mh = 0; mh < 2; ++mh) {
                u32x4 rr[2][2], qq[2][2];
#pragma unroll
                for (int m2 = 0; m2 < 2; ++m2)
#pragma unroll
                    for (int bj = 0; bj < 2; ++bj) { const size_t off = (size_t)(row0 + ai * 128 + (2 * mh + m2) * 16) * DM + col0 + bj * 128;
                        rr[m2][bj] = *(const u32x4*)(R + off); if (HAS_P) qq[m2][bj] = *(const u32x4*)(P + off); }
#pragma unroll
                for (int m2 = 0; m2 < 2; ++m2)
#pragma unroll
                    for (int bj = 0; bj < 2; ++bj) { const int m = 2 * mh + m2; const size_t off = (size_t)(row0 + ai * 128 + m * 16) * DM + col0 + bj * 128; const u32x4 r = rr[m2][bj];
                        f32x4 v0 = acc[ai][bj][m][0], v1 = acc[ai][bj][m][1];
                        v0 += (f32x4){bflo(r.x), bfhi(r.x), bflo(r.y), bfhi(r.y)} * ALPHA; v1 += (f32x4){bflo(r.z), bfhi(r.z), bflo(r.w), bfhi(r.w)} * ALPHA;
                        if (HAS_P) { const u32x4 q = qq[m2][bj];
                            v0 += (f32x4){bflo(q.x), bfhi(q.x), bflo(q.y), bfhi(q.y)}; v1 += (f32x4){bflo(q.z), bfhi(q.z), bflo(q.w), bfhi(q.w)}; }
                        u32x4 w; w.x = cvtpk_s(v0[0], v0[1]); w.y = cvtpk_s(v0[2], v0[3]); w.z = cvtpk_s(v1[0], v1[1]); w.w = cvtpk_s(v1[2], v1[3]);
                        *(u32x4*)(out + off) = w; }
                asm volatile("" ::: "memory");
            }
    }
};

struct EpiDown {
    static constexpr bool PERM = true, AFTER_DRAIN = false; static constexpr int HOOK_T = 4;
    bf16_t* out; const bf16_t* R; const bf16_t* G;
    __device__ __forceinline__ void hook(f32x4 (&acc)[2][2][4][2], const Unit& u, int wr, int wc, int fr, int fq) const {
        unsigned zoff; asm volatile("v_mov_b32 %0, 0" : "=v"(zoff));
        const bf16_t* gp = G + (size_t)(u.pm * 256 + wr * 64 + fr) * DM + u.pn * 256 + wc * 32 + 8 * fq + zoff;
#pragma unroll
        for (int ai = 0; ai < 2; ++ai)
#pragma unroll
            for (int mh = 0; mh < 2; ++mh) {
                u32x4 rr[2][2];
#pragma unroll
                for (int m2 = 0; m2 < 2; ++m2)
#pragma unroll
                    for (int bj = 0; bj < 2; ++bj) rr[m2][bj] = *(const u32x4*)(gp + (size_t)(ai * 128 + (2 * mh + m2) * 16) * DM + bj * 128);
#pragma unroll
                for (int m2 = 0; m2 < 2; ++m2)
#pragma unroll
                    for (int bj = 0; bj < 2; ++bj) { const u32x4 r = rr[m2][bj]; const int m = 2 * mh + m2;
                        acc[ai][bj][m][0] *= (f32x4){bflo(r.x), bfhi(r.x), bflo(r.y), bfhi(r.y)}; acc[ai][bj][m][1] *= (f32x4){bflo(r.z), bfhi(r.z), bflo(r.w), bfhi(r.w)}; }
                asm volatile("" ::: "memory");
            }
    }
    __device__ __forceinline__ void operator()(const f32x4 (&acc)[2][2][4][2], const Unit& u, int wr, int wc, int fr, int fq) const {
        const int row0 = u.pm * 256 + wr * 64 + fr, col0 = u.pn * 256 + wc * 32 + 8 * fq;
#pragma unroll
        for (int ai = 0; ai < 2; ++ai)
#pragma unroll
            for (int m = 0; m < 4; ++m)
#pragma unroll
                for (int bj = 0; bj < 2; ++bj) { const size_t off = (size_t)(row0 + ai * 128 + m * 16) * DM + col0 + bj * 128; const u32x4 r = *(const u32x4*)(R + off);
                    f32x4 v0 = acc[ai][bj][m][0], v1 = acc[ai][bj][m][1];
                    v0 += (f32x4){bflo(r.x), bfhi(r.x), bflo(r.y), bfhi(r.y)} * ALPHA; v1 += (f32x4){bflo(r.z), bfhi(r.z), bflo(r.w), bfhi(r.w)} * ALPHA;
                    u32x4 w; w.x = cvtpk_s(v0[0], v0[1]); w.y = cvtpk_s(v0[2], v0[3]); w.z = cvtpk_s(v1[0], v1[1]); w.w = cvtpk_s(v1[2], v1[3]);
                    *(u32x4*)(out + off) = w; }
    }
};

struct Epi5 {
    static constexpr bool PERM = true, AFTER_DRAIN = false; static constexpr int HOOK_T = 0;
    bf16_t* ACT; bf16_t* GPG; const float* b_pg;
    __device__ __forceinline__ void operator()(const f32x4 (&acc)[2][2][4][2], const Unit& u, int wr, int wc, int fr, int fq) const {
        const int pn = u.pn; const int row0 = u.pm * 256 + wr * 64 + fr, cw = wc * 32 + 8 * fq;
        if (pn < 44) {
#pragma unroll
            for (int ai = 0; ai < 2; ++ai)
#pragma unroll
                for (int m = 0; m < 4; ++m) { bf16_t* rowp = ACT + (size_t)(row0 + ai * 128 + m * 16) * KX + 256 + pn * 128 + cw;
                    f32x4 g0 = acc[ai][0][m][0], g1 = acc[ai][0][m][1]; const f32x4 u0 = acc[ai][1][m][0], u1 = acc[ai][1][m][1];
#pragma unroll
                    for (int j = 0; j < 4; ++j) { g0[j] = g0[j] * sigm(g0[j]) * u0[j]; g1[j] = g1[j] * sigm(g1[j]) * u1[j]; }
                    u32x4 w; w.x = cvtpk_s(g0[0], g0[1]); w.y = cvtpk_s(g0[2], g0[3]); w.z = cvtpk_s(g1[0], g1[1]); w.w = cvtpk_s(g1[2], g1[3]);
                    *(u32x4*)rowp = w; }
        } else {
            const int colt = (pn - 44) * 256;
            f32x4 bv[2][2];
#pragma unroll
            for (int bj = 0; bj < 2; ++bj)
#pragma unroll
                for (int n = 0; n < 2; ++n) bv[bj][n] = *(const f32x4*)(b_pg + colt + bj * 128 + cw + 4 * n);
#pragma unroll
            for (int ai = 0; ai < 2; ++ai)
#pragma unroll
                for (int m = 0; m < 4; ++m) { bf16_t* rowp = GPG + (size_t)(row0 + ai * 128 + m * 16) * DM + colt + cw;
#pragma unroll
                    for (int bj = 0; bj < 2; ++bj) { f32x4 v0 = acc[ai][bj][m][0] + bv[bj][0], v1 = acc[ai][bj][m][1] + bv[bj][1];
                        act8(v0, v1, 4);
                        u32x4 w; w.x = cvtpk_s(v0[0], v0[1]); w.y = cvtpk_s(v0[2], v0[3]); w.z = cvtpk_s(v1[0], v1[1]); w.w = cvtpk_s(v1[2], v1[3]);
                        *(u32x4*)(rowp + bj * 128) = w; } }
        }
    }
};

struct EpiPle {
    static constexpr bool PERM = true, AFTER_DRAIN = false; static constexpr int HOOK_T = 0;
    bf16_t* O; const bf16_t* G;
    __device__ __forceinline__ void operator()(const f32x4 (&acc)[2][2][4][2], const Unit& u, int wr, int wc, int fr, int fq) const {
        const int row0 = u.pm * 256 + wr * 64 + fr, col0 = u.pn * 256 + wc * 32 + 8 * fq;
#pragma unroll
        for (int ai = 0; ai < 2; ++ai) {
            u32x4 rr[4][2];
#pragma unroll
            for (int m = 0; m < 4; ++m)
#pragma unroll
                for (int bj = 0; bj < 2; ++bj) rr[m][bj] = *(const u32x4*)(G + (size_t)(row0 + ai * 128 + m * 16) * DM + col0 + bj * 128);
#pragma unroll
            for (int m = 0; m < 4; ++m)
#pragma unroll
                for (int bj = 0; bj < 2; ++bj) { const size_t off = (size_t)(row0 + ai * 128 + m * 16) * DM + col0 + bj * 128; const u32x4 r = rr[m][bj];
                    const f32x4 v0 = acc[ai][bj][m][0] * (f32x4){bflo(r.x), bfhi(r.x), bflo(r.y), bfhi(r.y)}, v1 = acc[ai][bj][m][1] * (f32x4){bflo(r.z), bfhi(r.z), bflo(r.w), bfhi(r.w)};
                    u32x4 w; w.x = cvtpk_s(v0[0], v0[1]); w.y = cvtpk_s(v0[2], v0[3]); w.z = cvtpk_s(v1[0], v1[1]); w.w = cvtpk_s(v1[2], v1[3]);
                    *(u32x4*)(O + off) = w; }
            asm volatile("" ::: "memory");
        }
    }
};

__device__ __forceinline__ int dkmap32(int pos) { const int qq = pos >> 3, jj = pos & 7; return jj < 4 ? 4 * qq + jj : 16 + 4 * qq + (jj - 4); }
__device__ __forceinline__ void tr_item(const float* W, int ldw, int srccol0, int k0, bf16_t* WT, int ldt, int dstrow0, LAS float* scr, int lane, bool zero, int dk0 = 0, bool qperm = false) {
    if (!zero) {
        f32x4 tv[8];
#pragma unroll
        for (int i = 0; i < 8; ++i) tv[i] = *(const f32x4*)(W + (size_t)(k0 + 8 * i + (lane >> 3)) * ldw + srccol0 + 4 * (lane & 7));
#pragma unroll
        for (int i = 0; i < 8; ++i) { LAS float* d = scr + (8 * i + (lane >> 3)) * 33 + 4 * (lane & 7); d[0] = tv[i][0]; d[1] = tv[i][1]; d[2] = tv[i][2]; d[3] = tv[i][3]; }
    }
    LDS_WAIT();
    const int c = lane & 7;
#pragma unroll
    for (int j = 0; j < 4; ++j) { const int n = (lane >> 3) + 8 * j; const LAS float* s = scr + (8 * c) * 33 + (qperm ? dkmap32(n) : n);
        u32x4 o; o.x = cvtpk_s(s[0 * 33], s[1 * 33]); o.y = cvtpk_s(s[2 * 33], s[3 * 33]); o.z = cvtpk_s(s[4 * 33], s[5 * 33]); o.w = cvtpk_s(s[6 * 33], s[7 * 33]);
        if (zero) o = (u32x4){0u, 0u, 0u, 0u};
        *(u32x4*)(WT + (size_t)(dstrow0 + n) * ldt + dk0 + k0 + 8 * c) = o; }
    LDS_WAIT();
}
template <bool OUT_BF16> __device__ __forceinline__ void ln_row(const float* in, void* outp, const float* g, const float* b, int lane) {
    const f32x4* xr = (const f32x4*)in + lane;
    f32x4 v[8]; float s = 0.f;
#pragma unroll
    for (int j = 0; j < 8; ++j) { v[j] = xr[64 * j]; s += (v[j][0] + v[j][1]) + (v[j][2] + v[j][3]); }
    const float mean = wave_sum(s) * (1.f / DM); float s2 = 0.f;
#pragma unroll
    for (int j = 0; j < 8; ++j) { v[j] = v[j] - mean; s2 += (v[j][0] * v[j][0] + v[j][1] * v[j][1]) + (v[j][2] * v[j][2] + v[j][3] * v[j][3]); }
    const float rstd = 1.f / sqrtf(wave_sum(s2) * (1.f / DM) + LN_EPS);
#pragma unroll
    for (int j = 0; j < 8; ++j) { const f32x4 gg = ((const f32x4*)g)[64 * j + lane], bb = ((const f32x4*)b)[64 * j + lane]; const f32x4 o = v[j] * rstd * gg + bb;
        if (OUT_BF16) { u32x2 w; w.x = cvtpk_s(o[0], o[1]); w.y = cvtpk_s(o[2], o[3]); ((u32x2*)outp)[64 * j + lane] = w; }
        else ((f32x4*)outp)[64 * j + lane] = o; }
}
template <bool OUT_BF16, bool IN_BF16 = false> __device__ __forceinline__ void ln_row2(const void* in0, const void* in1, void* out0, void* out1, const float* g, const float* b, int lane) {
    f32x4 v[8], w[8]; float s = 0.f, t = 0.f;
    if (IN_BF16) { const u32x2* x0 = (const u32x2*)in0 + lane; const u32x2* x1 = (const u32x2*)in1 + lane; u32x2 a0[8], a1[8];
#pragma unroll
        for (int j = 0; j < 8; ++j) { a0[j] = x0[64 * j]; a1[j] = x1[64 * j]; }
#pragma unroll
        for (int j = 0; j < 8; ++j) { v[j] = (f32x4){bflo(a0[j].x), bfhi(a0[j].x), bflo(a0[j].y), bfhi(a0[j].y)}; w[j] = (f32x4){bflo(a1[j].x), bfhi(a1[j].x), bflo(a1[j].y), bfhi(a1[j].y)}; }
    } else { const f32x4* x0 = (const f32x4*)in0 + lane; const f32x4* x1 = (const f32x4*)in1 + lane;
#pragma unroll
        for (int j = 0; j < 8; ++j) { v[j] = x0[64 * j]; w[j] = x1[64 * j]; } }
#pragma unroll
    for (int j = 0; j < 8; ++j) { s += (v[j][0] + v[j][1]) + (v[j][2] + v[j][3]); t += (w[j][0] + w[j][1]) + (w[j][2] + w[j][3]); }
#pragma unroll
    for (int o = 1; o < 64; o <<= 1) { s += __shfl_xor(s, o); t += __shfl_xor(t, o); }
    const float m0 = s * (1.f / DM), m1 = t * (1.f / DM); float s2 = 0.f, t2 = 0.f;
#pragma unroll
    for (int j = 0; j < 8; ++j) { v[j] = v[j] - m0; w[j] = w[j] - m1; s2 += (v[j][0] * v[j][0] + v[j][1] * v[j][1]) + (v[j][2] * v[j][2] + v[j][3] * v[j][3]); t2 += (w[j][0] * w[j][0] + w[j][1] * w[j][1]) + (w[j][2] * w[j][2] + w[j][3] * w[j][3]); }
#pragma unroll
    for (int o = 1; o < 64; o <<= 1) { s2 += __shfl_xor(s2, o); t2 += __shfl_xor(t2, o); }
    const float r0 = 1.f / sqrtf(s2 * (1.f / DM) + LN_EPS), r1 = 1.f / sqrtf(t2 * (1.f / DM) + LN_EPS);
#pragma unroll
    for (int j = 0; j < 8; ++j) { const f32x4 gg = ((const f32x4*)g)[64 * j + lane], bb = ((const f32x4*)b)[64 * j + lane]; const f32x4 o0 = v[j] * r0 * gg + bb, o1 = w[j] * r1 * gg + bb;
        if (OUT_BF16) { u32x2 p; p.x = cvtpk_s(o0[0], o0[1]); p.y = cvtpk_s(o0[2], o0[3]); ((u32x2*)out0)[64 * j + lane] = p; p.x = cvtpk_s(o1[0], o1[1]); p.y = cvtpk_s(o1[2], o1[3]); ((u32x2*)out1)[64 * j + lane] = p; }
        else { ((f32x4*)out0)[64 * j + lane] = o0; ((f32x4*)out1)[64 * j + lane] = o1; } }
}

template <bool OUT_BF16, bool IN_BF16> __device__ __forceinline__ void ln_stream(const void* in, void* out, const float* g, const float* b, int gw, int ngw, int lane) {
    typedef typename std::conditional<IN_BF16, u32x2, f32x4>::type raw_t;
    f32x4 gg[8], bb[8];
#pragma unroll
    for (int j = 0; j < 8; ++j) { gg[j] = ((const f32x4*)g)[64 * j + lane]; bb[j] = ((const f32x4*)b)[64 * j + lane]; }
    raw_t cur[2][8], nxt[2][8];
    const int nit = MTOK / (2 * ngw);
#define LN_LOAD(dst, it) do { _Pragma("unroll") for (int r = 0; r < 2; ++r) { const raw_t* rp = (const raw_t*)((const char*)in + (size_t)(gw + (2 * (it) + r) * ngw) * DM * (IN_BF16 ? 2 : 4)) + lane; \
        _Pragma("unroll") for (int j = 0; j < 8; ++j) dst[r][j] = rp[64 * j]; } } while (0)
    LN_LOAD(cur, 0);
    for (int it = 0; it < nit; ++it) {
        if (it + 1 < nit) LN_LOAD(nxt, it + 1);
        f32x4 v[2][8]; float s[2], s2[2];
#pragma unroll
        for (int r = 0; r < 2; ++r) { s[r] = 0.f;
#pragma unroll
            for (int j = 0; j < 8; ++j) { if constexpr (IN_BF16) { const u32x2 w = *(const u32x2*)&cur[r][j]; v[r][j] = (f32x4){bflo(w.x), bfhi(w.x), bflo(w.y), bfhi(w.y)}; } else v[r][j] = *(const f32x4*)&cur[r][j];
                s[r] += (v[r][j][0] + v[r][j][1]) + (v[r][j][2] + v[r][j][3]); } }
        s[0] = wave_sum(s[0]); s[1] = wave_sum(s[1]);
#pragma unroll
        for (int r = 0; r < 2; ++r) { const float mean = s[r] * (1.f / DM); s2[r] = 0.f;
#pragma unroll
            for (int j = 0; j < 8; ++j) { v[r][j] = v[r][j] - mean; s2[r] += (v[r][j][0] * v[r][j][0] + v[r][j][1] * v[r][j][1]) + (v[r][j][2] * v[r][j][2] + v[r][j][3] * v[r][j][3]); } }
        s2[0] = wave_sum(s2[0]); s2[1] = wave_sum(s2[1]);
#pragma unroll
        for (int r = 0; r < 2; ++r) { const float rstd = 1.f / sqrtf(s2[r] * (1.f / DM) + LN_EPS); const size_t row = (size_t)(gw + (2 * it + r) * ngw);
#pragma unroll
            for (int j = 0; j < 8; ++j) { const f32x4 o = v[r][j] * rstd * gg[j] + bb[j];
                if (OUT_BF16) { u32x2 pk; pk.x = cvtpk_s(o[0], o[1]); pk.y = cvtpk_s(o[2], o[3]); ((u32x2*)((bf16_t*)out + row * DM))[64 * j + lane] = pk; }
                else ((f32x4*)((float*)out + row * DM))[64 * j + lane] = o; } }
#pragma unroll
        for (int r = 0; r < 2; ++r)
#pragma unroll
            for (int j = 0; j < 8; ++j) cur[r][j] = nxt[r][j];
    }
#undef LN_LOAD
}

__device__ __forceinline__ void phase_prep(const Args& a, LAS unsigned char* lds, int gw, int ngw, int wave, int lane) {
    LAS float* scr = (LAS float*)(lds + wave * 8448);
    bf16_t* W1T = (bf16_t*)(a.ws + OFF_W1T); bf16_t* WOT = (bf16_t*)(a.ws + OFF_WOT);
    constexpr int I1 = 32 * (N1 / 32), IO = 32 * 64;
    for (int it = gw; it < I1; it += ngw) {
        if (it < I1) { const int kb = it / (N1 / 32), nb = it % (N1 / 32), n0 = nb * 32;
            const bool zero = n0 >= 14400; int src;
            if (n0 < 4096) src = n0;
            else if (n0 < 8192) { const int t = (n0 - 4096) >> 8, wi = n0 & 255; src = wi < 128 ? 4096 + 128 * t + wi : 10304 + 128 * t + (wi - 128); }
            else if (n0 < 12288) { const int t = (n0 - 8192) >> 8, wi = n0 & 255; src = wi < 128 ? 6208 + 128 * t + wi : 12352 + 128 * t + (wi - 128); }
            else if (n0 < 14336) src = 8256 + (n0 - 12288);
            else src = 6144 + (n0 - 14336);
            tr_item(a.w_in, 14400, zero ? 0 : src, kb * 64, W1T, 2048, n0, scr, lane, zero, 0, n0 < 1024); }
        else { const int r = it - I1, kb = r / 64, nb = r % 64; tr_item(a.w_o, 2048, nb * 32, kb * 64, WOT, 2048, nb * 32, scr, lane, false); }
    }
    bf16_t* H0 = (bf16_t*)(a.ws + OFF_H0);
    ln_stream<true, false>(a.x, H0, a.ln0_g, a.ln0_b, gw, ngw, lane);
}
__device__ __forceinline__ void phase_prep2(const Args& a, LAS unsigned char* lds, int gw, int ngw, int wave, int lane) {
    LAS float* scr = (LAS float*)(lds + wave * 8448);
    bf16_t* WGUT = (bf16_t*)(a.out + DO_WGUT); bf16_t* WDT = (bf16_t*)(a.out + DO_WDT);
    constexpr int IG = 32 * (NGU / 32), ID = 88 * 64, IP = 4 * 64;
    { bf16_t* WOT = (bf16_t*)(a.ws + OFF_WOT);
      for (int r = gw; r < 32 * 64; r += ngw) { const int kb = r / 64, nb = r % 64; tr_item(a.w_o, 2048, nb * 32, kb * 64, WOT, 2048, nb * 32, scr, lane, false); } }
    for (int it = gw; it < IG + ID + IP; it += ngw) {
        if (it < IG) { const int kb = it / (NGU / 32), nb = it % (NGU / 32), n0 = nb * 32, t = n0 >> 8, wi = n0 & 255;
            if (t < 44) tr_item(a.w_gu, 2 * DFF, wi < 128 ? t * 128 + wi : DFF + t * 128 + (wi - 128), kb * 64, WGUT, 2048, n0, scr, lane, false);
            else tr_item(a.w_pg, 2048, (t - 44) * 256 + wi, kb * 64, WGUT, 2048, n0, scr, lane, false); }
        else if (it < IG + ID) { const int r = it - IG, kb = r / 64, nb = r % 64; tr_item(a.w_down, 2048, nb * 32, kb * 64, WDT, KX, nb * 32, scr, lane, false, 256); }
        else { const int r = it - IG - ID, kb = r / 64, nb = r % 64; tr_item(a.w_pu, 2048, nb * 32, kb * 64, WDT, KX, nb * 32, scr, lane, false, 0); }
    }
}
__device__ __forceinline__ void phase_pconv(const Args& a, int gw, int ngw, int lane) {
    bf16_t* ACT = (bf16_t*)(a.ws + OFF_ACT);
    for (int i = gw * 64 + lane; i < MTOK * 64; i += ngw * 64) { const int m = i >> 6, c4 = (i & 63) * 4; const f32x4 v = *(const f32x4*)(a.p + (size_t)m * 256 + c4);
        u32x2 w; w.x = cvtpk_s(v[0], v[1]); w.y = cvtpk_s(v[2], v[3]); *(u32x2*)(ACT + (size_t)m * KX + c4) = w; }
}

__device__ __forceinline__ void phase_kt(const Args& a, LAS unsigned char* lds, int tid) {
    LAS float* fgs = (LAS float*)(lds + 131072);
    bf16_t* Kb = (bf16_t*)(a.ws + OFF_K); const float* FG = (const float*)(a.ws + OFF_FG); const float* FG2 = (const float*)(a.ws + OFF_FG2); float* DEC = (float*)(a.out + DO_DEC);
    const int col2 = 2 * tid, h = col2 >> 8, d = col2 & 255;
    float w0[16], w1[16];
#pragma unroll
    for (int r = 0; r < 16; ++r) { const float2 t = *(const float2*)(a.w_f2 + (h * 16 + r) * 256 + d); w0[r] = t.x; w1[r] = t.y; }
    const float2 bb = *(const float2*)(a.b_f2 + h * 256 + d);
    for (int it = blockIdx.x; it < NCHUNK; it += gridDim.x) {
        const size_t row0 = (size_t)it * 64;
        __syncthreads();
#pragma unroll
        for (int i = 0; i < 2; ++i) { const int p = tid + 512 * i; ((LAS f32x4*)fgs)[p] = ((const f32x4*)(FG + row0 * 64))[p] + ((const f32x4*)(FG2 + row0 * 64))[p] + *(const f32x4*)(a.b_in + 6144 + 4 * (p & 15)); }
        __syncthreads();
        float run0 = 0.f, run1 = 0.f;
        unsigned kwc[8], kwn[8];
#pragma unroll
        for (int tt = 0; tt < 8; ++tt) { kwc[tt] = *(const unsigned*)(Kb + (row0 + 56 + tt) * 1024 + col2); kwn[tt] = 0u; }
        for (int tg = 7; tg >= 0; --tg) {
            if (tg > 0) {
#pragma unroll
                for (int tt = 0; tt < 8; ++tt) kwn[tt] = *(const unsigned*)(Kb + (row0 + (tg - 1) * 8 + tt) * 1024 + col2); }
            float v0[8], v1[8];
#pragma unroll
            for (int tt = 7; tt >= 0; --tt) { const int t = tg * 8 + tt;
                const LAS f32x4* fp = (const LAS f32x4*)(fgs + t * 64 + h * 16);
                float f0 = bb.x, f1 = bb.y;
#pragma unroll
                for (int r4 = 0; r4 < 4; ++r4) { const f32x4 fv = fp[r4];
#pragma unroll
                    for (int j = 0; j < 4; ++j) { f0 += fv[j] * w0[r4 * 4 + j]; f1 += fv[j] * w1[r4 * 4 + j]; } }
                const float la0 = (fminf(f0, 0.f) - __logf(1.f + __expf(-fabsf(f0)))) * 0.0625f, la1 = (fminf(f1, 0.f) - __logf(1.f + __expf(-fabsf(f1)))) * 0.0625f;
                const unsigned kw = kwc[tt];
                v0[tt] = bflo(kw) * __expf(run0); v1[tt] = bfhi(kw) * __expf(run1);
                run0 += la0; run1 += la1; }
            u32x4 p0, p1;
            p0.x = cvtpk_s(v0[0], v0[1]); p0.y = cvtpk_s(v0[2], v0[3]); p0.z = cvtpk_s(v0[4], v0[5]); p0.w = cvtpk_s(v0[6], v0[7]);
            p1.x = cvtpk_s(v1[0], v1[1]); p1.y = cvtpk_s(v1[2], v1[3]); p1.z = cvtpk_s(v1[4], v1[5]); p1.w = cvtpk_s(v1[6], v1[7]);
            *(LAS u32x4*)(lds + col2 * 128 + ((tg ^ (col2 & 7)) << 4)) = p0;
            *(LAS u32x4*)(lds + (col2 + 1) * 128 + ((tg ^ ((col2 + 1) & 7)) << 4)) = p1;
#pragma unroll
            for (int tt = 0; tt < 8; ++tt) kwc[tt] = kwn[tt];
        }
        *(float2*)(DEC + (size_t)it * 1024 + col2) = make_float2(__expf(run0), __expf(run1));
        __syncthreads();
#pragma unroll
        for (int i = 0; i < 16; ++i) { const int p = tid + 512 * i, c = p >> 3, s = p & 7;
            *(u32x4*)(Kb + (size_t)it * 65536 + c * 64 + s * 8) = *(const LAS u32x4*)(lds + c * 128 + ((s ^ (c & 7)) << 4)); }
    }
    __syncthreads();
}

__device__ __forceinline__ void phase_scan(const Args& a, LAS unsigned char* lds, int tid, int wave, int lane) {
    const int bx = blockIdx.x, xcd = bx & 7, jj = bx >> 3, bh = xcd * 2 + (jj >> 3), b = bh >> 2, h = bh & 3, dvb = jj & 7, l15 = lane & 15, q = lane >> 4;
    constexpr int KTB = 0, QB = 65536, VB = 131072, DB = 147456;
    const bf16_t* KT = (const bf16_t*)(a.ws + OFF_K) + (size_t)(b * 128) * 65536 + h * 16384;
    const bf16_t* Qg = (const bf16_t*)(a.ws + OFF_Q) + (size_t)(b * 8192) * 1024 + h * 256;
    bf16_t* Vg = (bf16_t*)(a.ws + OFF_V) + (size_t)(b * 8192) * 2048 + h * 512 + dvb * 64;
    const float* DEC = (const float*)(a.out + DO_DEC) + (size_t)(b * 128) * 1024 + h * 256;
#define SBAR() do { asm volatile("s_waitcnt lgkmcnt(0)" ::: "memory"); __builtin_amdgcn_s_barrier(); asm volatile("" ::: "memory"); } while (0)
    if (wave >= 4) {
        const int lw = wave - 4;
        const unsigned kvo = (unsigned)(((lane >> 3) * 64 + (((lane & 7) ^ ((lane >> 3) & 7)) << 3)) * 2);
        unsigned qvo[8];
#pragma unroll
        for (int i = 0; i < 8; ++i) { const int frl = 2 * i + (lane >> 5); qvo[i] = (unsigned)(((lw * 16 + frl) * 1024 + (((lane & 31) ^ (frl & 15)) << 3)) * 2); }
        const unsigned vvo = (unsigned)(((lane >> 3) * 2048 + (lane & 7) * 8) * 2);
#define G1(cc) do { const int c_ = (cc) > 127 ? 127 : (cc); const char* qb_ = (const char*)(Qg + (size_t)c_ * 65536); LAS unsigned char* d_ = lds + QB + ((cc) & 1) * 32768 + lw * 8192; \
            _Pragma("unroll") for (int i = 0; i < 8; ++i) __builtin_amdgcn_global_load_lds((const unsigned*)(qb_ + qvo[i]), (LAS unsigned*)(d_ + i * 1024), 16, 0, 0); } while (0)
#define G2(cc) do { const int c_ = (cc) > 127 ? 127 : (cc); const char* kb_ = (const char*)(KT + (size_t)c_ * 65536) + lw * 8192; LAS unsigned char* d_ = lds + KTB + ((cc) & 1) * 32768 + lw * 8192; \
            _Pragma("unroll") for (int i = 0; i < 8; ++i) __builtin_amdgcn_global_load_lds((const unsigned*)(kb_ + i * 1024 + kvo), (LAS unsigned*)(d_ + i * 1024), 16, 0, 0); \
            const char* vb_ = (const char*)(Vg + (size_t)(c_ * 64 + lw * 16) * 2048); LAS unsigned char* dv_ = lds + VB + ((cc) & 1) * 8192 + lw * 2048; \
            _Pragma("unroll") for (int i = 0; i < 2; ++i) __builtin_amdgcn_global_load_lds((const unsigned*)(vb_ + (size_t)i * 8 * 2048 * 2 + vvo), (LAS unsigned*)(dv_ + i * 1024), 16, 0, 0); \
            __builtin_amdgcn_global_load_lds((const unsigned*)(DEC + (size_t)c_ * 1024 + lw * 64 + lane), (LAS unsigned*)(lds + DB + ((cc) & 1) * 1024 + lw * 256), 4, 0, 0); } while (0)
        G2(0); G1(0); G2(1);
        for (int c = 0; c < 128; ++c) {
            asm volatile("s_waitcnt vmcnt(19)" ::: "memory");
            SBAR();
            G1(c + 1);
            asm volatile("s_waitcnt vmcnt(19)" ::: "memory");
            SBAR();
            G2(c + 2);
        }
        asm volatile("s_waitcnt vmcnt(0)" ::: "memory");
#undef G1
#undef G2
    } else {
        const unsigned ovo = (unsigned)((l15 * 2048 + 16 * wave + 4 * q) * 2);
        __builtin_amdgcn_s_setprio(2);
        f32x4 accS[16];
#pragma unroll
        for (int i = 0; i < 16; ++i) accS[i] = (f32x4){0.f, 0.f, 0.f, 0.f};
        for (int c = 0; c < 128; ++c) {
            LAS unsigned char* KTs = lds + KTB + (c & 1) * 32768; LAS unsigned char* Qs = lds + QB + (c & 1) * 32768;
            const LAS unsigned short* Vs = (const LAS unsigned short*)(lds + VB + (c & 1) * 8192); LAS float* DECs = (LAS float*)(lds + DB + (c & 1) * 1024);
            SBAR();
            bf16x8 vb0, vb1;
            { const LAS unsigned short* vp = Vs + (8 * q) * 64 + 16 * wave + l15; unsigned w0[4], w1[4];
#pragma unroll
              for (int e = 0; e < 4; ++e) { w0[e] = (unsigned)vp[(2 * e) * 64] | ((unsigned)vp[(2 * e + 1) * 64] << 16); w1[e] = (unsigned)vp[(32 + 2 * e) * 64] | ((unsigned)vp[(32 + 2 * e + 1) * 64] << 16); }
              vb0 = __builtin_bit_cast(bf16x8, (u32x4){w0[0], w0[1], w0[2], w0[3]}); vb1 = __builtin_bit_cast(bf16x8, (u32x4){w1[0], w1[1], w1[2], w1[3]}); }
#define SCAN_KTLD(A0, A1, D, bt) do { _Pragma("unroll") for (int t = 0; t < 4; ++t) { const int dk = 16 * (4 * (bt) + t) + l15; \
                A0[t] = *(const LAS bf16x8*)(KTs + dk * 128 + ((q ^ (dk & 7)) << 4)); A1[t] = *(const LAS bf16x8*)(KTs + dk * 128 + (((4 + q) ^ (dk & 7)) << 4)); \
                D[t] = *(const LAS f32x4*)(DECs + 16 * (4 * (bt) + t) + 4 * q); } } while (0)
#define SCAN_KTMM(A0, A1, D, bt) do { _Pragma("unroll") for (int t = 0; t < 4; ++t) accS[4 * (bt) + t] = __builtin_amdgcn_mfma_f32_16x16x32_bf16(A0[t], vb0, accS[4 * (bt) + t] * D[t], 0, 0, 0); \
            _Pragma("unroll") for (int t = 0; t < 4; ++t) accS[4 * (bt) + t] = __builtin_amdgcn_mfma_f32_16x16x32_bf16(A1[t], vb1, accS[4 * (bt) + t], 0, 0, 0); } while (0)
            {
                bf16x8 xa0[4], xa1[4], ya0[4], ya1[4]; f32x4 xd[4], yd[4];
                SCAN_KTLD(xa0, xa1, xd, 0); __builtin_amdgcn_sched_barrier(0);
                SCAN_KTLD(ya0, ya1, yd, 1); __builtin_amdgcn_sched_barrier(0);
                SCAN_KTMM(xa0, xa1, xd, 0); __builtin_amdgcn_sched_barrier(0);
                SCAN_KTLD(xa0, xa1, xd, 2); __builtin_amdgcn_sched_barrier(0);
                SCAN_KTMM(ya0, ya1, yd, 1); __builtin_amdgcn_sched_barrier(0);
                SCAN_KTLD(ya0, ya1, yd, 3); __builtin_amdgcn_sched_barrier(0);
                SCAN_KTMM(xa0, xa1, xd, 2); __builtin_amdgcn_sched_barrier(0);
                SCAN_KTMM(ya0, ya1, yd, 3); __builtin_amdgcn_sched_barrier(0);
            }
            bf16x8 sf[8];
#pragma unroll
            for (int ks = 0; ks < 8; ++ks) { u32x4 w; w.x = cvtpk_s(accS[2 * ks][0], accS[2 * ks][1]); w.y = cvtpk_s(accS[2 * ks][2], accS[2 * ks][3]);
                w.z = cvtpk_s(accS[2 * ks + 1][0], accS[2 * ks + 1][1]); w.w = cvtpk_s(accS[2 * ks + 1][2], accS[2 * ks + 1][3]); sf[ks] = __builtin_bit_cast(bf16x8, w); }
            SBAR();
            f32x4 o[4];
#pragma unroll
            for (int ft = 0; ft < 4; ++ft) o[ft] = (f32x4){0.f, 0.f, 0.f, 0.f};
#define SCAN_QLD(Q, kb) do { _Pragma("unroll") for (int k2 = 0; k2 < 2; ++k2) _Pragma("unroll") for (int ft = 0; ft < 4; ++ft) { const int fr = 16 * ft + l15, pc = 4 * (2 * (kb) + k2) + q; \
                Q[k2 * 4 + ft] = *(const LAS u32x4*)(Qs + fr * 512 + ((pc ^ (fr & 15)) << 4)); } } while (0)
#define SCAN_QMM(Q, kb) do { _Pragma("unroll") for (int k2 = 0; k2 < 2; ++k2) _Pragma("unroll") for (int ft = 0; ft < 4; ++ft) \
                o[ft] = __builtin_amdgcn_mfma_f32_16x16x32_bf16(sf[2 * (kb) + k2], __builtin_bit_cast(bf16x8, Q[k2 * 4 + ft]), o[ft], 0, 0, 0); } while (0)
            {
                u32x4 xq[8], yq[8];
                SCAN_QLD(xq, 0); __builtin_amdgcn_sched_barrier(0);
                SCAN_QLD(yq, 1); __builtin_amdgcn_sched_barrier(0);
                SCAN_QMM(xq, 0); __builtin_amdgcn_sched_barrier(0);
                SCAN_QLD(xq, 2); __builtin_amdgcn_sched_barrier(0);
                SCAN_QMM(yq, 1); __builtin_amdgcn_sched_barrier(0);
                SCAN_QLD(yq, 3); __builtin_amdgcn_sched_barrier(0);
                SCAN_QMM(xq, 2); __builtin_amdgcn_sched_barrier(0);
                SCAN_QMM(yq, 3); __builtin_amdgcn_sched_barrier(0);
            }
#undef SCAN_KTLD
#undef SCAN_KTMM
#undef SCAN_QLD
#undef SCAN_QMM
#pragma unroll
            for (int ft = 0; ft < 4; ++ft) { u32x2 w; w.x = cvtpk_s(o[ft][0], o[ft][1]); w.y = cvtpk_s(o[ft][2], o[ft][3]);
                *(u32x2*)((char*)(Vg + (size_t)(c * 64 + 16 * ft) * 2048) + ovo) = w; }
        }
        __builtin_amdgcn_s_setprio(0);
    }
    SBAR();
#undef SBAR
}

__device__ __forceinline__ void phase_merge(const Args& a, LAS unsigned char* lds, int tid, int wave, int lane) {
    const int g = blockIdx.x & 3, l15 = lane & 15, q = lane >> 4;
    LAS unsigned char* Ws = lds; LAS unsigned char* ZT = lds + 32768; LAS float* SG = (LAS float*)(lds + 65536); LAS float* MU = (LAS float*)(lds + 65536 + 67584); LAS float* RS = MU + 128; LAS float* RO = MU + 256;
    const bf16_t* Zb = (const bf16_t*)(a.ws + OFF_Z); const bf16_t* Ob = (const bf16_t*)(a.ws + OFF_V); const bf16_t* OGb = (const bf16_t*)(a.ws + OFF_OG);
    bf16_t* Ub = (bf16_t*)(a.ws + OFF_U);
    for (int p = tid; p < 4096; p += 512) { const int i = p >> 5, j4 = (p & 31) * 4; f32x4 v = *(const f32x4*)(a.w_s + (size_t)g * 16384 + i * 128 + j4);
        if ((j4 >> 6) > (i >> 6)) v = (f32x4){0.f, 0.f, 0.f, 0.f};
        u32x2 w; w.x = cvtpk_s(v[0], v[1]); w.y = cvtpk_s(v[2], v[3]);
        *(LAS u32x2*)(Ws + i * 256 + (((j4 >> 3) ^ (i & 7)) << 4) + (j4 & 4) * 2) = w; }
    for (int item = blockIdx.x; item < 1024; item += gridDim.x) {
        const int nb = item >> 2; const size_t row0 = (size_t)nb * 128; const int colg = g * 512;
        __syncthreads();
#pragma unroll 4
        for (int rr = 0; rr < 16; ++rr) { const int i = wave * 16 + rr; const size_t off = (row0 + i) * DM + colg + lane * 8;
            const u32x4 zw = *(const u32x4*)(Zb + off), ow = *(const u32x4*)(Ob + off);
            float z[8] = {bflo(zw.x), bfhi(zw.x), bflo(zw.y), bfhi(zw.y), bflo(zw.z), bfhi(zw.z), bflo(zw.w), bfhi(zw.w)};
            const float o[8] = {bflo(ow.x), bfhi(ow.x), bflo(ow.y), bfhi(ow.y), bflo(ow.z), bfhi(ow.z), bflo(ow.w), bfhi(ow.w)};
            float s = 0.f, so = 0.f;
#pragma unroll
            for (int e = 0; e < 8; ++e) { s += z[e]; so += o[e] * o[e]; }
            const float mean = wave_sum(s) * (1.f / 512.f); so = wave_sum(so); float s2 = 0.f;
#pragma unroll
            for (int e = 0; e < 8; ++e) { const float dd = z[e] - mean; s2 += dd * dd; }
            s2 = wave_sum(s2);
            if (lane == 0) { MU[i] = mean; RS[i] = 1.f / sqrtf(s2 * (1.f / 512.f) + LN_EPS); RO[i] = 1.f / sqrtf(so * (1.f / 512.f) + LN_EPS); } }
        __syncthreads();
        for (int cc = 0; cc < 4; ++cc) {
            const int colc = colg + cc * 128;
            u32x4 uw4[4], ow4[4], gw4[4];
#pragma unroll
            for (int k = 0; k < 4; ++k) { const int p = tid + 512 * k, i = p >> 4, c8 = (p & 15) * 8; const size_t off = (row0 + i) * DM + colc + c8;
                uw4[k] = *(const u32x4*)(Ub + off); ow4[k] = *(const u32x4*)(Ob + off); gw4[k] = *(const u32x4*)(OGb + off); }
            { const int c8 = (tid & 15) * 8;
              const f32x4 g0 = *(const f32x4*)(a.gm_g + colc + c8), g1 = *(const f32x4*)(a.gm_g + colc + c8 + 4), b0 = *(const f32x4*)(a.gm_b + colc + c8), b1 = *(const f32x4*)(a.gm_b + colc + c8 + 4);
#pragma unroll
              for (int i = 0; i < 2; ++i) { const int p = tid + 512 * i, j = (p >> 4) * 2;
                const u32x4 zw = *(const u32x4*)(Zb + (row0 + j) * DM + colc + c8), zx = *(const u32x4*)(Zb + (row0 + j + 1) * DM + colc + c8);
                const float z[8] = {bflo(zw.x), bfhi(zw.x), bflo(zw.y), bfhi(zw.y), bflo(zw.z), bfhi(zw.z), bflo(zw.w), bfhi(zw.w)};
                const float y[8] = {bflo(zx.x), bfhi(zx.x), bflo(zx.y), bfhi(zx.y), bflo(zx.z), bfhi(zx.z), bflo(zx.w), bfhi(zx.w)};
                const float mu0 = MU[j], rs0 = RS[j], mu1 = MU[j + 1], rs1 = RS[j + 1];
#pragma unroll
                for (int e = 0; e < 8; ++e) { const float gg = e < 4 ? g0[e & 3] : g1[e & 3], bb = e < 4 ? b0[e & 3] : b1[e & 3];
                    const float zn0 = (z[e] - mu0) * rs0 * gg + bb, zn1 = (y[e] - mu1) * rs1 * gg + bb;
                    const int c = c8 + e;
                    *(LAS unsigned*)(ZT + c * 256 + (((j >> 3) ^ ((c ^ (c >> 3)) & 7)) << 4) + (j & 7) * 2) = cvtpk_s(zn0, zn1); } } }
            __syncthreads();
            {
                const int c = 16 * wave + l15; bf16x8 zf[4];
#pragma unroll
                for (int ks = 0; ks < 4; ++ks) zf[ks] = *(const LAS bf16x8*)(ZT + c * 256 + (((4 * ks + q) ^ ((c ^ (c >> 3)) & 7)) << 4));
#pragma unroll
                for (int it = 0; it < 8; ++it) { const int i = 16 * it + l15; f32x4 acc = (f32x4){0.f, 0.f, 0.f, 0.f};
#pragma unroll
                    for (int ks = 0; ks < 4; ++ks) { if (it < 4 && ks >= 2) continue;
                        const bf16x8 wf = *(const LAS bf16x8*)(Ws + i * 256 + (((4 * ks + q) ^ (i & 7)) << 4));
                        acc = __builtin_amdgcn_mfma_f32_16x16x32_bf16(wf, zf[ks], acc, 0, 0, 0); }
#pragma unroll
                    for (int r = 0; r < 4; ++r) SG[(16 * it + 4 * q + r) * 132 + c] = acc[r]; }
            }
            __syncthreads();
#pragma unroll
            for (int k = 0; k < 4; ++k) { const int p = tid + 512 * k, i = p >> 4, c8 = (p & 15) * 8; const size_t off = (row0 + i) * DM + colc + c8;
                const u32x4 uw = uw4[k], ow = ow4[k], gw = gw4[k];
                const f32x4 s0 = *(const LAS f32x4*)(SG + i * 132 + c8), s1 = *(const LAS f32x4*)(SG + i * 132 + c8 + 4);
                const f32x4 n0 = *(const f32x4*)(a.gla_g + colc + c8), n1 = *(const f32x4*)(a.gla_g + colc + c8 + 4);
                const float bs = a.b_s[g * 128 + i], ro = RO[i];
                const unsigned uu[4] = {uw.x, uw.y, uw.z, uw.w}, oo[4] = {ow.x, ow.y, ow.z, ow.w}, gg[4] = {gw.x, gw.y, gw.z, gw.w};
                float m[8];
#pragma unroll
                for (int e = 0; e < 8; ++e) { const int wi = e >> 1; const bool hi = e & 1;
                    const float uv = hi ? bfhi(uu[wi]) : bflo(uu[wi]), ov = hi ? bfhi(oo[wi]) : bflo(oo[wi]), gv = hi ? bfhi(gg[wi]) : bflo(gg[wi]);
                    const float sg = (e < 4 ? s0[e & 3] : s1[e & 3]) + bs, ng = e < 4 ? n0[e & 3] : n1[e & 3];
                    m[e] = gv * (ov * ro * ng) + uv * sg; }
                u32x4 w; w.x = cvtpk_s(m[0], m[1]); w.y = cvtpk_s(m[2], m[3]); w.z = cvtpk_s(m[4], m[5]); w.w = cvtpk_s(m[6], m[7]);
                *(u32x4*)(Ub + off) = w; }
        }
    }
    __syncthreads();
}

typedef __attribute__((address_space(1))) unsigned gu32;
#define XB_TMO      128
#define XB_XCNT(j)  (256  + 64 * (j))
#define XB_XSUB(j)  (1280 + 64 * (j))
#define XB_XGEN(j)  (2304 + 64 * (j))
#define XB_TOP      3328
#define XB_TOPGEN   3392
#define XCD_BAR_WORDS 3456
#define XB_SPIN_CAP (1u << 18)

__device__ __forceinline__ unsigned xb_ld(unsigned* p)              { return __hip_atomic_load(p, __ATOMIC_RELAXED, __HIP_MEMORY_SCOPE_AGENT); }
__device__ __forceinline__ unsigned xb_add(unsigned* p, unsigned v) { return __hip_atomic_fetch_add(p, v, __ATOMIC_RELAXED, __HIP_MEMORY_SCOPE_AGENT); }
__device__ __forceinline__ unsigned xb_xcc_id() { return (unsigned)__builtin_amdgcn_s_getreg((3 << 11) | 20) & 0xFu; }
#define XB_SPIN(cond, bar) do { unsigned _sp = 0; while (cond) { __builtin_amdgcn_s_sleep(1); \
    if ((++_sp & 255u) == 0u) { if (xb_ld(&(bar)[XB_TMO])) break; if (_sp > XB_SPIN_CAP) { atomicAdd(&(bar)[XB_TMO], 1u); break; } } } } while (0)

struct XcdBarrier {
    unsigned* bar; unsigned x;
    volatile LAS unsigned* st;
};

__device__ __forceinline__ XcdBarrier xcd_barrier_post(unsigned* bar, volatile LAS unsigned* st) {
    XcdBarrier b; b.bar = bar; b.x = xb_xcc_id(); b.st = st;
    if (threadIdx.x == 0) (void)xb_add(&bar[XB_XCNT(b.x)], 1u);
    return b;
}
__device__ __forceinline__ void xcd_barrier_complete(unsigned* bar, unsigned x, unsigned& nloc, unsigned& nx) {
    const unsigned G = gridDim.x * gridDim.y * gridDim.z;
    unsigned sum, cnt, mine, sp = 0u;
    for (;;) {
        sum = 0u; cnt = 0u; mine = 0u;
#pragma unroll
        for (unsigned j = 0; j < 16; ++j) { const unsigned c = xb_ld(&bar[XB_XCNT(j)]); sum += c; cnt += (c > 0u) ? 1u : 0u; mine = (j == x) ? c : mine; }
        if (sum == G) break;
        __builtin_amdgcn_s_sleep(1);
        if ((++sp & 255u) == 0u) { if (xb_ld(&bar[XB_TMO])) break; if (sp > XB_SPIN_CAP) { atomicAdd(&bar[XB_TMO], 1u); break; } }
    }
    nloc = mine > 0u ? mine : 1u; nx = cnt > 0u ? cnt : 1u;
}

__device__ __forceinline__ void xcd_barrier(const XcdBarrier& b) {
    asm volatile("s_waitcnt vmcnt(0)" ::: "memory");
    __syncthreads();
    if (threadIdx.x == 0) {
        unsigned* bar = b.bar;
        __builtin_amdgcn_s_waitcnt(0);
        unsigned nloc = b.st[0], nx = b.st[1];
        if (nloc == 0u) { xcd_barrier_complete(bar, b.x, nloc, nx); b.st[0] = nloc; b.st[1] = nx; }
        const unsigned old = xb_add(&bar[XB_XSUB(b.x)], 1u);
        const unsigned gen = old / nloc;
        if (old + 1u == (gen + 1u) * nloc) {
            __builtin_amdgcn_fence(__ATOMIC_RELEASE, "agent");
            asm volatile("s_waitcnt vmcnt(0)" ::: "memory");
            const unsigned og = xb_add(&bar[XB_TOP], 1u);
            const unsigned tg = og / nx;
            if (og + 1u == (tg + 1u) * nx) xb_add(&bar[XB_TOPGEN], 1u);
            else XB_SPIN(xb_ld(&bar[XB_TOPGEN]) == tg, bar);
            __builtin_amdgcn_fence(__ATOMIC_ACQUIRE, "agent");
            xb_add(&bar[XB_XGEN(b.x)], 1u);
            asm volatile("s_waitcnt vmcnt(0)" ::: "memory");
        } else {
            XB_SPIN(xb_ld(&bar[XB_XGEN(b.x)]) == gen, bar);
            __builtin_amdgcn_fence(__ATOMIC_ACQUIRE, "agent");
            asm volatile("s_waitcnt vmcnt(0)" ::: "memory");
        }
    }
    __syncthreads();
}


__global__ void __launch_bounds__(512, 2) mega(Args a) {
    extern __shared__ __attribute__((aligned(16))) unsigned char lds_raw[];
    LAS unsigned char* lds = (LAS unsigned char*)lds_raw;
    const int tid = threadIdx.x, lane = tid & 63, wave = __builtin_amdgcn_readfirstlane(tid >> 6);
    const int G = gridDim.x, gw = blockIdx.x * 8 + wave, ngw = G * 8;
    const int lo = a.ph_lo, hi = a.ph_hi;
    if (tid < 16) ((LAS unsigned*)(lds + LDS_BARW))[tid] = 0u;
    __syncthreads();
    XcdBarrier bar; bar.bar = (unsigned*)(a.ws + OFF_CTL); bar.x = 0; bar.st = nullptr;
    if (a.coop) bar = xcd_barrier_post((unsigned*)(a.ws + OFF_CTL), (volatile LAS unsigned*)(lds + LDS_BARW));
#define IN(k) (lo <= (k) && (k) < hi)
#ifndef PROF_SEC
#define PROF_SEC 0
#endif
#ifndef PROF_WG
#define PROF_WG 0
#endif
    unsigned long long bacc = 0ull;
    if (a.pad == 0x7fffffff) cg::this_grid().sync();
#define SEAM(k) do { if (IN(k) && IN((k) + 1)) { unsigned long long tb_ = 0ull; if (PROF_SEC == 20 && (k) != 0) tb_ = __builtin_amdgcn_s_memrealtime(); xcd_barrier(bar); \
        if (PROF_SEC == 20 && (k) != 0) bacc += __builtin_amdgcn_s_memrealtime() - tb_; } } while (0)
    if (IN(0)) { phase_prep(a, lds, gw, ngw, wave, lane); __syncthreads(); }
    SEAM(0);
    if (IN(1)) { { pg8::Gemm gm{(const bf16_t*)(a.ws + OFF_H0), (const bf16_t*)(a.ws + OFF_W1T), MTOK, 14336, DM}; pg8::StaticOrder S; S.init(MTOK, 14336, G, (int)blockIdx.x);
          Epi1 E{a.ws, a.out, a.b_in};
          pg8::gemm_phase<Epi1, pg8::StaticOrder, true, true>(lds, gm, S, E); }
        { pg8::Gemm gm{(const bf16_t*)(a.ws + OFF_H0), (const bf16_t*)(a.ws + OFF_W1T) + (size_t)14336 * DM, MTOK, 512, 1024, DM, (size_t)2048, (size_t)2048}; pg8::StaticOrder S; S.init(MTOK, 512, G, (int)blockIdx.x);
          EpiFg E{(float*)(a.ws + OFF_FG), (float*)(a.ws + OFF_FG2)};
          pg8::gemm_phase<EpiFg, pg8::StaticOrder, true, true>(lds, gm, S, E); } }
    SEAM(1);
    if (IN(2)) phase_kt(a, lds, tid);
    SEAM(2);
    if (IN(3)) { if (blockIdx.x < 128) phase_scan(a, lds, tid, wave, lane); else { phase_prep2(a, lds, (blockIdx.x - 128) * 8 + wave, (G - 128) * 8, wave, lane); __syncthreads(); } }
    SEAM(3);
    if (IN(4)) phase_merge(a, lds, tid, wave, lane);
    SEAM(4);
    if (IN(5)) { pg8::Gemm gm{(const bf16_t*)(a.ws + OFF_U), (const bf16_t*)(a.ws + OFF_WOT), MTOK, DM, DM}; pg8::StaticOrder S; S.init(MTOK, DM, G, (int)blockIdx.x);
        EpiRes<false> E{(bf16_t*)(a.ws + OFF_H1PRE), (const bf16_t*)(a.ws + OFF_H0), nullptr};
        pg8::gemm_phase<EpiRes<false>, pg8::StaticOrder, true, true>(lds, gm, S, E); }
    SEAM(5);
    if (IN(6)) { const bf16_t* src = (const bf16_t*)(a.ws + OFF_H1PRE); bf16_t* H1 = (bf16_t*)(a.ws + OFF_H1);
        ln_stream<true, true>(src, H1, a.ln1_g, a.ln1_b, gw, ngw, lane); }
    SEAM(6);
    if (IN(7)) { phase_pconv(a, gw, ngw, lane);
        pg8::Gemm gm{(const bf16_t*)(a.ws + OFF_H1), (const bf16_t*)(a.out + DO_WGUT), MTOK, NGU, DM}; pg8::StaticOrder S; S.init(MTOK, NGU, G, (int)blockIdx.x);
        Epi5 E{(bf16_t*)(a.ws + OFF_ACT), (bf16_t*)(a.ws + OFF_GPG), a.b_pg};
        pg8::gemm_phase<Epi5, pg8::StaticOrder, true, true>(lds, gm, S, E); }
    SEAM(7);
    if (IN(9)) { pg8::Gemm gm{(const bf16_t*)(a.ws + OFF_ACT), (const bf16_t*)(a.out + DO_WDT), MTOK, DM, KX}; pg8::StaticOrder S; S.init(MTOK, DM, G, (int)blockIdx.x);
        EpiDown E{(bf16_t*)(a.ws + OFF_OUTPRE), (const bf16_t*)(a.ws + OFF_H1), (const bf16_t*)(a.ws + OFF_GPG)};
        pg8::gemm_phase<EpiDown, pg8::StaticOrder, true, true>(lds, gm, S, E); }
    SEAM(9);
    if (IN(10)) { const bf16_t* src = (const bf16_t*)(a.ws + OFF_OUTPRE); float* o = (float*)a.out;
        ln_stream<false, true>(src, o, a.ln2_g, a.ln2_b, gw, ngw, lane);
        if (PROF_SEC == 20) { __syncthreads(); if (blockIdx.x == PROF_WG && wave == 0) { const float d = (float)bacc * 0.01f * 5e-4f;
#pragma unroll 1
                for (int k = 0; k < 16; ++k) if (lane == 0) o[(size_t)(gw + k * ngw) * DM] += (k & 1) ? -d : d; } } }
    if (IN(11)) {
        float* o = (float*)a.out;
        if (a.pad == 0) { const bf16_t* src = (const bf16_t*)(a.ws + (size_t)a.coop * MiB);
            for (size_t i = (size_t)blockIdx.x * 512 + tid; i < (size_t)MTOK * DM; i += (size_t)G * 512) o[i] = __uint_as_float(((unsigned)src[i]) << 16); }
        else { const float* src = (const float*)(a.ws + (size_t)a.coop * MiB);
            for (size_t i = (size_t)blockIdx.x * 512 + tid; i < (size_t)MTOK * DM; i += (size_t)G * 512) o[i] = src[i]; }
    }
#undef IN
#undef SEAM
}

#ifndef N_LAUNCH_MODE
#define N_LAUNCH_MODE 1
#endif
extern "C" void kernel_launch(void* const* d_in, const int* in_sizes, int n_in, void* d_out, int out_size, void* d_ws, size_t ws_size, hipStream_t stream) {
    static int grid = 0;
    if (grid == 0) {
        if (n_in != 23 || out_size != MTOK * DM || ws_size < WS_NEED) { fprintf(stderr, "kernel_launch: unexpected shapes (n_in %d out %d ws %zu)\n", n_in, out_size, ws_size); grid = -1; return; }
        int dev = 0, cus = 0, per_cu = 0;
        hipGetDevice(&dev); hipDeviceGetAttribute(&cus, hipDeviceAttributeMultiprocessorCount, dev);
        if (hipFuncSetAttribute((const void*)mega, hipFuncAttributeMaxDynamicSharedMemorySize, LDS_BYTES) != hipSuccess) { fprintf(stderr, "kernel_launch: hipFuncSetAttribute failed\n"); grid = -1; return; }
        hipOccupancyMaxActiveBlocksPerMultiprocessor(&per_cu, (const void*)mega, 512, LDS_BYTES);
        (void)hipGetLastError();
        if (cus != 256 || per_cu < 1) { fprintf(stderr, "kernel_launch: needs 256 CUs with one resident block each (cus %d per_cu %d)\n", cus, per_cu); grid = -1; return; }
        grid = 256;
    }
    if (grid < 0) return;
    Args a{};
    const float** f = (const float**)&a;
    for (int i = 0; i < 23; ++i) f[i] = (const float*)d_in[i];
    a.out = (unsigned char*)d_out; a.ws = (unsigned char*)d_ws;
#if N_LAUNCH_MODE == 1
    a.ph_lo = 0; a.ph_hi = 11; a.coop = 1;
    if (hipMemsetAsync((char*)d_ws + OFF_CTL, 0, 65536, stream) != hipSuccess) { fprintf(stderr, "kernel_launch: memset failed\n"); return; }
    void* args[] = {&a};
    hipError_t e = hipLaunchCooperativeKernel((const void*)mega, dim3(grid), dim3(512), args, LDS_BYTES, stream);
    if (e != hipSuccess) fprintf(stderr, "cooperative launch failed: %s\n", hipGetErrorString(e));
#else
#ifndef DBG_STOP
#define DBG_STOP 10
#endif
#ifndef DBG_OFF_MIB
#define DBG_OFF_MIB 321
#endif
#ifndef DBG_F32
#define DBG_F32 0
#endif
#ifndef PROG
#define PROG {0, 1, 2, 3, 4, 5, 6, 7, 8, 9, 10}
#endif
    static const int prog[] = PROG;
    for (int pi = 0; pi < (int)(sizeof(prog) / sizeof(prog[0])); ++pi) { const int ph = prog[pi]; if (ph > DBG_STOP) break; a.ph_lo = ph; a.ph_hi = ph + 1; a.coop = 0;
        hipLaunchKernelGGL(mega, dim3(grid), dim3(512), LDS_BYTES, stream, a); }
    if (DBG_STOP < 10) { a.ph_lo = 11; a.ph_hi = 12; a.coop = DBG_OFF_MIB; a.pad = DBG_F32;
        hipLaunchKernelGGL(mega, dim3(grid), dim3(512), LDS_BYTES, stream, a); }
#endif
}
```

```cpp
#include <hip/hip_runtime.h>
#include <hip/hip_cooperative_groups.h>
#include <cstdio>
#include <cstdint>
#include <type_traits>
namespace cg = cooperative_groups;
namespace pg8 {
#define PG8_LAS __attribute__((address_space(3)))
typedef unsigned short bf16_t;
typedef short bf16x8 __attribute__((ext_vector_type(8)));
typedef float f32x4 __attribute__((ext_vector_type(4)));
typedef unsigned u32x4 __attribute__((ext_vector_type(4)));
constexpr int BM = 256, BK = 64, HALF = 128, HTB = HALF * BK * 2  , STAGE_BYTES = 8 * HTB, NXCD = 8, WGM = 8;

__host__ __device__ __forceinline__ int lds_byte(int r, int c) { const int st = (r >> 4) * 2 + (c >> 5), rr = r & 15, cc = c & 31, ob = rr * 64 + cc * 2; return st * 1024 + (ob ^ (((ob >> 9) & 1) << 5)); }
__host__ __device__ __forceinline__ void stage_rc(int b, int& R, int& C) { const int st = b / 1024, sb = b % 1024, swz = sb ^ (((sb >> 9) & 1) << 5); R = (st >> 1) * 16 + swz / 64; C = (st & 1) * 32 + (swz % 64) / 2; }
__host__ __device__ __forceinline__ int perm32(int rho) { const int n = rho >> 4, i = rho & 15; return 8 * (i >> 2) + 4 * n + (i & 3); }

struct Unit { int pm, pn; };
struct Gemm { const bf16_t* A; const bf16_t* Bt; int M, N, K; int ld = 0; size_t a_pn = 0; size_t b_pn = ~(size_t)0; };

struct StaticOrder {
    int nM, nN, nwg, G, c;
    __host__ __device__ void init(int M, int N, int G_, int c_) { nM = M / BM; nN = N / BM; nwg = nM * nN; G = G_; c = c_; }
    __host__ __device__ bool next(int i, Unit& u) const {
        const long L = (long)i * G + c; if (L >= nwg) return false;
        int wgid = (int)L; { const int q = nwg / NXCD, r = nwg % NXCD, xcd = wgid % NXCD, off = wgid / NXCD; wgid = (xcd < r ? xcd * (q + 1) : r * (q + 1) + (xcd - r) * q) + off; }
        const int nig = WGM * nN, gid = wgid / nig, fm = gid * WGM, gsz = (nM - fm) < WGM ? (nM - fm) : WGM;
        u.pm = fm + ((wgid % nig) % gsz); u.pn = (wgid % nig) / gsz; return true;
    }
    __device__ __forceinline__ void a_ready(const Unit&) const {}
    __device__ __forceinline__ void done(const Unit&) const {}
};
__device__ __forceinline__ unsigned cvt_pk_bf16(float lo, float hi) { unsigned r; asm volatile("v_cvt_pk_bf16_f32 %0, %1, %2" : "=v"(r) : "v"(lo), "v"(hi)); return r; }
typedef float f32x2 __attribute__((ext_vector_type(2)));
__device__ __forceinline__ f32x2 gelu_pk(f32x2 v) {
    const f32x2 av = __builtin_elementwise_abs(v), d = av * 0.2316418882f + 1.0f;
    f32x2 t; t.x = __builtin_amdgcn_rcpf(d.x); t.y = __builtin_amdgcn_rcpf(d.y);
    f32x2 q = t * 0.5307027145f + (-0.7265760135f); q = q * t + 0.7107068705f; q = q * t + (-0.142248368f); q = q * t + 0.127414796f; q = q * t;
    const f32x2 s = (v * v) * (-0.72134752044f);
    f32x2 e; e.x = __builtin_amdgcn_exp2f(s.x); e.y = __builtin_amdgcn_exp2f(s.y);
    const f32x2 m = v * (q * e), r = v - m;
    f32x2 o; o.x = v.x < 0.f ? m.x : r.x; o.y = v.y < 0.f ? m.y : r.y; return o;
}

template <class Epi, class Sched, bool ALIGN_EPI = false, bool SP2 = false>
__device__ __forceinline__ void gemm_phase(PG8_LAS unsigned char* lds, const Gemm g, const Sched& S, const Epi& E) {
    const int tid = threadIdx.x, wid = __builtin_amdgcn_readfirstlane(tid >> 6), lane = tid & 63, wr = wid >> 2, wc = wid & 3, fr = lane & 15, fq = lane >> 4;
    const int nt = g.K / BK, K = g.ld ? g.ld : g.K;
    unsigned voffA[2], voffB[2];
#pragma unroll
    for (int i = 0; i < 2; ++i) { int R, C; stage_rc(tid * 16 + i * 8192, R, C); const int Rb = Epi::PERM ? ((R & ~31) + perm32(R & 31)) : R;
        voffA[i] = (unsigned)(R * K + C) * 2u; voffB[i] = (unsigned)(Rb * K + C) * 2u; }
    const size_t kstep = (size_t)(BK * 2);
    const size_t hstep = (size_t)HALF * K * 2;
    const size_t tstep = 2 * hstep;
    const unsigned ldsw = (unsigned)wid * 1024u;
    const int aoff = lds_byte(wr * 64 + fr, fq * 8), boff = lds_byte(wc * 32 + fr, fq * 8);
#define PG8_SA(b, h) (((b) * 2 + (h)) * HTB)
#define PG8_SB(b, h) ((4 + (b) * 2 + (h)) * HTB)
#define PG8_STAGE(bufoff, gbase, voff) do { _Pragma("unroll") for (int _i = 0; _i < 2; ++_i) \
        __builtin_amdgcn_global_load_lds((const unsigned*)((const char*)(gbase) + (voff)[_i]), (PG8_LAS unsigned*)(lds + (bufoff) + ldsw + _i * 8192), 16, 0, 0); } while (0)
#define PG8_LDA(dst, b, h) do { _Pragma("unroll") for (int m = 0; m < 4; ++m) _Pragma("unroll") for (int k = 0; k < 2; ++k) dst[m][k] = *(const PG8_LAS bf16x8*)(lds + PG8_SA(b, h) + aoff + m * 2048 + k * 1024); } while (0)
#define PG8_LDB(dst, b, h) do { _Pragma("unroll") for (int n = 0; n < 2; ++n) _Pragma("unroll") for (int k = 0; k < 2; ++k) dst[n][k] = *(const PG8_LAS bf16x8*)(lds + PG8_SB(b, h) + boff + n * 2048 + k * 1024); } while (0)
#define PG8_MMA(ai, bj, At, Bt) do { __builtin_amdgcn_s_setprio(1); _Pragma("unroll") for (int m = 0; m < 4; ++m) _Pragma("unroll") for (int n = 0; n < 2; ++n) _Pragma("unroll") for (int k = 0; k < 2; ++k) \
        acc[ai][bj][m][n] = __builtin_amdgcn_mfma_f32_16x16x32_bf16(Bt[n][k], At[m][k], acc[ai][bj][m][n], 0, 0, 0); __builtin_amdgcn_s_setprio(0); } while (0)
#define PG8_WAIT_V(n) asm volatile("s_waitcnt vmcnt(" #n ")" ::: "memory")
#define PG8_WAIT_L(n) asm volatile("s_waitcnt lgkmcnt(" #n ")" ::: "memory")
#define PG8_BAR __builtin_amdgcn_s_barrier()
#define PG8_SCHED __builtin_amdgcn_sched_barrier(0)
    Unit cur, nxt; int ui = 0;
    if (!S.next(0, cur)) return;
    f32x4 acc[2][2][4][2];
#pragma unroll
    for (int a = 0; a < 2; ++a)
#pragma unroll
        for (int b = 0; b < 2; ++b)
#pragma unroll
            for (int m = 0; m < 4; ++m)
#pragma unroll
                for (int n = 0; n < 2; ++n) acc[a][b][m][n] = (f32x4){0.f, 0.f, 0.f, 0.f};
    bf16x8 At[4][2], B0[2][2], B1[2][2];
    const size_t bpn = g.b_pn == ~(size_t)0 ? tstep : g.b_pn;
    const char* cA = (const char*)g.A + (size_t)cur.pm * tstep + (size_t)cur.pn * g.a_pn; const char* cB = (const char*)g.Bt + (size_t)cur.pn * bpn;
    S.a_ready(cur);
    if constexpr (SP2) {
        PG8_STAGE(PG8_SB(0, 0), cB, voffB); PG8_STAGE(PG8_SB(0, 1), cB + hstep, voffB); PG8_STAGE(PG8_SA(0, 0), cA, voffA); PG8_STAGE(PG8_SA(0, 1), cA + hstep, voffA);
        if (wr == 1) PG8_BAR;
        PG8_WAIT_V(2); PG8_BAR;
        PG8_STAGE(PG8_SB(1, 0), cB + kstep, voffB); PG8_STAGE(PG8_SA(1, 0), cA + kstep, voffA); PG8_STAGE(PG8_SB(1, 1), cB + hstep + kstep, voffB);
        PG8_WAIT_V(6); PG8_BAR;
    } else {
        PG8_STAGE(PG8_SB(0, 0), cB, voffB); PG8_STAGE(PG8_SA(0, 0), cA, voffA); PG8_STAGE(PG8_SB(0, 1), cB + hstep, voffB); PG8_STAGE(PG8_SA(0, 1), cA + hstep, voffA);
        if (wr == 1) PG8_BAR;
        PG8_WAIT_V(4); PG8_BAR;
        PG8_STAGE(PG8_SB(1, 0), cB + kstep, voffB); PG8_STAGE(PG8_SA(1, 0), cA + kstep, voffA); PG8_STAGE(PG8_SB(1, 1), cB + hstep + kstep, voffB);
        PG8_WAIT_V(6); PG8_BAR;
    }
    for (;;) {
        const bool has_next = S.next(ui + 1, nxt);
        const char* nA = has_next ? (const char*)g.A + (size_t)nxt.pm * tstep + (size_t)nxt.pn * g.a_pn : cA; const char* nB = has_next ? (const char*)g.Bt + (size_t)nxt.pn * bpn : cB;
        for (int t = 0; t < nt; t += 2) {
            const bool last = (t == nt - 2);
            const char* a1 = cA + (size_t)(t + 1) * kstep;
            const char* a2 = last ? nA : cA + (size_t)(t + 2) * kstep; const char* b2 = last ? nB : cB + (size_t)(t + 2) * kstep;
            const char* a3 = a2 + kstep; const char* b3 = b2 + kstep;
            if (last && has_next) S.a_ready(nxt);
            if constexpr (Epi::HOOK_T > 0) { if (t == Epi::HOOK_T) E.hook(acc, cur, wr, wc, fr, fq); }
            if constexpr (SP2) {
            PG8_LDB(B0, 0, 0); PG8_LDB(B1, 0, 1); PG8_SCHED; PG8_LDA(At, 0, 0); PG8_STAGE(PG8_SA(1, 1), a1 + hstep, voffA);
            PG8_WAIT_V(8); PG8_WAIT_L(0); PG8_BAR; PG8_MMA(0, 0, At, B0); PG8_MMA(0, 1, At, B1); PG8_BAR; PG8_SCHED;
            PG8_LDA(At, 0, 1); PG8_STAGE(PG8_SB(0, 0), b2, voffB); PG8_STAGE(PG8_SB(0, 1), b2 + hstep, voffB); PG8_STAGE(PG8_SA(0, 0), a2, voffA);
            PG8_WAIT_V(8); PG8_WAIT_L(0); PG8_BAR; PG8_MMA(1, 0, At, B0); PG8_MMA(1, 1, At, B1); PG8_BAR; PG8_SCHED;
            PG8_LDB(B0, 1, 0); PG8_LDB(B1, 1, 1); PG8_SCHED; PG8_LDA(At, 1, 0); PG8_STAGE(PG8_SA(0, 1), a2 + hstep, voffA);
            PG8_WAIT_V(8); PG8_WAIT_L(0); PG8_BAR; PG8_MMA(0, 0, At, B0); PG8_MMA(0, 1, At, B1); PG8_BAR; PG8_SCHED;
            PG8_LDA(At, 1, 1); PG8_STAGE(PG8_SB(1, 0), b3, voffB); PG8_STAGE(PG8_SB(1, 1), b3 + hstep, voffB); PG8_STAGE(PG8_SA(1, 0), a3, voffA);
            PG8_WAIT_V(8); PG8_WAIT_L(0); PG8_BAR; PG8_MMA(1, 0, At, B0); PG8_MMA(1, 1, At, B1); PG8_BAR; PG8_SCHED;
            } else {
            PG8_LDB(B0, 0, 0); PG8_SCHED; PG8_LDA(At, 0, 0); PG8_STAGE(PG8_SA(1, 1), a1 + hstep, voffA);
            PG8_WAIT_L(8); PG8_BAR; PG8_WAIT_L(0); PG8_MMA(0, 0, At, B0); PG8_BAR; PG8_SCHED;
            PG8_LDB(B1, 0, 1); PG8_STAGE(PG8_SB(0, 0), b2, voffB);
            PG8_BAR; PG8_WAIT_L(0); PG8_MMA(0, 1, At, B1); PG8_BAR;
            PG8_LDA(At, 0, 1); PG8_STAGE(PG8_SA(0, 0), a2, voffA);
            PG8_BAR; PG8_WAIT_L(0); PG8_MMA(1, 0, At, B0); PG8_BAR; PG8_SCHED;
            PG8_STAGE(PG8_SB(0, 1), b2 + hstep, voffB);
            PG8_WAIT_V(6); PG8_BAR; PG8_MMA(1, 1, At, B1); PG8_BAR;
            PG8_LDB(B0, 1, 0); PG8_SCHED; PG8_LDA(At, 1, 0); PG8_STAGE(PG8_SA(0, 1), a2 + hstep, voffA);
            PG8_WAIT_L(8); PG8_BAR; PG8_WAIT_L(0); PG8_MMA(0, 0, At, B0); PG8_BAR; PG8_SCHED;
            PG8_LDB(B1, 1, 1); PG8_STAGE(PG8_SB(1, 0), b3, voffB);
            PG8_BAR; PG8_WAIT_L(0); PG8_MMA(0, 1, At, B1); PG8_BAR;
            PG8_LDA(At, 1, 1); PG8_STAGE(PG8_SA(1, 0), a3, voffA);
            PG8_BAR; PG8_WAIT_L(0); PG8_MMA(1, 0, At, B0); PG8_BAR; PG8_SCHED;
            PG8_STAGE(PG8_SB(1, 1), b3 + hstep, voffB);
            PG8_WAIT_V(6); PG8_BAR; PG8_MMA(1, 1, At, B1); PG8_BAR;
            }
        }
        if constexpr (ALIGN_EPI) { if (wr == 0) PG8_BAR; }
        if constexpr (!Epi::AFTER_DRAIN) { E(acc, cur, wr, wc, fr, fq); S.done(cur); }
        if (!has_next) break;
#pragma unroll
        for (int a = 0; a < 2; ++a)
#pragma unroll
            for (int b = 0; b < 2; ++b)
#pragma unroll
                for (int m = 0; m < 4; ++m)
#pragma unroll
                    for (int n = 0; n < 2; ++n) acc[a][b][m][n] = (f32x4){0.f, 0.f, 0.f, 0.f};
        cur = nxt; cA = nA; cB = nB; ++ui;
        if constexpr (ALIGN_EPI) { if (wr == 1) PG8_BAR; }
    }
    PG8_WAIT_V(0);
    if constexpr (!ALIGN_EPI) { if (wr == 0) PG8_BAR; }
    PG8_BAR;
    if constexpr (Epi::AFTER_DRAIN) { E.fused(acc, cur, wr, wc, fr, fq, lds, wid, lane); S.done(cur); }
#undef PG8_SA
#undef PG8_SB
#undef PG8_STAGE
#undef PG8_LDA
#undef PG8_LDB
#undef PG8_MMA
#undef PG8_WAIT_V
#undef PG8_WAIT_L
#undef PG8_BAR
#undef PG8_SCHED
}
}

#define LAS __attribute__((address_space(3)))
typedef unsigned short bf16_t;
typedef short bf16x8 __attribute__((ext_vector_type(8)));
typedef float f32x4 __attribute__((ext_vector_type(4)));
typedef unsigned u32x4 __attribute__((ext_vector_type(4)));
typedef unsigned u32x2 __attribute__((ext_vector_type(2)));

constexpr int KX = 5888  , MTOK = 32768, DM = 2048, NCHUNK = 512  , DFF = 5632, N1 = 14592, NGU = 13312;
constexpr float ALPHA = 1.189207115002721f, LN_EPS = 1e-5f;
constexpr size_t MiB = 1u << 20;
constexpr size_t OFF_W1T = 0, OFF_WOT = 57 * MiB, OFF_H0 = 65 * MiB, OFF_Q = 193 * MiB, OFF_K = 257 * MiB, OFF_V = 321 * MiB, OFF_OG = 449 * MiB,
                 OFF_U = 577 * MiB, OFF_Z = 705 * MiB, OFF_GA = 833 * MiB, OFF_FG = 961 * MiB, OFF_CTL = 969 * MiB, OFF_FG2 = 976 * MiB  , WS_NEED = 984 * MiB;
constexpr size_t OFF_H1PRE = OFF_V, OFF_H1 = OFF_Z, OFF_ACT = OFF_Q  , OFF_GPG = OFF_GA, OFF_OUTPRE = 0;
constexpr size_t DO_GB = 0, DO_PLEB = 0, DO_DEC = 128 * MiB, DO_WGUT = 130 * MiB, DO_WDT = 182 * MiB, DO_WPUT = 204 * MiB, DO_PB = 205 * MiB;
constexpr int LDS_BYTES = 153600, LDS_BARW = 153536;

struct Args {
    const float *x, *p, *ln0_g, *ln0_b, *w_in, *b_in, *w_f2, *b_f2, *gla_g, *gm_g, *gm_b, *w_s, *b_s, *w_o, *ln1_g, *ln1_b, *w_gu, *w_down, *w_pg, *b_pg, *w_pu, *ln2_g, *ln2_b;
    unsigned char* out; unsigned char* ws; int ph_lo, ph_hi, coop, pad;
};

typedef float f32x2_t __attribute__((ext_vector_type(2))); typedef __bf16 bf16x2_t __attribute__((ext_vector_type(2)));
__device__ __forceinline__ unsigned cvtpk_s(float lo, float hi) { f32x2_t v = {lo, hi}; bf16x2_t b = __builtin_convertvector(v, bf16x2_t); return __builtin_bit_cast(unsigned, b); }
__device__ __forceinline__ float bflo(unsigned w) { return __uint_as_float(w << 16); }
__device__ __forceinline__ float bfhi(unsigned w) { return __uint_as_float(w & 0xffff0000u); }
__device__ __forceinline__ float sigm(float x) { return __builtin_amdgcn_rcpf(1.f + __expf(-x)); }
#define WS_DPP(x, ctrl, rm) __builtin_bit_cast(float, __builtin_amdgcn_update_dpp(0, __builtin_bit_cast(int, (x)), (ctrl), (rm), 0xf, false))
__device__ __forceinline__ float wave_sum(float v) {
    v += WS_DPP(v, 0xb1, 0xf); v += WS_DPP(v, 0x4e, 0xf); v += WS_DPP(v, 0x124, 0xf); v += WS_DPP(v, 0x128, 0xf); v += WS_DPP(v, 0x142, 0xa); v += WS_DPP(v, 0x143, 0xc);
    return __builtin_bit_cast(float, __builtin_amdgcn_readlane(__builtin_bit_cast(int, v), 63));
}
#define LDS_WAIT() asm volatile("s_waitcnt lgkmcnt(0)" ::: "memory")

using pg8::Unit;
using pg8::gelu_pk;
typedef float f32x2 __attribute__((ext_vector_type(2)));

__device__ __forceinline__ void act8(f32x4& v0, f32x4& v1, int mode) {
    if (mode == 0) { v0 = v0 * 0.0625f; v1 = v1 * 0.0625f; }
    else if (mode == 2) {
#pragma unroll
        for (int j = 0; j < 4; ++j) { v0[j] = v0[j] * sigm(v0[j]); v1[j] = v1[j] * sigm(v1[j]); } }
    else if (mode == 3) { f32x2 a = gelu_pk((f32x2){v0[0], v0[1]}), b = gelu_pk((f32x2){v0[2], v0[3]}), c = gelu_pk((f32x2){v1[0], v1[1]}), d = gelu_pk((f32x2){v1[2], v1[3]});
        v0 = (f32x4){a.x, a.y, b.x, b.y}; v1 = (f32x4){c.x, c.y, d.x, d.y}; }
    else if (mode == 4) {
#pragma unroll
        for (int j = 0; j < 4; ++j) { v0[j] = sigm(v0[j]); v1[j] = sigm(v1[j]); } }
}

struct Epi1 {
    static constexpr bool PERM = true, AFTER_DRAIN = false; static constexpr int HOOK_T = 0;
    unsigned char* ws; unsigned char* dout; const float* b_in;
    __device__ __forceinline__ void operator()(const f32x4 (&acc)[2][2][4][2], const Unit& u, int wr, int wc, int fr, int fq) const {
        const int pn = u.pn; const int row0 = u.pm * 256 + wr * 64 + fr;
        if (pn == 56) {
            if (wc < 2) {
                float* FG = (float*)(ws + OFF_FG); const int c0 = wc * 32 + 8 * fq;
                const f32x4 b0 = *(const f32x4*)(b_in + 6144 + c0), b1 = *(const f32x4*)(b_in + 6144 + c0 + 4);
#pragma unroll
                for (int ai = 0; ai < 2; ++ai)
#pragma unroll
                    for (int m = 0; m < 4; ++m) { float* rp = FG + (size_t)(row0 + ai * 128 + m * 16) * 64 + c0;
                        *(f32x4*)rp = acc[ai][0][m][0] + b0; *(f32x4*)(rp + 4) = acc[ai][0][m][1] + b1; }
            }
            return;
        }
        const int cw = wc * 32 + 8 * fq;
        if (pn >= 16 && pn < 48) {
            const bool first = pn < 32; const int t = first ? pn - 16 : pn - 32;
            const float* bA = b_in + (first ? 4096 : 6208) + 128 * t + cw; const float* bB = b_in + (first ? 10304 : 12352) + 128 * t + cw;
            const f32x4 a0 = *(const f32x4*)bA, a1 = *(const f32x4*)(bA + 4), g0 = *(const f32x4*)bB, g1 = *(const f32x4*)(bB + 4);
            bf16_t* rowp0 = (bf16_t*)(ws + (first ? OFF_OG : OFF_U)) + (size_t)row0 * 2048 + 128 * t + cw;
            if (first) pair_body<2>(acc, a0, a1, g0, g1, rowp0); else pair_body<3>(acc, a0, a1, g0, g1, rowp0);
            return;
        }
        int mode, ldc, colt, bsrc; bf16_t* base;
        if (pn < 4) { mode = 0; base = (bf16_t*)(ws + OFF_Q); ldc = 1024; colt = pn * 256; bsrc = pn * 256; }
        else if (pn < 8) { mode = 1; base = (bf16_t*)(ws + OFF_K); ldc = 1024; colt = (pn - 4) * 256; bsrc = pn * 256; }
        else if (pn < 16) { mode = 1; base = (bf16_t*)(ws + OFF_V); ldc = 2048; colt = (pn - 8) * 256; bsrc = pn * 256; }
        else { mode = 3; base = (bf16_t*)(ws + OFF_Z); ldc = 2048; colt = (pn - 48) * 256; bsrc = 8256 + (pn - 48) * 256; }
        f32x4 bv[2][2];
#pragma unroll
        for (int bj = 0; bj < 2; ++bj)
#pragma unroll
            for (int n = 0; n < 2; ++n) bv[bj][n] = *(const f32x4*)(b_in + bsrc + bj * 128 + (mode == 0 ? wc * 32 + 4 * fq + 16 * n : cw + 4 * n));
        bf16_t* rowp0 = base + (size_t)row0 * ldc + colt + cw;
        switch (mode) {
            case 0: body<0>(acc, bv, rowp0, ldc); break;
            case 1: body<1>(acc, bv, rowp0, ldc); break;
            default: body<3>(acc, bv, rowp0, ldc); break;
        }
    }
    template <int MODE> __device__ __forceinline__ void body(const f32x4 (&acc)[2][2][4][2], const f32x4 (&bv)[2][2], bf16_t* rowp0, int ldc) const {
#pragma unroll
        for (int ai = 0; ai < 2; ++ai)
#pragma unroll
            for (int m = 0; m < 4; ++m) { bf16_t* rowp = rowp0 + (size_t)(ai * 128 + m * 16) * ldc;
#pragma unroll
                for (int bj = 0; bj < 2; ++bj) { f32x4 v0 = acc[ai][bj][m][0] + bv[bj][0], v1 = acc[ai][bj][m][1] + bv[bj][1];
                    act8(v0, v1, MODE);
                    u32x4 w; w.x = cvtpk_s(v0[0], v0[1]); w.y = cvtpk_s(v0[2], v0[3]); w.z = cvtpk_s(v1[0], v1[1]); w.w = cvtpk_s(v1[2], v1[3]);
                    *(u32x4*)(rowp + bj * 128) = w; } }
    }
    template <int MODE> __device__ __forceinline__ void pair_body(const f32x4 (&acc)[2][2][4][2], const f32x4 a0, const f32x4 a1, const f32x4 g0, const f32x4 g1, bf16_t* rowp0) const {
#pragma unroll
        for (int ai = 0; ai < 2; ++ai)
#pragma unroll
            for (int m = 0; m < 4; ++m) { f32x4 v0 = acc[ai][0][m][0] + a0, v1 = acc[ai][0][m][1] + a1, s0 = acc[ai][1][m][0] + g0, s1 = acc[ai][1][m][1] + g1;
                act8(v0, v1, MODE); act8(s0, s1, 4);
                v0 = v0 * s0; v1 = v1 * s1;
                u32x4 w; w.x = cvtpk_s(v0[0], v0[1]); w.y = cvtpk_s(v0[2], v0[3]); w.z = cvtpk_s(v1[0], v1[1]); w.w = cvtpk_s(v1[2], v1[3]);
                *(u32x4*)(rowp0 + (size_t)(ai * 128 + m * 16) * 2048) = w; }
    }
};

struct EpiFg {
    static constexpr bool PERM = true, AFTER_DRAIN = false; static constexpr int HOOK_T = 0;
    float* P0; float* P1;
    __device__ __forceinline__ void operator()(const f32x4 (&acc)[2][2][4][2], const Unit& u, int wr, int wc, int fr, int fq) const {
        if (wc >= 2) return;
        float* FG = u.pn ? P1 : P0; const int row0 = u.pm * 256 + wr * 64 + fr, c0 = wc * 32 + 8 * fq;
#pragma unroll
        for (int ai = 0; ai < 2; ++ai)
#pragma unroll
            for (int m = 0; m < 4; ++m) { float* rp = FG + (size_t)(row0 + ai * 128 + m * 16) * 64 + c0; *(f32x4*)rp = acc[ai][0][m][0]; *(f32x4*)(rp + 4) = acc[ai][0][m][1]; }
    }
};

template <bool HAS_P> struct EpiRes {
    static constexpr bool PERM = true, AFTER_DRAIN = false; static constexpr int HOOK_T = 0;
    bf16_t* out; const bf16_t* R; const bf16_t* P;
    __device__ __forceinline__ void operator()(const f32x4 (&acc)[2][2][4][2], const Unit& u, int wr, int wc, int fr, int fq) const {
        const int row0 = u.pm * 256 + wr * 64 + fr, col0 = u.pn * 256 + wc * 32 + 8 * fq;
#pragma unroll
        for (int ai = 0; ai < 2; ++ai)
#pragma unroll
            for (int mh = 0; mh < 2; ++mh) {
                u32x4 rr[2][2], qq[2][2];
#pragma unroll
                for (int m2 = 0; m2 < 2; ++m2)
#pragma unroll
                    for (int bj = 0; bj < 2; ++bj) { const size_t off = (size_t)(row0 + ai * 128 + (2 * mh + m2) * 16) * DM + col0 + bj * 128;
                        rr[m2][bj] = *(const u32x4*)(R + off); if (HAS_P) qq[m2][bj] = *(const u32x4*)(P + off); }
#pragma unroll
                for (int m2 = 0; m2 < 2; ++m2)
#pragma unroll
                    for (int bj = 0; bj < 2; ++bj) { const int m = 2 * mh + m2; const size_t off = (size_t)(row0 + ai * 128 + m * 16) * DM + col0 + bj * 128; const u32x4 r = rr[m2][bj];
                        f32x4 v0 = acc[ai][bj][m][0], v1 = acc[ai][bj][m][1];
                        v0 += (f32x4){bflo(r.x), bfhi(r.x), bflo(r.y), bfhi(r.y)} * ALPHA; v1 += (f32x4){bflo(r.z), bfhi(r.z), bflo(r.w), bfhi(r.w)} * ALPHA;
                        if (HAS_P) { const u32x4 q = qq[m2][bj];
                            v0 += (f32x4){bflo(q.x), bfhi(q.x), bflo(q.y), bfhi(q.y)}; v1 += (f32x4){bflo(q.z), bfhi(q.z), bflo(q.w), bfhi(q.w)}; }
                        u32x4 w; w.x = cvtpk_s(v0[0], v0[1]); w.y = cvtpk_s(v0[2], v0[3]); w.z = cvtpk_s(v1[0], v1[1]); w.w = cvtpk_s(v1[2], v1[3]);
                        *(u32x4*)(out + off) = w; }
                asm volatile("" ::: "memory");
            }
    }
};

struct EpiDown {
    static constexpr bool PERM = true, AFTER_DRAIN = false; static constexpr int HOOK_T = 4;
    bf16_t* out; const bf16_t* R; const bf16_t* G;
    __device__ __forceinline__ void hook(f32x4 (&acc)[2][2][4][2], const Unit& u, int wr, int wc, int fr, int fq) const {
        unsigned zoff; asm volatile("v_mov_b32 %0, 0" : "=v"(zoff));
        const bf16_t* gp = G + (size_t)(u.pm * 256 + wr * 64 + fr) * DM + u.pn * 256 + wc * 32 + 8 * fq + zoff;
#pragma unroll
        for (int ai = 0; ai < 2; ++ai)
#pragma unroll
            for (int mh = 0; mh < 2; ++mh) {
                u32x4 rr[2][2];
#pragma unroll
                for (int m2 = 0; m2 < 2; ++m2)
#pragma unroll
                    for (int bj = 0; bj < 2; ++bj) rr[m2][bj] = *(const u32x4*)(gp + (size_t)(ai * 128 + (2 * mh + m2) * 16) * DM + bj * 128);
#pragma unroll
                for (int m2 = 0; m2 < 2; ++m2)
#pragma unroll
                    for (int bj = 0; bj < 2; ++bj) { const u32x4 r = rr[m2][bj]; const int m = 2 * mh + m2;
                        acc[ai][bj][m][0] *= (f32x4){bflo(r.x), bfhi(r.x), bflo(r.y), bfhi(r.y)}; acc[ai][bj][m][1] *= (f32x4){bflo(r.z), bfhi(r.z), bflo(r.w), bfhi(r.w)}; }
                asm volatile("" ::: "memory");
            }
    }
    __device__ __forceinline__ void operator()(const f32x4 (&acc)[2][2][4][2], const Unit& u, int wr, int wc, int fr, int fq) const {
        const int row0 = u.pm * 256 + wr * 64 + fr, col0 = u.pn * 256 + wc * 32 + 8 * fq;
#pragma unroll
        for (int ai = 0; ai < 2; ++ai)
#pragma unroll
            for (int m = 0; m < 4; ++m)
#pragma unroll
                for (int bj = 0; bj < 2; ++bj) { const size_t off = (size_t)(row0 + ai * 128 + m * 16) * DM + col0 + bj * 128; const u32x4 r = *(const u32x4*)(R + off);
                    f32x4 v0 = acc[ai][bj][m][0], v1 = acc[ai][bj][m][1];
                    v0 += (f32x4){bflo(r.x), bfhi(r.x), bflo(r.y), bfhi(r.y)} * ALPHA; v1 += (f32x4){bflo(r.z), bfhi(r.z), bflo(r.w), bfhi(r.w)} * ALPHA;
                    u32x4 w; w.x = cvtpk_s(v0[0], v0[1]); w.y = cvtpk_s(v0[2], v0[3]); w.z = cvtpk_s(v1[0], v1[1]); w.w = cvtpk_s(v1[2], v1[3]);
                    *(u32x4*)(out + off) = w; }
    }
};

struct Epi5 {
    static constexpr bool PERM = true, AFTER_DRAIN = false; static constexpr int HOOK_T = 0;
    bf16_t* ACT; bf16_t* GPG; const float* b_pg;
    __device__ __forceinline__ void operator()(const f32x4 (&acc)[2][2][4][2], const Unit& u, int wr, int wc, int fr, int fq) const {
        const int pn = u.pn; const int row0 = u.pm * 256 + wr * 64 + fr, cw = wc * 32 + 8 * fq;
        if (pn < 44) {
#pragma unroll
            for (int ai = 0; ai < 2; ++ai)
#pragma unroll
                for (int m = 0; m < 4; ++m) { bf16_t* rowp = ACT + (size_t)(row0 + ai * 128 + m * 16) * KX + 256 + pn * 128 + cw;
                    f32x4 g0 = acc[ai][0][m][0], g1 = acc[ai][0][m][1]; const f32x4 u0 = acc[ai][1][m][0], u1 = acc[ai][1][m][1];
#pragma unroll
                    for (int j = 0; j < 4; ++j) { g0[j] = g0[j] * sigm(g0[j]) * u0[j]; g1[j] = g1[j] * sigm(g1[j]) * u1[j]; }
                    u32x4 w; w.x = cvtpk_s(g0[0], g0[1]); w.y = cvtpk_s(g0[2], g0[3]); w.z = cvtpk_s(g1[0], g1[1]); w.w = cvtpk_s(g1[2], g1[3]);
                    *(u32x4*)rowp = w; }
        } else {
            const int colt = (pn - 44) * 256;
            f32x4 bv[2][2];
#pragma unroll
            for (int bj = 0; bj < 2; ++bj)
#pragma unroll
                for (int n = 0; n < 2; ++n) bv[bj][n] = *(const f32x4*)(b_pg + colt + bj * 128 + cw + 4 * n);
#pragma unroll
            for (int ai = 0; ai < 2; ++ai)
#pragma unroll
                for (int m = 0; m < 4; ++m) { bf16_t* rowp = GPG + (size_t)(row0 + ai * 128 + m * 16) * DM + colt + cw;
#pragma unroll
                    for (int bj = 0; bj < 2; ++bj) { f32x4 v0 = acc[ai][bj][m][0] + bv[bj][0], v1 = acc[ai][bj][m][1] + bv[bj][1];
                        act8(v0, v1, 4);
                        u32x4 w; w.x = cvtpk_s(v0[0], v0[1]); w.y = cvtpk_s(v0[2], v0[3]); w.z = cvtpk_s(v1[0], v1[1]); w.w = cvtpk_s(v1[2], v1[3]);
                        *(u32x4*)(rowp + bj * 128) = w; } }
        }
    }
};

struct EpiPle {
    static constexpr bool PERM = true, AFTER_DRAIN = false; static constexpr int HOOK_T = 0;
    bf16_t* O; const bf16_t* G;
    __device__ __forceinline__ void operator()(const f32x4 (&acc)[2][2][4][2], const Unit& u, int wr, int wc, int fr, int fq) const {
        const int row0 = u.pm * 256 + wr * 64 + fr, col0 = u.pn * 256 + wc * 32 + 8 * fq;
#pragma unroll
        for (int ai = 0; ai < 2; ++ai) {
            u32x4 rr[4][2];
#pragma unroll
            for (int m = 0; m < 4; ++m)
#pragma unroll
                for (int bj = 0; bj < 2; ++bj) rr[m][bj] = *(const u32x4*)(G + (size_t)(row0 + ai * 128 + m * 16) * DM + col0 + bj * 128);
#pragma unroll
            for (int m = 0; m < 4; ++m)
#pragma unroll
                for (int bj = 0; bj < 2; ++bj) { const size_t off = (size_t)(row0 + ai * 128 + m * 16) * DM + col0 + bj * 128; const u32x4 r = rr[m][bj];
                    const f32x4 v0 = acc[ai][bj][m][0] * (f32x4){bflo(r.x), bfhi(r.x), bflo(r.y), bfhi(r.y)}, v1 = acc[ai][bj][m][1] * (f32x4){bflo(r.z), bfhi(r.z), bflo(r.w), bfhi(r.w)};
                    u32x4 w; w.x = cvtpk_s(v0[0], v0[1]); w.y = cvtpk_s(v0[2], v0[3]); w.z = cvtpk_s(v1[0], v1[1]); w.w = cvtpk_s(v1[2], v1[3]);
                    *(u32x4*)(O + off) = w; }
            asm volatile("" ::: "memory");
        }
    }
};

__device__ __forceinline__ int dkmap32(int pos) { const int qq = pos >> 3, jj = pos & 7; return jj < 4 ? 4 * qq + jj : 16 + 4 * qq + (jj - 4); }
__device__ __forceinline__ void tr_item(const float* W, int ldw, int srccol0, int k0, bf16_t* WT, int ldt, int dstrow0, LAS float* scr, int lane, bool zero, int dk0 = 0, bool qperm = false) {
    if (!zero) {
        f32x4 tv[8];
#pragma unroll
        for (int i = 0; i < 8; ++i) tv[i] = *(const f32x4*)(W + (size_t)(k0 + 8 * i + (lane >> 3)) * ldw + srccol0 + 4 * (lane & 7));
#pragma unroll
        for (int i = 0; i < 8; ++i) { LAS float* d = scr + (8 * i + (lane >> 3)) * 33 + 4 * (lane & 7); d[0] = tv[i][0]; d[1] = tv[i][1]; d[2] = tv[i][2]; d[3] = tv[i][3]; }
    }
    LDS_WAIT();
    const int c = lane & 7;
#pragma unroll
    for (int j = 0; j < 4; ++j) { const int n = (lane >> 3) + 8 * j; const LAS float* s = scr + (8 * c) * 33 + (qperm ? dkmap32(n) : n);
        u32x4 o; o.x = cvtpk_s(s[0 * 33], s[1 * 33]); o.y = cvtpk_s(s[2 * 33], s[3 * 33]); o.z = cvtpk_s(s[4 * 33], s[5 * 33]); o.w = cvtpk_s(s[6 * 33], s[7 * 33]);
        if (zero) o = (u32x4){0u, 0u, 0u, 0u};
        *(u32x4*)(WT + (size_t)(dstrow0 + n) * ldt + dk0 + k0 + 8 * c) = o; }
    LDS_WAIT();
}
template <bool OUT_BF16> __device__ __forceinline__ void ln_row(const float* in, void* outp, const float* g, const float* b, int lane) {
    const f32x4* xr = (const f32x4*)in + lane;
    f32x4 v[8]; float s = 0.f;
#pragma unroll
    for (int j = 0; j < 8; ++j) { v[j] = xr[64 * j]; s += (v[j][0] + v[j][1]) + (v[j][2] + v[j][3]); }
    const float mean = wave_sum(s) * (1.f / DM); float s2 = 0.f;
#pragma unroll
    for (int j = 0; j < 8; ++j) { v[j] = v[j] - mean; s2 += (v[j][0] * v[j][0] + v[j][1] * v[j][1]) + (v[j][2] * v[j][2] + v[j][3] * v[j][3]); }
    const float rstd = 1.f / sqrtf(wave_sum(s2) * (1.f / DM) + LN_EPS);
#pragma unroll
    for (int j = 0; j < 8; ++j) { const f32x4 gg = ((const f32x4*)g)[64 * j + lane], bb = ((const f32x4*)b)[64 * j + lane]; const f32x4 o = v[j] * rstd * gg + bb;
        if (OUT_BF16) { u32x2 w; w.x = cvtpk_s(o[0], o[1]); w.y = cvtpk_s(o[2], o[3]); ((u32x2*)outp)[64 * j + lane] = w; }
        else ((f32x4*)outp)[64 * j + lane] = o; }
}
template <bool OUT_BF16, bool IN_BF16 = false> __device__ __forceinline__ void ln_row2(const void* in0, const void* in1, void* out0, void* out1, const float* g, const float* b, int lane) {
    f32x4 v[8], w[8]; float s = 0.f, t = 0.f;
    if (IN_BF16) { const u32x2* x0 = (const u32x2*)in0 + lane; const u32x2* x1 = (const u32x2*)in1 + lane; u32x2 a0[8], a1[8];
#pragma unroll
        for (int j = 0; j < 8; ++j) { a0[j] = x0[64 * j]; a1[j] = x1[64 * j]; }
#pragma unroll
        for (int j = 0; j < 8; ++j) { v[j] = (f32x4){bflo(a0[j].x), bfhi(a0[j].x), bflo(a0[j].y), bfhi(a0[j].y)}; w[j] = (f32x4){bflo(a1[j].x), bfhi(a1[j].x), bflo(a1[j].y), bfhi(a1[j].y)}; }
    } else { const f32x4* x0 = (const f32x4*)in0 + lane; const f32x4* x1 = (const f32x4*)in1 + lane;
#pragma unroll
        for (int j = 0; j < 8; ++j) { v[j] = x0[64 * j]; w[j] = x1[64 * j]; } }
#pragma unroll
    for (int j = 0; j < 8; ++j) { s += (v[j][0] + v[j][1]) + (v[j][2] + v[j][3]); t += (w[j][0] + w[j][1]) + (w[j][2] + w[j][3]); }
#pragma unroll
    for (int o = 1; o < 64; o <<= 1) { s += __shfl_xor(s, o); t += __shfl_xor(t, o); }
    const float m0 = s * (1.f / DM), m1 = t * (1.f / DM); float s2 = 0.f, t2 = 0.f;
#pragma unroll
    for (int j = 0; j < 8; ++j) { v[j] = v[j] - m0; w[j] = w[j] - m1; s2 += (v[j][0] * v[j][0] + v[j][1] * v[j][1]) + (v[j][2] * v[j][2] + v[j][3] * v[j][3]); t2 += (w[j][0] * w[j][0] + w[j][1] * w[j][1]) + (w[j][2] * w[j][2] + w[j][3] * w[j][3]); }
#pragma unroll
    for (int o = 1; o < 64; o <<= 1) { s2 += __shfl_xor(s2, o); t2 += __shfl_xor(t2, o); }
    const float r0 = 1.f / sqrtf(s2 * (1.f / DM) + LN_EPS), r1 = 1.f / sqrtf(t2 * (1.f / DM) + LN_EPS);
#pragma unroll
    for (int j = 0; j < 8; ++j) { const f32x4 gg = ((const f32x4*)g)[64 * j + lane], bb = ((const f32x4*)b)[64 * j + lane]; const f32x4 o0 = v[j] * r0 * gg + bb, o1 = w[j] * r1 * gg + bb;
        if (OUT_BF16) { u32x2 p; p.x = cvtpk_s(o0[0], o0[1]); p.y = cvtpk_s(o0[2], o0[3]); ((u32x2*)out0)[64 * j + lane] = p; p.x = cvtpk_s(o1[0], o1[1]); p.y = cvtpk_s(o1[2], o1[3]); ((u32x2*)out1)[64 * j + lane] = p; }
        else { ((f32x4*)out0)[64 * j + lane] = o0; ((f32x4*)out1)[64 * j + lane] = o1; } }
}

template <bool OUT_BF16, bool IN_BF16> __device__ __forceinline__ void ln_stream(const void* in, void* out, const float* g, const float* b, int gw, int ngw, int lane) {
    typedef typename std::conditional<IN_BF16, u32x2, f32x4>::type raw_t;
    f32x4 gg[8], bb[8];
#pragma unroll
    for (int j = 0; j < 8; ++j) { gg[j] = ((const f32x4*)g)[64 * j + lane]; bb[j] = ((const f32x4*)b)[64 * j + lane]; }
    raw_t cur[2][8], nxt[2][8];
    const int nit = MTOK / (2 * ngw);
#define LN_LOAD(dst, it) do { _Pragma("unroll") for (int r = 0; r < 2; ++r) { const raw_t* rp = (const raw_t*)((const char*)in + (size_t)(gw + (2 * (it) + r) * ngw) * DM * (IN_BF16 ? 2 : 4)) + lane; \
        _Pragma("unroll") for (int j = 0; j < 8; ++j) dst[r][j] = rp[64 * j]; } } while (0)
    LN_LOAD(cur, 0);
    for (int it = 0; it < nit; ++it) {
        if (it + 1 < nit) LN_LOAD(nxt, it + 1);
        f32x4 v[2][8]; float s[2], s2[2];
#pragma unroll
        for (int r = 0; r < 2; ++r) { s[r] = 0.f;
#pragma unroll
            for (int j = 0; j < 8; ++j) { if constexpr (IN_BF16) { const u32x2 w = *(const u32x2*)&cur[r][j]; v[r][j] = (f32x4){bflo(w.x), bfhi(w.x), bflo(w.y), bfhi(w.y)}; } else v[r][j] = *(const f32x4*)&cur[r][j];
                s[r] += (v[r][j][0] + v[r][j][1]) + (v[r][j][2] + v[r][j][3]); } }
        s[0] = wave_sum(s[0]); s[1] = wave_sum(s[1]);
#pragma unroll
        for (int r = 0; r < 2; ++r) { const float mean = s[r] * (1.f / DM); s2[r] = 0.f;
#pragma unroll
            for (int j = 0; j < 8; ++j) { v[r][j] = v[r][j] - mean; s2[r] += (v[r][j][0] * v[r][j][0] + v[r][j][1] * v[r][j][1]) + (v[r][j][2] * v[r][j][2] + v[r][j][3] * v[r][j][3]); } }
        s2[0] = wave_sum(s2[0]); s2[1] = wave_sum(s2[1]);
#pragma unroll
        for (int r = 0; r < 2; ++r) { const float rstd = 1.f / sqrtf(s2[r] * (1.f / DM) + LN_EPS); const size_t row = (size_t)(gw + (2 * it + r) * ngw);
#pragma unroll
            for (int j = 0; j < 8; ++j) { const f32x4 o = v[r][j] * rstd * gg[j] + bb[j];
                if (OUT_BF16) { u32x2 pk; pk.x = cvtpk_s(o[0], o[1]); pk.y = cvtpk_s(o[2], o[3]); ((u32x2*)((bf16_t*)out + row * DM))[64 * j + lane] = pk; }
                else ((f32x4*)((float*)out + row * DM))[64 * j + lane] = o; } }
#pragma unroll
        for (int r = 0; r < 2; ++r)
#pragma unroll
            for (int j = 0; j < 8; ++j) cur[r][j] = nxt[r][j];
    }
#undef LN_LOAD
}

__device__ __forceinline__ void phase_prep(const Args& a, LAS unsigned char* lds, int gw, int ngw, int wave, int lane) {
    LAS float* scr = (LAS float*)(lds + wave * 8448);
    bf16_t* W1T = (bf16_t*)(a.ws + OFF_W1T); bf16_t* WOT = (bf16_t*)(a.ws + OFF_WOT);
    constexpr int I1 = 32 * (N1 / 32), IO = 32 * 64;
    for (int it = gw; it < I1; it += ngw) {
        if (it < I1) { const int kb = it / (N1 / 32), nb = it % (N1 / 32), n0 = nb * 32;
            const bool zero = n0 >= 14400; int src;
            if (n0 < 4096) src = n0;
            else if (n0 < 8192) { const int t = (n0 - 4096) >> 8, wi = n0 & 255; src = wi < 128 ? 4096 + 128 * t + wi : 10304 + 128 * t + (wi - 128); }
            else if (n0 < 12288) { const int t = (n0 - 8192) >> 8, wi = n0 & 255; src = wi < 128 ? 6208 + 128 * t + wi : 12352 + 128 * t + (wi - 128); }
            else if (n0 < 14336) src = 8256 + (n0 - 12288);
            else src = 6144 + (n0 - 14336);
            tr_item(a.w_in, 14400, zero ? 0 : src, kb * 64, W1T, 2048, n0, scr, lane, zero, 0, n0 < 1024); }
        else { const int r = it - I1, kb = r / 64, nb = r % 64; tr_item(a.w_o, 2048, nb * 32, kb * 64, WOT, 2048, nb * 32, scr, lane, false); }
    }
    bf16_t* H0 = (bf16_t*)(a.ws + OFF_H0);
    ln_stream<true, false>(a.x, H0, a.ln0_g, a.ln0_b, gw, ngw, lane);
}
__device__ __forceinline__ void phase_prep2(const Args& a, LAS unsigned char* lds, int gw, int ngw, int wave, int lane) {
    LAS float* scr = (LAS float*)(lds + wave * 8448);
    bf16_t* WGUT = (bf16_t*)(a.out + DO_WGUT); bf16_t* WDT = (bf16_t*)(a.out + DO_WDT);
    constexpr int IG = 32 * (NGU / 32), ID = 88 * 64, IP = 4 * 64;
    { bf16_t* WOT = (bf16_t*)(a.ws + OFF_WOT);
      for (int r = gw; r < 32 * 64; r += ngw) { const int kb = r / 64, nb = r % 64; tr_item(a.w_o, 2048, nb * 32, kb * 64, WOT, 2048, nb * 32, scr, lane, false); } }
    for (int it = gw; it < IG + ID + IP; it += ngw) {
        if (it < IG) { const int kb = it / (NGU / 32), nb = it % (NGU / 32), n0 = nb * 32, t = n0 >> 8, wi = n0 & 255;
            if (t < 44) tr_item(a.w_gu, 2 * DFF, wi < 128 ? t * 128 + wi : DFF + t * 128 + (wi - 128), kb * 64, WGUT, 2048, n0, scr, lane, false);
            else tr_item(a.w_pg, 2048, (t - 44) * 256 + wi, kb * 64, WGUT, 2048, n0, scr, lane, false); }
        else if (it < IG + ID) { const int r = it - IG, kb = r / 64, nb = r % 64; tr_item(a.w_down, 2048, nb * 32, kb * 64, WDT, KX, nb * 32, scr, lane, false, 256); }
        else { const int r = it - IG - ID, kb = r / 64, nb = r % 64; tr_item(a.w_pu, 2048, nb * 32, kb * 64, WDT, KX, nb * 32, scr, lane, false, 0); }
    }
}
__device__ __forceinline__ void phase_pconv(const Args& a, int gw, int ngw, int lane) {
    bf16_t* ACT = (bf16_t*)(a.ws + OFF_ACT);
    for (int i = gw * 64 + lane; i < MTOK * 64; i += ngw * 64) { const int m = i >> 6, c4 = (i & 63) * 4; const f32x4 v = *(const f32x4*)(a.p + (size_t)m * 256 + c4);
        u32x2 w; w.x = cvtpk_s(v[0], v[1]); w.y = cvtpk_s(v[2], v[3]); *(u32x2*)(ACT + (size_t)m * KX + c4) = w; }
}

__device__ __forceinline__ void phase_kt(const Args& a, LAS unsigned char* lds, int tid) {
    LAS float* fgs = (LAS float*)(lds + 131072);
    bf16_t* Kb = (bf16_t*)(a.ws + OFF_K); const float* FG = (const float*)(a.ws + OFF_FG); const float* FG2 = (const float*)(a.ws + OFF_FG2); float* DEC = (float*)(a.out + DO_DEC);
    const int col2 = 2 * tid, h = col2 >> 8, d = col2 & 255;
    float w0[16], w1[16];
#pragma unroll
    for (int r = 0; r < 16; ++r) { const float2 t = *(const float2*)(a.w_f2 + (h * 16 + r) * 256 + d); w0[r] = t.x; w1[r] = t.y; }
    const float2 bb = *(const float2*)(a.b_f2 + h * 256 + d);
    for (int it = blockIdx.x; it < NCHUNK; it += gridDim.x) {
        const size_t row0 = (size_t)it * 64;
        __syncthreads();
#pragma unroll
        for (int i = 0; i < 2; ++i) { const int p = tid + 512 * i; ((LAS f32x4*)fgs)[p] = ((const f32x4*)(FG + row0 * 64))[p] + ((const f32x4*)(FG2 + row0 * 64))[p] + *(const f32x4*)(a.b_in + 6144 + 4 * (p & 15)); }
        __syncthreads();
        float run0 = 0.f, run1 = 0.f;
        unsigned kwc[8], kwn[8];
#pragma unroll
        for (int tt = 0; tt < 8; ++tt) { kwc[tt] = *(const unsigned*)(Kb + (row0 + 56 + tt) * 1024 + col2); kwn[tt] = 0u; }
        for (int tg = 7; tg >= 0; --tg) {
            if (tg > 0) {
#pragma unroll
                for (int tt = 0; tt < 8; ++tt) kwn[tt] = *(const unsigned*)(Kb + (row0 + (tg - 1) * 8 + tt) * 1024 + col2); }
            float v0[8], v1[8];
#pragma unroll
            for (int tt = 7; tt >= 0; --tt) { const int t = tg * 8 + tt;
                const LAS f32x4* fp = (const LAS f32x4*)(fgs + t * 64 + h * 16);
                float f0 = bb.x, f1 = bb.y;
#pragma unroll
                for (int r4 = 0; r4 < 4; ++r4) { const f32x4 fv = fp[r4];
#pragma unroll
                    for (int j = 0; j < 4; ++j) { f0 += fv[j] * w0[r4 * 4 + j]; f1 += fv[j] * w1[r4 * 4 + j]; } }
                const float la0 = (fminf(f0, 0.f) - __logf(1.f + __expf(-fabsf(f0)))) * 0.0625f, la1 = (fminf(f1, 0.f) - __logf(1.f + __expf(-fabsf(f1)))) * 0.0625f;
                const unsigned kw = kwc[tt];
                v0[tt] = bflo(kw) * __expf(run0); v1[tt] = bfhi(kw) * __expf(run1);
                run0 += la0; run1 += la1; }
            u32x4 p0, p1;
            p0.x = cvtpk_s(v0[0], v0[1]); p0.y = cvtpk_s(v0[2], v0[3]); p0.z = cvtpk_s(v0[4], v0[5]); p0.w = cvtpk_s(v0[6], v0[7]);
            p1.x = cvtpk_s(v1[0], v1[1]); p1.y = cvtpk_s(v1[2], v1[3]); p1.z = cvtpk_s(v1[4], v1[5]); p1.w = cvtpk_s(v1[6], v1[7]);
            *(LAS u32x4*)(lds + col2 * 128 + ((tg ^ (col2 & 7)) << 4)) = p0;
            *(LAS u32x4*)(lds + (col2 + 1) * 128 + ((tg ^ ((col2 + 1) & 7)) << 4)) = p1;
#pragma unroll
            for (int tt = 0; tt < 8; ++tt) kwc[tt] = kwn[tt];
        }
        *(float2*)(DEC + (size_t)it * 1024 + col2) = make_float2(__expf(run0), __expf(run1));
        __syncthreads();
#pragma unroll
        for (int i = 0; i < 16; ++i) { const int p = tid + 512 * i, c = p >> 3, s = p & 7;
            *(u32x4*)(Kb + (size_t)it * 65536 + c * 64 + s * 8) = *(const LAS u32x4*)(lds + c * 128 + ((s ^ (c & 7)) << 4)); }
    }
    __syncthreads();
}

__device__ __forceinline__ void phase_scan(const Args& a, LAS unsigned char* lds, int tid, int wave, int lane) {
    const int bx = blockIdx.x, xcd = bx & 7, jj = bx >> 3, bh = xcd * 2 + (jj >> 3), b = bh >> 2, h = bh & 3, dvb = jj & 7, l15 = lane & 15, q = lane >> 4;
    constexpr int KTB = 0, QB = 65536, VB = 131072, DB = 147456;
    const bf16_t* KT = (const bf16_t*)(a.ws + OFF_K) + (size_t)(b * 128) * 65536 + h * 16384;
    const bf16_t* Qg = (const bf16_t*)(a.ws + OFF_Q) + (size_t)(b * 8192) * 1024 + h * 256;
    bf16_t* Vg = (bf16_t*)(a.ws + OFF_V) + (size_t)(b * 8192) * 2048 + h * 512 + dvb * 64;
    const float* DEC = (const float*)(a.out + DO_DEC) + (size_t)(b * 128) * 1024 + h * 256;
#define SBAR() do { asm volatile("s_waitcnt lgkmcnt(0)" ::: "memory"); __builtin_amdgcn_s_barrier(); asm volatile("" ::: "memory"); } while (0)
    if (wave >= 4) {
        const int lw = wave - 4;
        const unsigned kvo = (unsigned)(((lane >> 3) * 64 + (((lane & 7) ^ ((lane >> 3) & 7)) << 3)) * 2);
        unsigned qvo[8];
#pragma unroll
        for (int i = 0; i < 8; ++i) { const int frl = 2 * i + (lane >> 5); qvo[i] = (unsigned)(((lw * 16 + frl) * 1024 + (((lane & 31) ^ (frl & 15)) << 3)) * 2); }
        const unsigned vvo = (unsigned)(((lane >> 3) * 2048 + (lane & 7) * 8) * 2);
#define G1(cc) do { const int c_ = (cc) > 127 ? 127 : (cc); const char* qb_ = (const char*)(Qg + (size_t)c_ * 65536); LAS unsigned char* d_ = lds + QB + ((cc) & 1) * 32768 + lw * 8192; \
            _Pragma("unroll") for (int i = 0; i < 8; ++i) __builtin_amdgcn_global_load_lds((const unsigned*)(qb_ + qvo[i]), (LAS unsigned*)(d_ + i * 1024), 16, 0, 0); } while (0)
#define G2(cc) do { const int c_ = (cc) > 127 ? 127 : (cc); const char* kb_ = (const char*)(KT + (size_t)c_ * 65536) + lw * 8192; LAS unsigned char* d_ = lds + KTB + ((cc) & 1) * 32768 + lw * 8192; \
            _Pragma("unroll") for (int i = 0; i < 8; ++i) __builtin_amdgcn_global_load_lds((const unsigned*)(kb_ + i * 1024 + kvo), (LAS unsigned*)(d_ + i * 1024), 16, 0, 0); \
            const char* vb_ = (const char*)(Vg + (size_t)(c_ * 64 + lw * 16) * 2048); LAS unsigned char* dv_ = lds + VB + ((cc) & 1) * 8192 + lw * 2048; \
            _Pragma("unroll") for (int i = 0; i < 2; ++i) __builtin_amdgcn_global_load_lds((const unsigned*)(vb_ + (size_t)i * 8 * 2048 * 2 + vvo), (LAS unsigned*)(dv_ + i * 1024), 16, 0, 0); \
            __builtin_amdgcn_global_load_lds((const unsigned*)(DEC + (size_t)c_ * 1024 + lw * 64 + lane), (LAS unsigned*)(lds + DB + ((cc) & 1) * 1024 + lw * 256), 4, 0, 0); } while (0)
        G2(0); G1(0); G2(1);
        for (int c = 0; c < 128; ++c) {
            asm volatile("s_waitcnt vmcnt(19)" ::: "memory");
            SBAR();
            G1(c + 1);
            asm volatile("s_waitcnt vmcnt(19)" ::: "memory");
            SBAR();
            G2(c + 2);
        }
        asm volatile("s_waitcnt vmcnt(0)" ::: "memory");
#undef G1
#undef G2
    } else {
        const unsigned ovo = (unsigned)((l15 * 2048 + 16 * wave + 4 * q) * 2);
        __builtin_amdgcn_s_setprio(2);
        f32x4 accS[16];
#pragma unroll
        for (int i = 0; i < 16; ++i) accS[i] = (f32x4){0.f, 0.f, 0.f, 0.f};
        for (int c = 0; c < 128; ++c) {
            LAS unsigned char* KTs = lds + KTB + (c & 1) * 32768; LAS unsigned char* Qs = lds + QB + (c & 1) * 32768;
            const LAS unsigned short* Vs = (const LAS unsigned short*)(lds + VB + (c & 1) * 8192); LAS float* DECs = (LAS float*)(lds + DB + (c & 1) * 1024);
            SBAR();
            bf16x8 vb0, vb1;
            { const LAS unsigned short* vp = Vs + (8 * q) * 64 + 16 * wave + l15; unsigned w0[4], w1[4];
#pragma unroll
              for (int e = 0; e < 4; ++e) { w0[e] = (unsigned)vp[(2 * e) * 64] | ((unsigned)vp[(2 * e + 1) * 64] << 16); w1[e] = (unsigned)vp[(32 + 2 * e) * 64] | ((unsigned)vp[(32 + 2 * e + 1) * 64] << 16); }
              vb0 = __builtin_bit_cast(bf16x8, (u32x4){w0[0], w0[1], w0[2], w0[3]}); vb1 = __builtin_bit_cast(bf16x8, (u32x4){w1[0], w1[1], w1[2], w1[3]}); }
#define SCAN_KTLD(A0, A1, D, bt) do { _Pragma("unroll") for (int t = 0; t < 4; ++t) { const int dk = 16 * (4 * (bt) + t) + l15; \
                A0[t] = *(const LAS bf16x8*)(KTs + dk * 128 + ((q ^ (dk & 7)) << 4)); A1[t] = *(const LAS bf16x8*)(KTs + dk * 128 + (((4 + q) ^ (dk & 7)) << 4)); \
                D[t] = *(const LAS f32x4*)(DECs + 16 * (4 * (bt) + t) + 4 * q); } } while (0)
#define SCAN_KTMM(A0, A1, D, bt) do { _Pragma("unroll") for (int t = 0; t < 4; ++t) accS[4 * (bt) + t] = __builtin_amdgcn_mfma_f32_16x16x32_bf16(A0[t], vb0, accS[4 * (bt) + t] * D[t], 0, 0, 0); \
            _Pragma("unroll") for (int t = 0; t < 4; ++t) accS[4 * (bt) + t] = __builtin_amdgcn_mfma_f32_16x16x32_bf16(A1[t], vb1, accS[4 * (bt) + t], 0, 0, 0); } while (0)
            {
                bf16x8 xa0[4], xa1[4], ya0[4], ya1[4]; f32x4 xd[4], yd[4];
                SCAN_KTLD(xa0, xa1, xd, 0); __builtin_amdgcn_sched_barrier(0);
                SCAN_KTLD(ya0, ya1, yd, 1); __builtin_amdgcn_sched_barrier(0);
                SCAN_KTMM(xa0, xa1, xd, 0); __builtin_amdgcn_sched_barrier(0);
                SCAN_KTLD(xa0, xa1, xd, 2); __builtin_amdgcn_sched_barrier(0);
                SCAN_KTMM(ya0, ya1, yd, 1); __builtin_amdgcn_sched_barrier(0);
                SCAN_KTLD(ya0, ya1, yd, 3); __builtin_amdgcn_sched_barrier(0);
                SCAN_KTMM(xa0, xa1, xd, 2); __builtin_amdgcn_sched_barrier(0);
                SCAN_KTMM(ya0, ya1, yd, 3); __builtin_amdgcn_sched_barrier(0);
            }
            bf16x8 sf[8];
#pragma unroll
            for (int ks = 0; ks < 8; ++ks) { u32x4 w; w.x = cvtpk_s(accS[2 * ks][0], accS[2 * ks][1]); w.y = cvtpk_s(accS[2 * ks][2], accS[2 * ks][3]);
                w.z = cvtpk_s(accS[2 * ks + 1][0], accS[2 * ks + 1][1]); w.w = cvtpk_s(accS[2 * ks + 1][2], accS[2 * ks + 1][3]); sf[ks] = __builtin_bit_cast(bf16x8, w); }
            SBAR();
            f32x4 o[4];
#pragma unroll
            for (int ft = 0; ft < 4; ++ft) o[ft] = (f32x4){0.f, 0.f, 0.f, 0.f};
#define SCAN_QLD(Q, kb) do { _Pragma("unroll") for (int k2 = 0; k2 < 2; ++k2) _Pragma("unroll") for (int ft = 0; ft < 4; ++ft) { const int fr = 16 * ft + l15, pc = 4 * (2 * (kb) + k2) + q; \
                Q[k2 * 4 + ft] = *(const LAS u32x4*)(Qs + fr * 512 + ((pc ^ (fr & 15)) << 4)); } } while (0)
#define SCAN_QMM(Q, kb) do { _Pragma("unroll") for (int k2 = 0; k2 < 2; ++k2) _Pragma("unroll") for (int ft = 0; ft < 4; ++ft) \
                o[ft] = __builtin_amdgcn_mfma_f32_16x16x32_bf16(sf[2 * (kb) + k2], __builtin_bit_cast(bf16x8, Q[k2 * 4 + ft]), o[ft], 0, 0, 0); } while (0)
            {
                u32x4 xq[8], yq[8];
                SCAN_QLD(xq, 0); __builtin_amdgcn_sched_barrier(0);
                SCAN_QLD(yq, 1); __builtin_amdgcn_sched_barrier(0);
                SCAN_QMM(xq, 0); __builtin_amdgcn_sched_barrier(0);
                SCAN_QLD(xq, 2); __builtin_amdgcn_sched_barrier(0);
                SCAN_QMM(yq, 1); __builtin_amdgcn_sched_barrier(0);
                SCAN_QLD(yq, 3); __builtin_amdgcn_sched_barrier(0);
                SCAN_QMM(xq, 2); __builtin_amdgcn_sched_barrier(0);
                SCAN_QMM(yq, 3); __builtin_amdgcn_sched_barrier(0);
            }
#undef SCAN_KTLD
#undef SCAN_KTMM
#undef SCAN_QLD
#undef SCAN_QMM
#pragma unroll
            for (int ft = 0; ft < 4; ++ft) { u32x2 w; w.x = cvtpk_s(o[ft][0], o[ft][1]); w.y = cvtpk_s(o[ft][2], o[ft][3]);
                *(u32x2*)((char*)(Vg + (size_t)(c * 64 + 16 * ft) * 2048) + ovo) = w; }
        }
        __builtin_amdgcn_s_setprio(0);
    }
    SBAR();
#undef SBAR
}

__device__ __forceinline__ void phase_merge(const Args& a, LAS unsigned char* lds, int tid, int wave, int lane) {
    const int g = blockIdx.x & 3, l15 = lane & 15, q = lane >> 4;
    LAS unsigned char* Ws = lds; LAS unsigned char* ZT = lds + 32768; LAS float* SG = (LAS float*)(lds + 65536); LAS float* MU = (LAS float*)(lds + 65536 + 67584); LAS float* RS = MU + 128; LAS float* RO = MU + 256;
    const bf16_t* Zb = (const bf16_t*)(a.ws + OFF_Z); const bf16_t* Ob = (const bf16_t*)(a.ws + OFF_V); const bf16_t* OGb = (const bf16_t*)(a.ws + OFF_OG);
    bf16_t* Ub = (bf16_t*)(a.ws + OFF_U);
    for (int p = tid; p < 4096; p += 512) { const int i = p >> 5, j4 = (p & 31) * 4; f32x4 v = *(const f32x4*)(a.w_s + (size_t)g * 16384 + i * 128 + j4);
        if ((j4 >> 6) > (i >> 6)) v = (f32x4){0.f, 0.f, 0.f, 0.f};
        u32x2 w; w.x = cvtpk_s(v[0], v[1]); w.y = cvtpk_s(v[2], v[3]);
        *(LAS u32x2*)(Ws + i * 256 + (((j4 >> 3) ^ (i & 7)) << 4) + (j4 & 4) * 2) = w; }
    for (int item = blockIdx.x; item < 1024; item += gridDim.x) {
        const int nb = item >> 2; const size_t row0 = (size_t)nb * 128; const int colg = g * 512;
        __syncthreads();
#pragma unroll 4
        for (int rr = 0; rr < 16; ++rr) { const int i = wave * 16 + rr; const size_t off = (row0 + i) * DM + colg + lane * 8;
            const u32x4 zw = *(const u32x4*)(Zb + off), ow = *(const u32x4*)(Ob + off);
            float z[8] = {bflo(zw.x), bfhi(zw.x), bflo(zw.y), bfhi(zw.y), bflo(zw.z), bfhi(zw.z), bflo(zw.w), bfhi(zw.w)};
            const float o[8] = {bflo(ow.x), bfhi(ow.x), bflo(ow.y), bfhi(ow.y), bflo(ow.z), bfhi(ow.z), bflo(ow.w), bfhi(ow.w)};
            float s = 0.f, so = 0.f, s2 = 0.f;
#pragma unroll
            for (int e = 0; e < 8; ++e) { s += z[e]; s2 += z[e] * z[e]; so += o[e] * o[e]; }
            s = wave_sum(s); s2 = wave_sum(s2); so = wave_sum(so);
            const float mean = s * (1.f / 512.f);
            if (lane == 0) { MU[i] = mean; RS[i] = 1.f / sqrtf(fmaxf(s2 * (1.f / 512.f) - mean * mean, 0.f) + LN_EPS); RO[i] = 1.f / sqrtf(so * (1.f / 512.f) + LN_EPS); } }
        __syncthreads();
        for (int cc = 0; cc < 4; ++cc) {
            const int colc = colg + cc * 128;
            u32x4 uw4[4], ow4[4], gw4[4];
#pragma unroll
            for (int k = 0; k < 4; ++k) { const int p = tid + 512 * k, i = p >> 4, c8 = (p & 15) * 8; const size_t off = (row0 + i) * DM + colc + c8;
                uw4[k] = *(const u32x4*)(Ub + off); ow4[k] = *(const u32x4*)(Ob + off); gw4[k] = *(const u32x4*)(OGb + off); }
            { const int c8 = (tid & 15) * 8;
              const f32x4 g0 = *(const f32x4*)(a.gm_g + colc + c8), g1 = *(const f32x4*)(a.gm_g + colc + c8 + 4), b0 = *(const f32x4*)(a.gm_b + colc + c8), b1 = *(const f32x4*)(a.gm_b + colc + c8 + 4);
#pragma unroll
              for (int i = 0; i < 2; ++i) { const int p = tid + 512 * i, j = (p >> 4) * 2;
                const u32x4 zw = *(const u32x4*)(Zb + (row0 + j) * DM + colc + c8), zx = *(const u32x4*)(Zb + (row0 + j + 1) * DM + colc + c8);
                const float z[8] = {bflo(zw.x), bfhi(zw.x), bflo(zw.y), bfhi(zw.y), bflo(zw.z), bfhi(zw.z), bflo(zw.w), bfhi(zw.w)};
                const float y[8] = {bflo(zx.x), bfhi(zx.x), bflo(zx.y), bfhi(zx.y), bflo(zx.z), bfhi(zx.z), bflo(zx.w), bfhi(zx.w)};
                const float mu0 = MU[j], rs0 = RS[j], mu1 = MU[j + 1], rs1 = RS[j + 1];
#pragma unroll
                for (int e = 0; e < 8; ++e) { const float gg = e < 4 ? g0[e & 3] : g1[e & 3], bb = e < 4 ? b0[e & 3] : b1[e & 3];
                    const float zn0 = (z[e] - mu0) * rs0 * gg + bb, zn1 = (y[e] - mu1) * rs1 * gg + bb;
                    const int c = c8 + e;
                    *(LAS unsigned*)(ZT + c * 256 + (((j >> 3) ^ ((c ^ (c >> 3)) & 7)) << 4) + (j & 7) * 2) = cvtpk_s(zn0, zn1); } } }
            __syncthreads();
            {
                const int c = 16 * wave + l15; bf16x8 zf[4];
#pragma unroll
                for (int ks = 0; ks < 4; ++ks) zf[ks] = *(const LAS bf16x8*)(ZT + c * 256 + (((4 * ks + q) ^ ((c ^ (c >> 3)) & 7)) << 4));
#pragma unroll
                for (int it = 0; it < 8; ++it) { const int i = 16 * it + l15; f32x4 acc = (f32x4){0.f, 0.f, 0.f, 0.f};
#pragma unroll
                    for (int ks = 0; ks < 4; ++ks) { if (it < 4 && ks >= 2) continue;
                        const bf16x8 wf = *(const LAS bf16x8*)(Ws + i * 256 + (((4 * ks + q) ^ (i & 7)) << 4));
                        acc = __builtin_amdgcn_mfma_f32_16x16x32_bf16(wf, zf[ks], acc, 0, 0, 0); }
#pragma unroll
                    for (int r = 0; r < 4; ++r) SG[(16 * it + 4 * q + r) * 132 + c] = acc[r]; }
            }
            __syncthreads();
#pragma unroll
            for (int k = 0; k < 4; ++k) { const int p = tid + 512 * k, i = p >> 4, c8 = (p & 15) * 8; const size_t off = (row0 + i) * DM + colc + c8;
                const u32x4 uw = uw4[k], ow = ow4[k], gw = gw4[k];
                const f32x4 s0 = *(const LAS f32x4*)(SG + i * 132 + c8), s1 = *(const LAS f32x4*)(SG + i * 132 + c8 + 4);
                const f32x4 n0 = *(const f32x4*)(a.gla_g + colc + c8), n1 = *(const f32x4*)(a.gla_g + colc + c8 + 4);
                const float bs = a.b_s[g * 128 + i], ro = RO[i];
                const unsigned uu[4] = {uw.x, uw.y, uw.z, uw.w}, oo[4] = {ow.x, ow.y, ow.z, ow.w}, gg[4] = {gw.x, gw.y, gw.z, gw.w};
                float m[8];
#pragma unroll
                for (int e = 0; e < 8; ++e) { const int wi = e >> 1; const bool hi = e & 1;
                    const float uv = hi ? bfhi(uu[wi]) : bflo(uu[wi]), ov = hi ? bfhi(oo[wi]) : bflo(oo[wi]), gv = hi ? bfhi(gg[wi]) : bflo(gg[wi]);
                    const float sg = (e < 4 ? s0[e & 3] : s1[e & 3]) + bs, ng = e < 4 ? n0[e & 3] : n1[e & 3];
                    m[e] = gv * (ov * ro * ng) + uv * sg; }
                u32x4 w; w.x = cvtpk_s(m[0], m[1]); w.y = cvtpk_s(m[2], m[3]); w.z = cvtpk_s(m[4], m[5]); w.w = cvtpk_s(m[6], m[7]);
                *(u32x4*)(Ub + off) = w; }
        }
    }
    __syncthreads();
}

typedef __attribute__((address_space(1))) unsigned gu32;
#define XB_TMO      128
#define XB_XCNT(j)  (256  + 64 * (j))
#define XB_XSUB(j)  (1280 + 64 * (j))
#define XB_XGEN(j)  (2304 + 64 * (j))
#define XB_TOP      3328
#define XB_TOPGEN   3392
#define XCD_BAR_WORDS 3456
#define XB_SPIN_CAP (1u << 18)

__device__ __forceinline__ unsigned xb_ld(unsigned* p)              { return __hip_atomic_load(p, __ATOMIC_RELAXED, __HIP_MEMORY_SCOPE_AGENT); }
__device__ __forceinline__ unsigned xb_add(unsigned* p, unsigned v) { return __hip_atomic_fetch_add(p, v, __ATOMIC_RELAXED, __HIP_MEMORY_SCOPE_AGENT); }
__device__ __forceinline__ unsigned xb_xcc_id() { return (unsigned)__builtin_amdgcn_s_getreg((3 << 11) | 20) & 0xFu; }
#define XB_SPIN(cond, bar) do { unsigned _sp = 0; while (cond) { __builtin_amdgcn_s_sleep(1); \
    if ((++_sp & 255u) == 0u) { if (xb_ld(&(bar)[XB_TMO])) break; if (_sp > XB_SPIN_CAP) { atomicAdd(&(bar)[XB_TMO], 1u); break; } } } } while (0)

struct XcdBarrier {
    unsigned* bar; unsigned x;
    volatile LAS unsigned* st;
};

__device__ __forceinline__ XcdBarrier xcd_barrier_post(unsigned* bar, volatile LAS unsigned* st) {
    XcdBarrier b; b.bar = bar; b.x = xb_xcc_id(); b.st = st;
    if (threadIdx.x == 0) (void)xb_add(&bar[XB_XCNT(b.x)], 1u);
    return b;
}
__device__ __forceinline__ void xcd_barrier_complete(unsigned* bar, unsigned x, unsigned& nloc, unsigned& nx) {
    const unsigned G = gridDim.x * gridDim.y * gridDim.z;
    unsigned sum, cnt, mine, sp = 0u;
    for (;;) {
        sum = 0u; cnt = 0u; mine = 0u;
#pragma unroll
        for (unsigned j = 0; j < 16; ++j) { const unsigned c = xb_ld(&bar[XB_XCNT(j)]); sum += c; cnt += (c > 0u) ? 1u : 0u; mine = (j == x) ? c : mine; }
        if (sum == G) break;
        __builtin_amdgcn_s_sleep(1);
        if ((++sp & 255u) == 0u) { if (xb_ld(&bar[XB_TMO])) break; if (sp > XB_SPIN_CAP) { atomicAdd(&bar[XB_TMO], 1u); break; } }
    }
    nloc = mine > 0u ? mine : 1u; nx = cnt > 0u ? cnt : 1u;
}

__device__ __forceinline__ void xcd_barrier(const XcdBarrier& b) {
    asm volatile("s_waitcnt vmcnt(0)" ::: "memory");
    __syncthreads();
    if (threadIdx.x == 0) {
        unsigned* bar = b.bar;
        __builtin_amdgcn_s_waitcnt(0);
        unsigned nloc = b.st[0], nx = b.st[1];
        if (nloc == 0u) { xcd_barrier_complete(bar, b.x, nloc, nx); b.st[0] = nloc; b.st[1] = nx; }
        const unsigned old = xb_add(&bar[XB_XSUB(b.x)], 1u);
        const unsigned gen = old / nloc;
        if (old + 1u == (gen + 1u) * nloc) {
            __builtin_amdgcn_fence(__ATOMIC_RELEASE, "agent");
            asm volatile("s_waitcnt vmcnt(0)" ::: "memory");
            const unsigned og = xb_add(&bar[XB_TOP], 1u);
            const unsigned tg = og / nx;
            if (og + 1u == (tg + 1u) * nx) xb_add(&bar[XB_TOPGEN], 1u);
            else XB_SPIN(xb_ld(&bar[XB_TOPGEN]) == tg, bar);
            __builtin_amdgcn_fence(__ATOMIC_ACQUIRE, "agent");
            xb_add(&bar[XB_XGEN(b.x)], 1u);
            asm volatile("s_waitcnt vmcnt(0)" ::: "memory");
        } else {
            XB_SPIN(xb_ld(&bar[XB_XGEN(b.x)]) == gen, bar);
            __builtin_amdgcn_fence(__ATOMIC_ACQUIRE, "agent");
            asm volatile("s_waitcnt vmcnt(0)" ::: "memory");
        }
    }
    __syncthreads();
}


__global__ void __launch_bounds__(512, 2) mega(Args a) {
    extern __shared__ __attribute__((aligned(16))) unsigned char lds_raw[];
    LAS unsigned char* lds = (LAS unsigned char*)lds_raw;
    const int tid = threadIdx.x, lane = tid & 63, wave = __builtin_amdgcn_readfirstlane(tid >> 6);
    const int G = gridDim.x, gw = blockIdx.x * 8 + wave, ngw = G * 8;
    const int lo = a.ph_lo, hi = a.ph_hi;
    if (tid < 16) ((LAS unsigned*)(lds + LDS_BARW))[tid] = 0u;
    __syncthreads();
    XcdBarrier bar; bar.bar = (unsigned*)(a.ws + OFF_CTL); bar.x = 0; bar.st = nullptr;
    if (a.coop) bar = xcd_barrier_post((unsigned*)(a.ws + OFF_CTL), (volatile LAS unsigned*)(lds + LDS_BARW));
#define IN(k) (lo <= (k) && (k) < hi)
#ifndef PROF_SEC
#define PROF_SEC 0
#endif
#ifndef PROF_WG
#define PROF_WG 0
#endif
    unsigned long long bacc = 0ull;
    if (a.pad == 0x7fffffff) cg::this_grid().sync();
#define SEAM(k) do { if (IN(k) && IN((k) + 1)) { unsigned long long tb_ = 0ull; if (PROF_SEC == 20 && (k) != 0) tb_ = __builtin_amdgcn_s_memrealtime(); xcd_barrier(bar); \
        if (PROF_SEC == 20 && (k) != 0) bacc += __builtin_amdgcn_s_memrealtime() - tb_; } } while (0)
    if (IN(0)) { phase_prep(a, lds, gw, ngw, wave, lane); __syncthreads(); }
    SEAM(0);
    if (IN(1)) { { pg8::Gemm gm{(const bf16_t*)(a.ws + OFF_H0), (const bf16_t*)(a.ws + OFF_W1T), MTOK, 14336, DM}; pg8::StaticOrder S; S.init(MTOK, 14336, G, (int)blockIdx.x);
          Epi1 E{a.ws, a.out, a.b_in};
          pg8::gemm_phase<Epi1, pg8::StaticOrder, true, true>(lds, gm, S, E); }
        { pg8::Gemm gm{(const bf16_t*)(a.ws + OFF_H0), (const bf16_t*)(a.ws + OFF_W1T) + (size_t)14336 * DM, MTOK, 512, 1024, DM, (size_t)2048, (size_t)2048}; pg8::StaticOrder S; S.init(MTOK, 512, G, (int)blockIdx.x);
          EpiFg E{(float*)(a.ws + OFF_FG), (float*)(a.ws + OFF_FG2)};
          pg8::gemm_phase<EpiFg, pg8::StaticOrder, true, true>(lds, gm, S, E); } }
    SEAM(1);
    if (IN(2)) phase_kt(a, lds, tid);
    SEAM(2);
    if (IN(3)) { if (blockIdx.x < 128) phase_scan(a, lds, tid, wave, lane); else { phase_prep2(a, lds, (blockIdx.x - 128) * 8 + wave, (G - 128) * 8, wave, lane); __syncthreads(); } }
    SEAM(3);
    if (IN(4)) phase_merge(a, lds, tid, wave, lane);
    SEAM(4);
    if (IN(5)) { pg8::Gemm gm{(const bf16_t*)(a.ws + OFF_U), (const bf16_t*)(a.ws + OFF_WOT), MTOK, DM, DM}; pg8::StaticOrder S; S.init(MTOK, DM, G, (int)blockIdx.x);
        EpiRes<false> E{(bf16_t*)(a.ws + OFF_H1PRE), (const bf16_t*)(a.ws + OFF_H0), nullptr};
        pg8::gemm_phase<EpiRes<false>, pg8::StaticOrder, true, true>(lds, gm, S, E); }
    SEAM(5);
    if (IN(6)) { const bf16_t* src = (const bf16_t*)(a.ws + OFF_H1PRE); bf16_t* H1 = (bf16_t*)(a.ws + OFF_H1);
        ln_stream<true, true>(src, H1, a.ln1_g, a.ln1_b, gw, ngw, lane); }
    SEAM(6);
    if (IN(7)) { phase_pconv(a, gw, ngw, lane);
        pg8::Gemm gm{(const bf16_t*)(a.ws + OFF_H1), (const bf16_t*)(a.out + DO_WGUT), MTOK, NGU, DM}; pg8::StaticOrder S; S.init(MTOK, NGU, G, (int)blockIdx.x);
        Epi5 E{(bf16_t*)(a.ws + OFF_ACT), (bf16_t*)(a.ws + OFF_GPG), a.b_pg};
        pg8::gemm_phase<Epi5, pg8::StaticOrder, true, true>(lds, gm, S, E); }
    SEAM(7);
    if (IN(9)) { pg8::Gemm gm{(const bf16_t*)(a.ws + OFF_ACT), (const bf16_t*)(a.out + DO_WDT), MTOK, DM, KX}; pg8::StaticOrder S; S.init(MTOK, DM, G, (int)blockIdx.x);
        EpiDown E{(bf16_t*)(a.ws + OFF_OUTPRE), (const bf16_t*)(a.ws + OFF_H1), (const bf16_t*)(a.ws + OFF_GPG)};
        pg8::gemm_phase<EpiDown, pg8::StaticOrder, true, true>(lds, gm, S, E); }
    SEAM(9);
    if (IN(10)) { const bf16_t* src = (const bf16_t*)(a.ws + OFF_OUTPRE); float* o = (float*)a.out;
        ln_stream<false, true>(src, o, a.ln2_g, a.ln2_b, gw, ngw, lane);
        if (PROF_SEC == 20) { __syncthreads(); if (blockIdx.x == PROF_WG && wave == 0) { const float d = (float)bacc * 0.01f * 5e-4f;
#pragma unroll 1
                for (int k = 0; k < 16; ++k) if (lane == 0) o[(size_t)(gw + k * ngw) * DM] += (k & 1) ? -d : d; } } }
    if (IN(11)) {
        float* o = (float*)a.out;
        if (a.pad == 0) { const bf16_t* src = (const bf16_t*)(a.ws + (size_t)a.coop * MiB);
            for (size_t i = (size_t)blockIdx.x * 512 + tid; i < (size_t)MTOK * DM; i += (size_t)G * 512) o[i] = __uint_as_float(((unsigned)src[i]) << 16); }
        else { const float* src = (const float*)(a.ws + (size_t)a.coop * MiB);
            for (size_t i = (size_t)blockIdx.x * 512 + tid; i < (size_t)MTOK * DM; i += (size_t)G * 512) o[i] = src[i]; }
    }
#undef IN
#undef SEAM
}

#ifndef N_LAUNCH_MODE
#define N_LAUNCH_MODE 1
#endif
extern "C" void kernel_launch(void* const* d_in, const int* in_sizes, int n_in, void* d_out, int out_size, void* d_ws, size_t ws_size, hipStream_t stream) {
    static int grid = 0;
    if (grid == 0) {
        if (n_in != 23 || out_size != MTOK * DM || ws_size < WS_NEED) { fprintf(stderr, "kernel_launch: unexpected shapes (n_in %d out %d ws %zu)\n", n_in, out_size, ws_size); grid = -1; return; }
        int dev = 0, cus = 0, per_cu = 0;
        hipGetDevice(&dev); hipDeviceGetAttribute(&cus, hipDeviceAttributeMultiprocessorCount, dev);
        if (hipFuncSetAttribute((const void*)mega, hipFuncAttributeMaxDynamicSharedMemorySize, LDS_BYTES) != hipSuccess) { fprintf(stderr, "kernel_launch: hipFuncSetAttribute failed\n"); grid = -1; return; }
        hipOccupancyMaxActiveBlocksPerMultiprocessor(&per_cu, (const void*)mega, 512, LDS_BYTES);
        (void)hipGetLastError();
        if (cus != 256 || per_cu < 1) { fprintf(stderr, "kernel_launch: needs 256 CUs with one resident block each (cus %d per_cu %d)\n", cus, per_cu); grid = -1; return; }
        grid = 256;
    }
    if (grid < 0) return;
    Args a{};
    const float** f = (const float**)&a;
    for (int i = 0; i < 23; ++i) f[i] = (const float*)d_in[i];
    a.out = (unsigned char*)d_out; a.ws = (unsigned char*)d_ws;
#if N_LAUNCH_MODE == 1
    a.ph_lo = 0; a.ph_hi = 11; a.coop = 1;
    if (hipMemsetAsync((char*)d_ws + OFF_CTL, 0, 65536, stream) != hipSuccess) { fprintf(stderr, "kernel_launch: memset failed\n"); return; }
    void* args[] = {&a};
    hipError_t e = hipLaunchCooperativeKernel((const void*)mega, dim3(grid), dim3(512), args, LDS_BYTES, stream);
    if (e != hipSuccess) fprintf(stderr, "cooperative launch failed: %s\n", hipGetErrorString(e));
#else
#ifndef DBG_STOP
#define DBG_STOP 10
#endif
#ifndef DBG_OFF_MIB
#define DBG_OFF_MIB 321
#endif
#ifndef DBG_F32
#define DBG_F32 0
#endif
#ifndef PROG
#define PROG {0, 1, 2, 3, 4, 5, 6, 7, 8, 9, 10}
#endif
    static const int prog[] = PROG;
    for (int pi = 0; pi < (int)(sizeof(prog) / sizeof(prog[0])); ++pi) { const int ph = prog[pi]; if (ph > DBG_STOP) break; a.ph_lo = ph; a.ph_hi = ph + 1; a.coop = 0;
        hipLaunchKernelGGL(mega, dim3(grid), dim3(512), LDS_BYTES, stream, a); }
    if (DBG_STOP < 10) { a.ph_lo = 11; a.ph_hi = 12; a.coop = DBG_OFF_MIB; a.pad = DBG_F32;
        hipLaunchKernelGGL(mega, dim3(grid), dim3(512), LDS_BYTES, stream, a); }
#endif
}
```
